# Optimizing an MI355X kernel written in HIP

```python
import math
import jax, jax.numpy as jnp
from jax import lax
import numpy as np

D_MODEL = 2048
BATCH = 2
SEQ = 16384
DEPTH = 1

HEAD_DIM = 128
N_HEADS_A = 8
N_HEADS_B = 8
MIX_WIDTH = (N_HEADS_A + N_HEADS_B) * HEAD_DIM
KV_RANK = 256
IDX_HEADS = 16
IDX_DIM = 64
TOPK_MAX = 256
N_BUCKETS = 32
MAX_DISTANCE = 128
D_FF = 5632
CONV_WIDTH = 3
Q_BLOCK = 128
EPS = 1e-6

COL_SIZES = (
    N_HEADS_A * HEAD_DIM,
    KV_RANK,
    IDX_HEADS * IDX_DIM,
    IDX_DIM,
    IDX_HEADS,
    N_HEADS_B * HEAD_DIM,
    N_HEADS_B * HEAD_DIM,
    N_HEADS_B * HEAD_DIM,
    N_HEADS_B,
)
D_IN = sum(COL_SIZES)

kernel_name = 'hymba_dsa_fox_convffn_layer'


def rmsnorm(x, g):
    xf = x.astype(jnp.float32)
    y = xf * lax.rsqrt(jnp.mean(xf * xf, axis=-1, keepdims=True) + EPS)
    return (y * g.astype(jnp.float32)).astype(x.dtype)


def t5_bucket(n):
    max_exact = N_BUCKETS // 2
    nf = jnp.maximum(n, 1).astype(jnp.float32)
    large = max_exact + (jnp.log(nf / max_exact) / math.log(MAX_DISTANCE / max_exact)
                         * (N_BUCKETS - max_exact)).astype(jnp.int32)
    large = jnp.minimum(large, N_BUCKETS - 1)
    return jnp.where(n < max_exact, n, large)


def to_blocks(a):
    b, l = a.shape[0], a.shape[1]
    a = a.reshape((b, l // Q_BLOCK, Q_BLOCK) + a.shape[2:])
    return jnp.moveaxis(a, 1, 0)


def from_blocks(a):
    a = jnp.moveaxis(a, 0, 1)
    return a.reshape((a.shape[0], a.shape[1] * a.shape[2]) + a.shape[3:])


def dsa_mixer(q, c_kv, q_idx, k_idx, w_idx, w_uk, w_uv, t5_table):
    L = q.shape[1]
    nb = L // Q_BLOCK
    topk = min(TOPK_MAX, L // 4)
    key_pos = jnp.arange(L)
    q_lat = jnp.einsum('bthd,hdr->bthr', q, w_uk)

    def block(args):
        blk, ql, qi, wi = args
        t_pos = blk * Q_BLOCK + jnp.arange(Q_BLOCK)
        causal = key_pos[None, :] <= t_pos[:, None]
        dots = jnp.einsum('bthd,bsd->bths', qi, k_idx).astype(jnp.float32) * (IDX_DIM ** -0.5)
        score = jnp.einsum('bth,bths->bts', wi.astype(jnp.float32) * (IDX_HEADS ** -0.5),
                           jax.nn.relu(dots))
        score = jnp.where(causal[None], score, -jnp.inf)
        _, sel = lax.top_k(score, topk)
        c_sel = jax.vmap(lambda c, i: c[i])(c_kv, sel)
        dist = t_pos[None, :, None] - sel
        valid = dist >= 0
        bias = t5_table[t5_bucket(jnp.maximum(dist, 0))]
        logits = (jnp.einsum('bthr,btkr->bthk', ql, c_sel).astype(jnp.float32) * (HEAD_DIM ** -0.5)
                  + jnp.moveaxis(bias, -1, 2).astype(jnp.float32))
        logits = jnp.where(valid[:, :, None, :], logits, -jnp.inf)
        p = jax.nn.softmax(logits, axis=-1).astype(c_sel.dtype)
        return jnp.einsum('bthk,btkr->bthr', p, c_sel)

    o_lat = from_blocks(lax.map(block, (jnp.arange(nb), to_blocks(q_lat),
                                        to_blocks(q_idx), to_blocks(w_idx))))
    return jnp.einsum('bthr,hrd->bthd', o_lat, w_uv)


def fox_mixer(q, k, v, log_f):
    L = q.shape[1]
    nb = L // Q_BLOCK
    key_pos = jnp.arange(L)
    cum = jnp.cumsum(log_f.astype(jnp.float32), axis=1)
    cum_k = jnp.moveaxis(cum, 1, 2)

    def block(args):
        blk, qb, cq = args
        t_pos = blk * Q_BLOCK + jnp.arange(Q_BLOCK)
        causal = key_pos[None, :] <= t_pos[:, None]
        decay = jnp.moveaxis(cq, 1, 2)[..., None] - cum_k[:, :, None, :]
        logits = jnp.einsum('bthd,bshd->bhts', qb, k).astype(jnp.float32) * (HEAD_DIM ** -0.5) + decay
        logits = jnp.where(causal[None, None], logits, -jnp.inf)
        p = jax.nn.softmax(logits, axis=-1).astype(v.dtype)
        return jnp.einsum('bhts,bshd->bthd', p, v)

    return from_blocks(lax.map(block, (jnp.arange(nb), to_blocks(q), to_blocks(cum))))


def conv_ffn(h, w_up, conv_w, conv_b, w_down):
    L = h.shape[1]
    u = h @ w_up
    up = jnp.pad(u, ((0, 0), (CONV_WIDTH - 1, 0), (0, 0)))
    acc = conv_b
    for j in range(CONV_WIDTH):
        acc = acc + conv_w[j] * up[:, j:j + L]
    gate, val = jnp.split(acc, 2, axis=-1)
    return (jax.nn.silu(gate) * val) @ w_down


def setup_inputs(seed: int = 0) -> dict:
    key = jax.random.key(seed)
    ks = jax.random.split(key, 15)
    f32 = jnp.float32
    n = lambda k, s: jax.random.normal(k, s, f32)
    return {
        'x': n(ks[0], (BATCH, SEQ, D_MODEL)),
        'w_in': n(ks[1], (DEPTH, D_MODEL, D_IN)) * D_MODEL ** -0.5,
        'kv_norm_g': 1.0 + 0.02 * n(ks[2], (DEPTH, KV_RANK)),
        'w_uk': n(ks[3], (DEPTH, N_HEADS_A, HEAD_DIM, KV_RANK)) * KV_RANK ** -0.5,
        'w_uv': n(ks[4], (DEPTH, N_HEADS_A, KV_RANK, HEAD_DIM)) * KV_RANK ** -0.5,
        't5_table': 0.5 * n(ks[5], (N_BUCKETS, N_HEADS_A)),
        'fgate_b': 3.0 + 0.1 * n(ks[6], (DEPTH, N_HEADS_B)),
        'w_o': n(ks[7], (DEPTH, MIX_WIDTH, D_MODEL)) * MIX_WIDTH ** -0.5,
        'norm1_g': 1.0 + 0.02 * n(ks[8], (DEPTH, D_MODEL)),
        'norm2_g': 1.0 + 0.02 * n(ks[9], (DEPTH, D_MODEL)),
        'w_up': n(ks[10], (DEPTH, D_MODEL, 2 * D_FF)) * D_MODEL ** -0.5,
        'conv_w': 0.5 * n(ks[11], (DEPTH, CONV_WIDTH, 2 * D_FF)),
        'conv_b': 0.02 * n(ks[12], (DEPTH, 2 * D_FF)),
        'w_down': n(ks[13], (DEPTH, D_FF, D_MODEL)) * D_FF ** -0.5,
        'final_g': 1.0 + 0.02 * n(ks[14], (D_MODEL,)),
    }


def reference(x, w_in, kv_norm_g, w_uk, w_uv, t5_table, fgate_b, w_o, norm1_g, norm2_g,
              w_up, conv_w, conv_b, w_down, final_g):
    B, L, _ = x.shape
    split_points = [int(s) for s in np.cumsum(COL_SIZES)[:-1]]
    for l in range(DEPTH):
        h = rmsnorm(x, norm1_g[l])
        proj = h @ w_in[l]
        aq, akv, aiq, aik, aiw, bq, bk, bv, bf = jnp.split(proj, split_points, axis=-1)
        c_kv = rmsnorm(akv, kv_norm_g[l])
        o_a = dsa_mixer(aq.reshape(B, L, N_HEADS_A, HEAD_DIM), c_kv,
                        aiq.reshape(B, L, IDX_HEADS, IDX_DIM), aik, aiw,
                        w_uk[l], w_uv[l], t5_table)
        log_f = jax.nn.log_sigmoid(bf.astype(jnp.float32) + fgate_b[l].astype(jnp.float32))
        o_b = fox_mixer(bq.reshape(B, L, N_HEADS_B, HEAD_DIM),
                        bk.reshape(B, L, N_HEADS_B, HEAD_DIM),
                        bv.reshape(B, L, N_HEADS_B, HEAD_DIM), log_f)
        mix = jnp.concatenate([o_a.reshape(B, L, -1), o_b.reshape(B, L, -1)], axis=-1)
        x = x + mix @ w_o[l]
        x = x + conv_ffn(rmsnorm(x, norm2_g[l]), w_up[l], conv_w[l], conv_b[l], w_down[l])
    return rmsnorm(x, final_g)
```

```cpp
#include <hip/hip_runtime.h>
#include <cstdio>
#include <cstdint>
namespace pg8 {
#define PG8_LAS __attribute__((address_space(3)))
typedef unsigned short bf16_t;
typedef short bf16x8 __attribute__((ext_vector_type(8)));
typedef float f32x4 __attribute__((ext_vector_type(4)));
typedef unsigned u32x4 __attribute__((ext_vector_type(4)));
constexpr int BM = 256, BK = 64, HALF = 128, HTB = HALF * BK * 2  , STAGE_BYTES = 8 * HTB, NXCD = 8, WGM = 8;

__host__ __device__ __forceinline__ int lds_byte(int r, int c) { const int st = (r >> 4) * 2 + (c >> 5), rr = r & 15, cc = c & 31, ob = rr * 64 + cc * 2; return st * 1024 + (ob ^ (((ob >> 9) & 1) << 5)); }
__host__ __device__ __forceinline__ void stage_rc(int b, int& R, int& C) { const int st = b / 1024, sb = b % 1024, swz = sb ^ (((sb >> 9) & 1) << 5); R = (st >> 1) * 16 + swz / 64; C = (st & 1) * 32 + (swz % 64) / 2; }
__host__ __device__ __forceinline__ int perm32(int rho) { const int n = rho >> 4, i = rho & 15; return 8 * (i >> 2) + 4 * n + (i & 3); }

struct Unit { int pm, pn; };
struct Gemm { const bf16_t* A; const bf16_t* Bt; int M, N, K; };

struct StaticOrder {
    int nM, nN, nwg, G, c;
    __host__ __device__ void init(int M, int N, int G_, int c_) { nM = M / BM; nN = N / BM; nwg = nM * nN; G = G_; c = c_; }
    __host__ __device__ bool next(int i, Unit& u) const {
        const long L = (long)i * G + c; if (L >= nwg) return false;
        int wgid = (int)L; { const int q = nwg / NXCD, r = nwg % NXCD, xcd = wgid % NXCD, off = wgid / NXCD; wgid = (xcd < r ? xcd * (q + 1) : r * (q + 1) + (xcd - r) * q) + off; }
        const int nig = WGM * nN, gid = wgid / nig, fm = gid * WGM, gsz = (nM - fm) < WGM ? (nM - fm) : WGM;
        u.pm = fm + ((wgid % nig) % gsz); u.pn = (wgid % nig) / gsz; return true;
    }
    __device__ __forceinline__ void a_ready(const Unit&) const {}
    __device__ __forceinline__ void done(const Unit&) const {}
};

__device__ __forceinline__ unsigned cvt_pk_bf16(float lo, float hi) { unsigned r; asm volatile("v_cvt_pk_bf16_f32 %0, %1, %2" : "=v"(r) : "v"(lo), "v"(hi)); return r; }
__device__ __forceinline__ u32x4 pack8bf(const f32x4 v0, const f32x4 v1) { u32x4 w; w.x = cvt_pk_bf16(v0[0], v0[1]); w.y = cvt_pk_bf16(v0[2], v0[3]); w.z = cvt_pk_bf16(v1[0], v1[1]); w.w = cvt_pk_bf16(v1[2], v1[3]); return w; }
__device__ __forceinline__ float dot4(const f32x4 a) { return (a[0] * a[0] + a[1] * a[1]) + (a[2] * a[2] + a[3] * a[3]); }
template <int CTRL> __device__ __forceinline__ float dppf(float v) { return __builtin_bit_cast(float, __builtin_amdgcn_update_dpp(0, __builtin_bit_cast(int, v), CTRL, 0xf, 0xf, false)); }

struct EpiInProj {
    static constexpr bool PERM = true, AFTER_DRAIN = false;
    bf16_t *qlat, *akv, *aiq, *bq; size_t qkv_stride; float* small;
    __device__ __forceinline__ void operator()(const f32x4 (&acc)[2][2][4][2], const Unit& u, int wr, int wc, int fr, int fq) const {
        const int pn = u.pn, row0 = u.pm * BM + wr * 64 + fr, cl = wc * 32 + 8 * fq;
        if (pn < 13) {
            bf16_t* dst; int ld, cb;
            if (pn < 8) { dst = qlat; ld = 2048; cb = pn * 256; } else if (pn == 8) { dst = akv; ld = 256; cb = 0; } else { dst = aiq; ld = 1024; cb = (pn - 9) * 256; }
#pragma unroll
            for (int ai = 0; ai < 2; ++ai)
#pragma unroll
                for (int m = 0; m < 4; ++m) { bf16_t* rowp = dst + (size_t)(row0 + ai * HALF + m * 16) * ld + cb + cl;
#pragma unroll
                    for (int bj = 0; bj < 2; ++bj) *(u32x4*)(rowp + bj * HALF) = pack8bf(acc[ai][bj][m][0], acc[ai][bj][m][1]); }
        } else if (pn < 25) {
            const int w = (pn - 13) >> 2, hp = (pn - 13) & 3; bf16_t* dst = bq + (size_t)w * qkv_stride;
#pragma unroll
            for (int ai = 0; ai < 2; ++ai)
#pragma unroll
                for (int m = 0; m < 4; ++m) { const int row = row0 + ai * HALF + m * 16, b = row >> 14, t = row & 16383;
#pragma unroll
                    for (int bj = 0; bj < 2; ++bj) *(u32x4*)(dst + ((size_t)(b * 8 + 2 * hp + bj) * 16384 + t) * 128 + cl) = pack8bf(acc[ai][bj][m][0], acc[ai][bj][m][1]); }
        } else {
#pragma unroll
            for (int ai = 0; ai < 2; ++ai)
#pragma unroll
                for (int m = 0; m < 4; ++m) { float* rp = small + (size_t)(row0 + ai * HALF + m * 16) * 128 + cl; *(f32x4*)rp = acc[ai][0][m][0]; *(f32x4*)(rp + 4) = acc[ai][0][m][1]; }
        }
    }
};
struct EpiOutProj {
    static constexpr bool PERM = true, AFTER_DRAIN = false;
    const float* x; float* x1; bf16_t* x1b; bf16_t* ahalo; float* ss;
    __device__ __forceinline__ void operator()(const f32x4 (&acc)[2][2][4][2], const Unit& u, int wr, int wc, int fr, int fq) const {
        const int row0 = u.pm * BM + wr * 64 + fr, col0 = u.pn * BM + wc * 32 + 8 * fq;
#pragma unroll
        for (int ai = 0; ai < 2; ++ai)
#pragma unroll
            for (int m = 0; m < 4; ++m) { const int row = row0 + ai * HALF + m * 16; float s = 0.f;
#pragma unroll
                for (int bj = 0; bj < 2; ++bj) { const size_t o = (size_t)row * 2048 + col0 + bj * HALF;
                    const f32x4 v0 = *(const f32x4*)(x + o) + acc[ai][bj][m][0], v1 = *(const f32x4*)(x + o + 4) + acc[ai][bj][m][1];
                    *(f32x4*)(x1 + o) = v0; *(f32x4*)(x1 + o + 4) = v1; const u32x4 w = pack8bf(v0, v1); *(u32x4*)(x1b + o) = w;
                    if ((row & 63) >= 62) *(u32x4*)(ahalo + (size_t)(2 * (row >> 6) + (row & 1)) * 2048 + col0 + bj * HALF) = w;
                    s += dot4(v0) + dot4(v1); }
                s += __shfl_xor(s, 16); s += __shfl_xor(s, 32);
                if (fq == 0) unsafeAtomicAdd(ss + row, s); }
    }
};
struct EpiHalo {
    static constexpr bool PERM = true, AFTER_DRAIN = false;
    const float* ss; float* uh;
    __device__ __forceinline__ void operator()(const f32x4 (&acc)[2][2][4][2], const Unit& u, int wr, int wc, int fr, int fq) const {
        const int row0 = u.pm * BM + wr * 64 + fr, col0 = u.pn * BM + wc * 32 + 8 * fq;
#pragma unroll
        for (int ai = 0; ai < 2; ++ai)
#pragma unroll
            for (int m = 0; m < 4; ++m) { const int hr = row0 + ai * HALF + m * 16, src = 64 * (hr >> 1) + 62 + (hr & 1);
                const float rs = 1.0f / sqrtf(ss[src] * (1.0f / 2048.0f) + 1e-6f);
#pragma unroll
                for (int bj = 0; bj < 2; ++bj) { float* p = uh + (size_t)hr * 11264 + col0 + bj * HALF; *(f32x4*)p = acc[ai][bj][m][0] * rs; *(f32x4*)(p + 4) = acc[ai][bj][m][1] * rs; } }
    }
};
struct EpiUp {
    static constexpr bool PERM = true, AFTER_DRAIN = false;
    const float* ss; const float* uh; const float* cw; const float* cbias; bf16_t* act;
    __device__ __forceinline__ void operator()(const f32x4 (&acc)[2][2][4][2], const Unit& u, int wr, int wc, int fr, int fq) const {
        const int pn = u.pn, cl = wc * 32 + 8 * fq, rowb0 = u.pm * BM + wr * 64;
        unsigned pk[2][4][2];
#pragma unroll
        for (int n = 0; n < 2; ++n) {
            f32x4 w0[2], w1[2], w2[2], bb[2];
#pragma unroll
            for (int bj = 0; bj < 2; ++bj) { const int oc = bj * 5632 + pn * 128 + cl + 4 * n;
                w0[bj] = *(const f32x4*)(cw + oc); w1[bj] = *(const f32x4*)(cw + 11264 + oc); w2[bj] = *(const f32x4*)(cw + 22528 + oc); bb[bj] = *(const f32x4*)(cbias + oc); }
#pragma unroll
            for (int ai = 0; ai < 2; ++ai) {
                const int rb = rowb0 + ai * HALF;
                f32x4 prev[2] = {(f32x4){0.f, 0.f, 0.f, 0.f}, (f32x4){0.f, 0.f, 0.f, 0.f}};
                if ((rb & 16383) != 0 && fr >= 14) { const int hr = 2 * ((rb >> 6) - 1) + (fr - 14);
#pragma unroll
                    for (int bj = 0; bj < 2; ++bj) prev[bj] = *(const f32x4*)(uh + (size_t)hr * 11264 + pn * 256 + bj * HALF + cl + 4 * n); }
#pragma unroll
                for (int m = 0; m < 4; ++m) {
                    const int row = rb + m * 16 + fr; const float rs = 1.0f / sqrtf(ss[row] * (1.0f / 2048.0f) + 1e-6f);
                    f32x4 y[2];
#pragma unroll
                    for (int bj = 0; bj < 2; ++bj) { const f32x4 uc = acc[ai][bj][m][n] * rs;
#pragma unroll
                        for (int j = 0; j < 4; ++j) { const float a1 = dppf<0x121>(uc[j]), b1 = dppf<0x121>(prev[bj][j]), a2 = dppf<0x122>(uc[j]), b2 = dppf<0x122>(prev[bj][j]);
                            const float u1 = fr >= 1 ? a1 : b1, u2 = fr >= 2 ? a2 : b2;
                            y[bj][j] = bb[bj][j] + w0[bj][j] * u2 + w1[bj][j] * u1 + w2[bj][j] * uc[j]; }
                        prev[bj] = uc; }
                    float a[4];
#pragma unroll
                    for (int j = 0; j < 4; ++j) { const float g = y[0][j]; a[j] = g * __builtin_amdgcn_rcpf(1.0f + __builtin_amdgcn_exp2f(-1.4426950408889634f * g)) * y[1][j]; }
                    const unsigned wlo = cvt_pk_bf16(a[0], a[1]), whi = cvt_pk_bf16(a[2], a[3]);
                    if (n == 0) { pk[ai][m][0] = wlo; pk[ai][m][1] = whi; }
                    else { u32x4 w; w.x = pk[ai][m][0]; w.y = pk[ai][m][1]; w.z = wlo; w.w = whi; *(u32x4*)(act + (size_t)row * 5632 + pn * 128 + cl) = w; }
                }
            }
        }
    }
};
struct EpiDown {
    static constexpr bool PERM = true, AFTER_DRAIN = false;
    float* xio; float* ss;
    __device__ __forceinline__ void operator()(const f32x4 (&acc)[2][2][4][2], const Unit& u, int wr, int wc, int fr, int fq) const {
        const int row0 = u.pm * BM + wr * 64 + fr, col0 = u.pn * BM + wc * 32 + 8 * fq;
#pragma unroll
        for (int ai = 0; ai < 2; ++ai)
#pragma unroll
            for (int m = 0; m < 4; ++m) { const int row = row0 + ai * HALF + m * 16; float s = 0.f;
#pragma unroll
                for (int bj = 0; bj < 2; ++bj) { float* p = xio + (size_t)row * 2048 + col0 + bj * HALF;
                    const f32x4 v0 = *(const f32x4*)p + acc[ai][bj][m][0], v1 = *(const f32x4*)(p + 4) + acc[ai][bj][m][1];
                    *(f32x4*)p = v0; *(f32x4*)(p + 4) = v1; s += dot4(v0) + dot4(v1); }
                s += __shfl_xor(s, 16); s += __shfl_xor(s, 32);
                if (fq == 0) unsafeAtomicAdd(ss + row, s); }
    }
};
template <class Epi, class Sched, bool ALIGN_EPI = false, bool SP2 = false>
__device__ __forceinline__ void gemm_phase(PG8_LAS unsigned char* lds, const Gemm g, const Sched& S, const Epi& E) {
    const int tid = threadIdx.x, wid = __builtin_amdgcn_readfirstlane(tid >> 6), lane = tid & 63, wr = wid >> 2, wc = wid & 3, fr = lane & 15, fq = lane >> 4;
    const int K = g.K, nt = K / BK;
    unsigned voffA[2], voffB[2];
#pragma unroll
    for (int i = 0; i < 2; ++i) { int R, C; stage_rc(tid * 16 + i * 8192, R, C); const int Rb = Epi::PERM ? ((R & ~31) + perm32(R & 31)) : R;
        voffA[i] = (unsigned)(R * K + C) * 2u; voffB[i] = (unsigned)(Rb * K + C) * 2u; }
    const size_t kstep = (size_t)(BK * 2);
    const size_t hstep = (size_t)HALF * K * 2;
    const size_t tstep = 2 * hstep;
    const unsigned ldsw = (unsigned)wid * 1024u;
    const int aoff = lds_byte(wr * 64 + fr, fq * 8), boff = lds_byte(wc * 32 + fr, fq * 8);
#define PG8_SA(b, h) (((b) * 2 + (h)) * HTB)
#define PG8_SB(b, h) ((4 + (b) * 2 + (h)) * HTB)
#define PG8_STAGE(bufoff, gbase, voff) do { _Pragma("unroll") for (int _i = 0; _i < 2; ++_i) \
        __builtin_amdgcn_global_load_lds((const unsigned*)((const char*)(gbase) + (voff)[_i]), (PG8_LAS unsigned*)(lds + (bufoff) + ldsw + _i * 8192), 16, 0, 0); } while (0)
#define PG8_LDA(dst, b, h) do { _Pragma("unroll") for (int m = 0; m < 4; ++m) _Pragma("unroll") for (int k = 0; k < 2; ++k) dst[m][k] = *(const PG8_LAS bf16x8*)(lds + PG8_SA(b, h) + aoff + m * 2048 + k * 1024); } while (0)
#define PG8_LDB(dst, b, h) do { _Pragma("unroll") for (int n = 0; n < 2; ++n) _Pragma("unroll") for (int k = 0; k < 2; ++k) dst[n][k] = *(const PG8_LAS bf16x8*)(lds + PG8_SB(b, h) + boff + n * 2048 + k * 1024); } while (0)
#define PG8_MMA(ai, bj, At, Bt) do { __builtin_amdgcn_s_setprio(1); _Pragma("unroll") for (int m = 0; m < 4; ++m) _Pragma("unroll") for (int n = 0; n < 2; ++n) _Pragma("unroll") for (int k = 0; k < 2; ++k) \
        acc[ai][bj][m][n] = __builtin_amdgcn_mfma_f32_16x16x32_bf16(Bt[n][k], At[m][k], acc[ai][bj][m][n], 0, 0, 0); __builtin_amdgcn_s_setprio(0); } while (0)
#define PG8_WAIT_V(n) asm volatile("s_waitcnt vmcnt(" #n ")" ::: "memory")
#define PG8_WAIT_L(n) asm volatile("s_waitcnt lgkmcnt(" #n ")" ::: "memory")
#define PG8_BAR __builtin_amdgcn_s_barrier()
#define PG8_SCHED __builtin_amdgcn_sched_barrier(0)
    Unit cur, nxt; int ui = 0;
    if (!S.next(0, cur)) return;
    f32x4 acc[2][2][4][2];
#pragma unroll
    for (int a = 0; a < 2; ++a)
#pragma unroll
        for (int b = 0; b < 2; ++b)
#pragma unroll
            for (int m = 0; m < 4; ++m)
#pragma unroll
                for (int n = 0; n < 2; ++n) acc[a][b][m][n] = (f32x4){0.f, 0.f, 0.f, 0.f};
    bf16x8 At[4][2], B0[2][2], B1[2][2];
    const char* cA = (const char*)g.A + (size_t)cur.pm * tstep; const char* cB = (const char*)g.Bt + (size_t)cur.pn * tstep;
    S.a_ready(cur);
    if constexpr (SP2) {
        PG8_STAGE(PG8_SB(0, 0), cB, voffB); PG8_STAGE(PG8_SB(0, 1), cB + hstep, voffB); PG8_STAGE(PG8_SA(0, 0), cA, voffA); PG8_STAGE(PG8_SA(0, 1), cA + hstep, voffA);
        if (wr == 1) PG8_BAR;
        PG8_WAIT_V(2); PG8_BAR;
        PG8_STAGE(PG8_SB(1, 0), cB + kstep, voffB); PG8_STAGE(PG8_SA(1, 0), cA + kstep, voffA); PG8_STAGE(PG8_SB(1, 1), cB + hstep + kstep, voffB);
        PG8_WAIT_V(6); PG8_BAR;
    } else {
        PG8_STAGE(PG8_SB(0, 0), cB, voffB); PG8_STAGE(PG8_SA(0, 0), cA, voffA); PG8_STAGE(PG8_SB(0, 1), cB + hstep, voffB); PG8_STAGE(PG8_SA(0, 1), cA + hstep, voffA);
        if (wr == 1) PG8_BAR;
        PG8_WAIT_V(4); PG8_BAR;
        PG8_STAGE(PG8_SB(1, 0), cB + kstep, voffB); PG8_STAGE(PG8_SA(1, 0), cA + kstep, voffA); PG8_STAGE(PG8_SB(1, 1), cB + hstep + kstep, voffB);
        PG8_WAIT_V(6); PG8_BAR;
    }
    for (;;) {
        const bool has_next = S.next(ui + 1, nxt);
        const char* nA = has_next ? (const char*)g.A + (size_t)nxt.pm * tstep : cA; const char* nB = has_next ? (const char*)g.Bt + (size_t)nxt.pn * tstep : cB;
        for (int t = 0; t < nt; t += 2) {
            const bool last = (t == nt - 2);
            const char* a1 = cA + (size_t)(t + 1) * kstep;
            const char* a2 = last ? nA : cA + (size_t)(t + 2) * kstep; const char* b2 = last ? nB : cB + (size_t)(t + 2) * kstep;
            const char* a3 = a2 + kstep; const char* b3 = b2 + kstep;
            if (last && has_next) S.a_ready(nxt);
            if constexpr (SP2) {
            PG8_LDB(B0, 0, 0); PG8_LDB(B1, 0, 1); PG8_SCHED; PG8_LDA(At, 0, 0); PG8_STAGE(PG8_SA(1, 1), a1 + hstep, voffA);
            PG8_WAIT_V(8); PG8_WAIT_L(0); PG8_BAR; PG8_MMA(0, 0, At, B0); PG8_MMA(0, 1, At, B1); PG8_BAR; PG8_SCHED;
            PG8_LDA(At, 0, 1); PG8_STAGE(PG8_SB(0, 0), b2, voffB); PG8_STAGE(PG8_SB(0, 1), b2 + hstep, voffB); PG8_STAGE(PG8_SA(0, 0), a2, voffA);
            PG8_WAIT_V(8); PG8_WAIT_L(0); PG8_BAR; PG8_MMA(1, 0, At, B0); PG8_MMA(1, 1, At, B1); PG8_BAR; PG8_SCHED;
            PG8_LDB(B0, 1, 0); PG8_LDB(B1, 1, 1); PG8_SCHED; PG8_LDA(At, 1, 0); PG8_STAGE(PG8_SA(0, 1), a2 + hstep, voffA);
            PG8_WAIT_V(8); PG8_WAIT_L(0); PG8_BAR; PG8_MMA(0, 0, At, B0); PG8_MMA(0, 1, At, B1); PG8_BAR; PG8_SCHED;
            PG8_LDA(At, 1, 1); PG8_STAGE(PG8_SB(1, 0), b3, voffB); PG8_STAGE(PG8_SB(1, 1), b3 + hstep, voffB); PG8_STAGE(PG8_SA(1, 0), a3, voffA);
            PG8_WAIT_V(8); PG8_WAIT_L(0); PG8_BAR; PG8_MMA(1, 0, At, B0); PG8_MMA(1, 1, At, B1); PG8_BAR; PG8_SCHED;
            } else {
            PG8_LDB(B0, 0, 0); PG8_SCHED; PG8_LDA(At, 0, 0); PG8_STAGE(PG8_SA(1, 1), a1 + hstep, voffA);
            PG8_WAIT_L(8); PG8_BAR; PG8_WAIT_L(0); PG8_MMA(0, 0, At, B0); PG8_BAR; PG8_SCHED;
            PG8_LDB(B1, 0, 1); PG8_STAGE(PG8_SB(0, 0), b2, voffB);
            PG8_BAR; PG8_WAIT_L(0); PG8_MMA(0, 1, At, B1); PG8_BAR;
            PG8_LDA(At, 0, 1); PG8_STAGE(PG8_SA(0, 0), a2, voffA);
            PG8_BAR; PG8_WAIT_L(0); PG8_MMA(1, 0, At, B0); PG8_BAR; PG8_SCHED;
            PG8_STAGE(PG8_SB(0, 1), b2 + hstep, voffB);
            PG8_WAIT_V(6); PG8_BAR; PG8_MMA(1, 1, At, B1); PG8_BAR;
            PG8_LDB(B0, 1, 0); PG8_SCHED; PG8_LDA(At, 1, 0); PG8_STAGE(PG8_SA(0, 1), a2 + hstep, voffA);
            PG8_WAIT_L(8); PG8_BAR; PG8_WAIT_L(0); PG8_MMA(0, 0, At, B0); PG8_BAR; PG8_SCHED;
            PG8_LDB(B1, 1, 1); PG8_STAGE(PG8_SB(1, 0), b3, voffB);
            PG8_BAR; PG8_WAIT_L(0); PG8_MMA(0, 1, At, B1); PG8_BAR;
            PG8_LDA(At, 1, 1); PG8_STAGE(PG8_SA(1, 0), a3, voffA);
            PG8_BAR; PG8_WAIT_L(0); PG8_MMA(1, 0, At, B0); PG8_BAR; PG8_SCHED;
            PG8_STAGE(PG8_SB(1, 1), b3 + hstep, voffB);
            PG8_WAIT_V(6); PG8_BAR; PG8_MMA(1, 1, At, B1); PG8_BAR;
            }
        }
        if constexpr (ALIGN_EPI) { if (wr == 0) PG8_BAR; }
        if constexpr (!Epi::AFTER_DRAIN) { E(acc, cur, wr, wc, fr, fq); S.done(cur); }
        if (!has_next) break;
#pragma unroll
        for (int a = 0; a < 2; ++a)
#pragma unroll
            for (int b = 0; b < 2; ++b)
#pragma unroll
                for (int m = 0; m < 4; ++m)
#pragma unroll
                    for (int n = 0; n < 2; ++n) acc[a][b][m][n] = (f32x4){0.f, 0.f, 0.f, 0.f};
        cur = nxt; cA = nA; cB = nB; ++ui;
        if constexpr (ALIGN_EPI) { if (wr == 1) PG8_BAR; }
    }
    PG8_WAIT_V(0);
    if constexpr (!ALIGN_EPI) { if (wr == 0) PG8_BAR; }
    PG8_BAR;
    if constexpr (Epi::AFTER_DRAIN) { E.fused(acc, cur, wr, wc, fr, fq, lds, wid, lane); S.done(cur); }
#undef PG8_SA
#undef PG8_SB
#undef PG8_STAGE
#undef PG8_LDA
#undef PG8_LDB
#undef PG8_MMA
#undef PG8_WAIT_V
#undef PG8_WAIT_L
#undef PG8_BAR
#undef PG8_SCHED
}
}
#define GAS __attribute__((address_space(1)))
#define LAS __attribute__((address_space(3)))
typedef unsigned short bf16;
typedef unsigned v4u __attribute__((ext_vector_type(4)));
typedef float f32x4 __attribute__((ext_vector_type(4)));
typedef short bf16x8 __attribute__((ext_vector_type(8)));
typedef GAS unsigned gu32;
typedef GAS unsigned long long gu64;
#define RLX_AGENT __ATOMIC_RELAXED, __HIP_MEMORY_SCOPE_AGENT
#define LDS_WAIT() asm volatile("s_waitcnt lgkmcnt(0)" ::: "memory")
#define VM_WAIT() asm volatile("s_waitcnt vmcnt(0)" ::: "memory")
__device__ __forceinline__ unsigned long long rt() { return __builtin_amdgcn_s_memrealtime(); }
__device__ __forceinline__ unsigned f2bf(float f) { unsigned u = __builtin_bit_cast(unsigned, f); return (u + 0x7fffu + ((u >> 16) & 1u)) >> 16; }
__device__ __forceinline__ unsigned pk2(float lo, float hi) { return f2bf(lo) | (f2bf(hi) << 16); }

#define XB_TMO      128
#define XB_XCNT(j)  (256  + 64 * (j))
#define XB_XSUB(j)  (1280 + 64 * (j))
#define XB_XGEN(j)  (2304 + 64 * (j))
#define XB_TOP      3328
#define XB_TOPGEN   3392
#define XCD_BAR_WORDS 3456
#define XB_SPIN_CAP (1u << 18)

__device__ __forceinline__ unsigned xb_ld(unsigned* p)              { return __hip_atomic_load(p, __ATOMIC_RELAXED, __HIP_MEMORY_SCOPE_AGENT); }
__device__ __forceinline__ unsigned xb_add(unsigned* p, unsigned v) { return __hip_atomic_fetch_add(p, v, __ATOMIC_RELAXED, __HIP_MEMORY_SCOPE_AGENT); }
__device__ __forceinline__ unsigned xb_xcc_id() { return (unsigned)__builtin_amdgcn_s_getreg((3 << 11) | 20) & 0xFu; }
#define XB_SPIN(cond, bar) do { unsigned _sp = 0; while (cond) { __builtin_amdgcn_s_sleep(1); \
    if ((++_sp & 255u) == 0u) { if (xb_ld(&(bar)[XB_TMO])) break; if (_sp > XB_SPIN_CAP) { atomicAdd(&(bar)[XB_TMO], 1u); break; } } } } while (0)

struct XcdBarrier {
    unsigned* bar; unsigned x;
    volatile LAS unsigned* st;
};

__device__ __forceinline__ XcdBarrier xcd_barrier_post(unsigned* bar, volatile LAS unsigned* st) {
    XcdBarrier b; b.bar = bar; b.x = xb_xcc_id(); b.st = st;
    if (threadIdx.x == 0) (void)xb_add(&bar[XB_XCNT(b.x)], 1u);
    return b;
}
__device__ __forceinline__ void xcd_barrier_complete(unsigned* bar, unsigned x, unsigned& nloc, unsigned& nx) {
    const unsigned G = gridDim.x * gridDim.y * gridDim.z;
    unsigned sum, cnt, mine, sp = 0u;
    for (;;) {
        sum = 0u; cnt = 0u; mine = 0u;
#pragma unroll
        for (unsigned j = 0; j < 16; ++j) { const unsigned c = xb_ld(&bar[XB_XCNT(j)]); sum += c; cnt += (c > 0u) ? 1u : 0u; mine = (j == x) ? c : mine; }
        if (sum == G) break;
        __builtin_amdgcn_s_sleep(1);
        if ((++sp & 255u) == 0u) { if (xb_ld(&bar[XB_TMO])) break; if (sp > XB_SPIN_CAP) { atomicAdd(&bar[XB_TMO], 1u); break; } }
    }
    nloc = mine > 0u ? mine : 1u; nx = cnt > 0u ? cnt : 1u;
}

__device__ __forceinline__ void xcd_barrier(const XcdBarrier& b) {
    asm volatile("s_waitcnt vmcnt(0)" ::: "memory");
    __syncthreads();
    if (threadIdx.x == 0) {
        unsigned* bar = b.bar;
        __builtin_amdgcn_s_waitcnt(0);
        unsigned nloc = b.st[0], nx = b.st[1];
        if (nloc == 0u) { xcd_barrier_complete(bar, b.x, nloc, nx); b.st[0] = nloc; b.st[1] = nx; }
        const unsigned old = xb_add(&bar[XB_XSUB(b.x)], 1u);
        const unsigned gen = old / nloc;
        if (old + 1u == (gen + 1u) * nloc) {
            __builtin_amdgcn_fence(__ATOMIC_RELEASE, "agent");
            asm volatile("s_waitcnt vmcnt(0)" ::: "memory");
            const unsigned og = xb_add(&bar[XB_TOP], 1u);
            const unsigned tg = og / nx;
            if (og + 1u == (tg + 1u) * nx) xb_add(&bar[XB_TOPGEN], 1u);
            else XB_SPIN(xb_ld(&bar[XB_TOPGEN]) == tg, bar);
            __builtin_amdgcn_fence(__ATOMIC_ACQUIRE, "agent");
            xb_add(&bar[XB_XGEN(b.x)], 1u);
            asm volatile("s_waitcnt vmcnt(0)" ::: "memory");
        } else {
            XB_SPIN(xb_ld(&bar[XB_XGEN(b.x)]) == gen, bar);
            __builtin_amdgcn_fence(__ATOMIC_ACQUIRE, "agent");
            asm volatile("s_waitcnt vmcnt(0)" ::: "memory");
        }
    }
    __syncthreads();
}
namespace fox {
constexpr int D = 128;
constexpr float SCALE = 0.08838834764831845f, LOG2E = 1.4426950408889634f;
constexpr float THR = 8.f;
constexpr int NW = 8, QBLK = 32, KVBLK = 64, QB = NW * QBLK;
constexpr int SHM_V = KVBLK * D * 2, SHM_K = KVBLK * D * 2;
constexpr int CB_OFF = 2 * SHM_V + 2 * SHM_K, WS_OFF = CB_OFF + 512;
constexpr int LDS_BYTES = WS_OFF + NW * 64 * 4;
constexpr unsigned WINF = 0x7fffffffu;
constexpr int LDO = 3072;

typedef unsigned short bf16;
typedef short bf16x8 __attribute__((ext_vector_type(8)));
typedef short s16x4 __attribute__((ext_vector_type(4)));
typedef float f32x16 __attribute__((ext_vector_type(16)));
typedef float f32x4 __attribute__((ext_vector_type(4)));
typedef unsigned u32x4 __attribute__((ext_vector_type(4)));

#define KSWZ(row, colB) ((row) * 256 + ((colB) ^ (((row) & 7) << 4)))
#define SBAR() __builtin_amdgcn_sched_barrier(0)
__device__ __forceinline__ int v_st(int k, int c) { const int kk = (k & ~0xC) | ((k & 4) << 1) | ((k & 8) >> 1); return ((kk >> 3) * 4 + (c >> 5)) * 512 + ((kk & 7) * 32 + (c & 31)) * 2; }
__device__ __forceinline__ int v_rd_base(int lane) { return ((lane & 3) << 3) | (((lane >> 2) & 3) << 6) | (((lane >> 4) & 1) << 5) | (((lane >> 5) & 1) << 8); }
constexpr int v_rd_off(int d0, int ks, int half) { return d0 * 512 + ks * 4096 + half * 2048; }
__device__ __forceinline__ int crow(int r, int hi) { return (r & 3) + 8 * (r >> 2) + 4 * hi; }
__device__ __forceinline__ unsigned cvtpk(float lo, float hi) { unsigned r; asm volatile("v_cvt_pk_bf16_f32 %0, %1, %2" : "=v"(r) : "v"(lo), "v"(hi)); return r; }
__device__ __forceinline__ bf16x8 load8(const bf16* p) { return *reinterpret_cast<const bf16x8*>(p); }
__device__ __forceinline__ void mask_tile(f32x16& p0, f32x16& p1, int dq, unsigned W) {
    const float NEG = -__builtin_inff();
#pragma unroll
    for (int r = 0; r < 16; ++r) {
        const int c = (r & 3) + 8 * (r >> 2);
        if ((unsigned)(dq - c) >= W) p0[r] = NEG;
        if ((unsigned)(dq - c - 32) >= W) p1[r] = NEG;
    }
}
__device__ __forceinline__ void partialSM(f32x16& p0, f32x16& p1, float& m_reg, float& mn, float& alpha) {
    float pmax = p0[0]; for (int r = 1; r < 16; ++r) pmax = fmaxf(pmax, p0[r]); for (int r = 0; r < 16; ++r) pmax = fmaxf(pmax, p1[r]);
    { auto rr = __builtin_amdgcn_permlane32_swap(__float_as_uint(pmax), __float_as_uint(pmax), false, false);
      pmax = fmaxf(__uint_as_float(rr[0]), __uint_as_float(rr[1])); }
    constexpr float C2 = LOG2E * SCALE;
    if (__builtin_expect(__all((pmax - m_reg) * SCALE <= THR), 1)) { mn = m_reg; alpha = 1.f; }
    else { mn = fmaxf(m_reg, pmax); alpha = __builtin_amdgcn_exp2f((m_reg - mn) * C2); m_reg = mn; }
    const float mnL = -mn * C2;
    for (int r = 0; r < 16; ++r) p0[r] = fmaf(p0[r], C2, mnL); for (int r = 0; r < 16; ++r) p1[r] = fmaf(p1[r], C2, mnL);
    for (int r = 0; r < 16; ++r) p0[r] = __builtin_amdgcn_exp2f(p0[r]);
}
__device__ __forceinline__ void finishSM(f32x16& p0, f32x16& p1, float alpha, float& l_reg, bf16x8& pa0, bf16x8& pa1, bf16x8& pa2, bf16x8& pa3) {
    for (int r = 0; r < 16; ++r) p1[r] = __builtin_amdgcn_exp2f(p1[r]);
    float ps = 0; for (int r = 0; r < 16; ++r) ps += p0[r]; for (int r = 0; r < 16; ++r) ps += p1[r];
    { auto rr = __builtin_amdgcn_permlane32_swap(__float_as_uint(ps), __float_as_uint(ps), false, false);
      ps = __uint_as_float(rr[0]) + __uint_as_float(rr[1]); }
    l_reg = l_reg * alpha + ps;
#define PK4(P, B_, OUT) do { unsigned a0 = cvtpk(P[B_+0], P[B_+1]), a1 = cvtpk(P[B_+2], P[B_+3]);                          \
        unsigned b0 = cvtpk(P[B_+4], P[B_+5]), b1 = cvtpk(P[B_+6], P[B_+7]);                                             \
        auto r0 = __builtin_amdgcn_permlane32_swap(a0, b0, false, false); auto r1 = __builtin_amdgcn_permlane32_swap(a1, b1, false, false); \
        u32x4 w = {r0[0], r1[0], r0[1], r1[1]}; OUT = *reinterpret_cast<bf16x8*>(&w); } while (0)
    PK4(p0, 0, pa0); PK4(p0, 8, pa1); PK4(p1, 0, pa2); PK4(p1, 8, pa3);
#undef PK4
}
template <int KB>
__device__ __forceinline__ void qkt(f32x16& p0, f32x16& p1, const char* K_lds, const float* cb, int r32, int hi, const bf16x8* qr) {
#pragma unroll
    for (int g = 0; g < 4; ++g) { const f32x4 b0 = *(const f32x4*)(cb + 8 * g + 4 * hi), b1 = *(const f32x4*)(cb + 32 + 8 * g + 4 * hi);
#pragma unroll
        for (int j = 0; j < 4; ++j) { p0[4 * g + j] = b0[j]; p1[4 * g + j] = b1[j]; } }
    const char* kb[4];
#pragma unroll
    for (int dd = 0; dd < 4; ++dd) kb[dd] = K_lds + KB * SHM_K + KSWZ(r32, (dd * 16 + hi * 8) * 2);
#pragma unroll
    for (int d0 = 0; d0 < 8; ++d0) { const char* a = kb[d0 & 3] + (d0 >> 2) * 128;
        bf16x8 b0 = *reinterpret_cast<const bf16x8*>(a);
        bf16x8 b1 = *reinterpret_cast<const bf16x8*>(a + 32 * 256);
        p0 = __builtin_amdgcn_mfma_f32_32x32x16_bf16(b0, qr[d0], p0, 0, 0, 0);
        p1 = __builtin_amdgcn_mfma_f32_32x32x16_bf16(b1, qr[d0], p1, 0, 0, 0); }
}
template <int VB>
__device__ __forceinline__ void pv_tile(f32x16* o, int vb0, bf16x8 pa0, bf16x8 pa1, bf16x8 pa2, bf16x8 pa3) {
#define TRRD(dst, off) asm volatile("ds_read_b64_tr_b16 %0, %1 offset:%2" : "=&v"(dst) : "v"(vb0), "i"(off) : "memory")
#define PV_D0(d0) do { s16x4 l0, l1, l2, l3, h0, h1, h2, h3; constexpr int b_ = VB * SHM_V + v_rd_off(d0, 0, 0);     \
        TRRD(l0, b_); TRRD(h0, b_ + 2048); TRRD(l1, b_ + 4096); TRRD(h1, b_ + 6144); TRRD(l2, b_ + 8192); TRRD(h2, b_ + 10240); TRRD(l3, b_ + 12288); TRRD(h3, b_ + 14336); \
        asm volatile("s_waitcnt lgkmcnt(0)" ::: "memory"); SBAR();             \
        o[d0] = __builtin_amdgcn_mfma_f32_32x32x16_bf16(pa0, (bf16x8){l0[0], l0[1], l0[2], l0[3], h0[0], h0[1], h0[2], h0[3]}, o[d0], 0, 0, 0);   \
        o[d0] = __builtin_amdgcn_mfma_f32_32x32x16_bf16(pa1, (bf16x8){l1[0], l1[1], l1[2], l1[3], h1[0], h1[1], h1[2], h1[3]}, o[d0], 0, 0, 0);   \
        o[d0] = __builtin_amdgcn_mfma_f32_32x32x16_bf16(pa2, (bf16x8){l2[0], l2[1], l2[2], l2[3], h2[0], h2[1], h2[2], h2[3]}, o[d0], 0, 0, 0);   \
        o[d0] = __builtin_amdgcn_mfma_f32_32x32x16_bf16(pa3, (bf16x8){l3[0], l3[1], l3[2], l3[3], h3[0], h3[1], h3[2], h3[3]}, o[d0], 0, 0, 0); } while (0)
    PV_D0(0); PV_D0(1); PV_D0(2); PV_D0(3);
#undef PV_D0
#undef TRRD
}

struct BlockRef { const bf16* Q; const bf16* K; const bf16* V; bf16* O; const float* C; float cref; int P0, jlo, ldo; };
struct Seam { bf16x8 qr[8]; bf16x8 st_v0, st_v1, st_k0, st_k1; float st_c; };
#define ROW(p, k0, rr) ((const bf16*)((const char*)(p) + (unsigned)((((k0) + (rr)) * D + sc) * 2)))
#define VMW() asm volatile("s_waitcnt vmcnt(0)" ::: "memory")
#define VMWN(n) asm volatile("s_waitcnt vmcnt(%0)" :: "i"(n) : "memory")
#define SLOAD_H(Kp, Vp, Cp, k0) do { S.st_v0 = load8(ROW(Vp, k0, sr)); S.st_v1 = load8(ROW(Vp, k0, 32 + sr));              \
                         S.st_k0 = load8(ROW(Kp, k0, sr)); S.st_k1 = load8(ROW(Kp, k0, 32 + sr));                          \
                         if (tid < 64) S.st_c = *(const float*)((const char*)(Cp) + (unsigned)(((k0) + tid) * 4)); } while (0)
#define SWRITE_HK(bf, cref_) do { *(bf16x8*)(K_lds + (bf) * SHM_K + kws) = S.st_k0; *(bf16x8*)(K_lds + (bf) * SHM_K + kws + 32 * 256) = S.st_k1; \
                         if (tid < 64) *(float*)(C_lds + (bf) * 256 + tid * 4) = ((cref_) - S.st_c) * (1.0f / SCALE); } while (0)
#define SWRITE_HV(bf) do { *(bf16x8*)(V_lds + (bf) * SHM_V + vst0) = S.st_v0; *(bf16x8*)(V_lds + (bf) * SHM_V + vst1) = S.st_v1; } while (0)
#define SWRITE_H(bf, cref_) do { SWRITE_HV(bf); SWRITE_HK(bf, cref_); } while (0)
__device__ __forceinline__ void fox_prime(const BlockRef& cur, char* lds, Seam& S) {
    const int tid = threadIdx.x, wid = __builtin_amdgcn_readfirstlane(tid >> 6), lane = tid & 63, r32 = lane & 31, hi = lane >> 5;
    const int sr = tid >> 4, sc = (tid & 15) * 8, kws = KSWZ(sr, sc * 2); char* K_lds = lds + 2 * SHM_V; char* C_lds = lds + CB_OFF;
    const int kb0 = cur.jlo * KVBLK;
    for (int d0 = 0; d0 < 8; ++d0) S.qr[d0] = load8((const bf16*)((const char*)cur.Q + (unsigned)(((wid * QBLK + r32) * D + d0 * 16 + hi * 8) * 2)));
    SLOAD_H(cur.K, cur.V, cur.C, kb0); VMW(); SWRITE_HK(0, cur.cref);
    __syncthreads();
}
__device__ __forceinline__ void fox_block(const BlockRef& cur, const BlockRef& nxt, int skv, char* lds, Seam& S) {
    const int tid = threadIdx.x, wid = __builtin_amdgcn_readfirstlane(tid >> 6), lane = tid & 63, r32 = lane & 31, hi = lane >> 5;
    const int j_lo = cur.jlo;
    int j_hi = (cur.P0 + QB - 1) / KVBLK + 1; if (j_hi > skv / KVBLK) j_hi = skv / KVBLK;
    const int NT = j_hi - j_lo;
    const int kbn = nxt.jlo * KVBLK;
    const int qlo = cur.P0 + wid * QBLK, qm = qlo + r32 - 4 * hi;
    char* V_lds = lds; char* K_lds = lds + 2 * SHM_V; char* C_lds = lds + CB_OFF;
    float* ws = (float*)(lds + WS_OFF) + wid * 64; float* li_l = ws, * al_l = ws + 32;
    float m_reg = -1e30f, l_reg = 0; f32x16 o[4] = {};
    const int sr = tid >> 4, sc = (tid & 15) * 8, vst0 = v_st(sr, sc), vst1 = v_st(32 + sr, sc), kws = KSWZ(sr, sc * 2);
    const int vb0 = (int)(uintptr_t)V_lds + v_rd_base(lane);
    const bf16* Kh = cur.K; const bf16* Vh = cur.V; const float* Ch = cur.C; const float cref = cur.cref;
#define CBT(bf) ((const float*)(C_lds + (bf) * 256))
#define RESC(a) do { if (__any((a) < 1.f)) { if (hi == 0) al_l[r32] = (a); asm volatile("s_waitcnt lgkmcnt(0)" ::: "memory");              \
                     for (int d_ = 0; d_ < 4; ++d_) for (int r = 0; r < 16; ++r) o[d_][r] *= al_l[crow(r, hi)]; } } while (0)
#define KBASE(t) ((j_lo + (t)) * KVBLK)
#define MASKT(P0_, P1_, t) do { const int kb_ = KBASE(t); if (kb_ + KVBLK - 1 > qlo) mask_tile(P0_, P1_, qm - kb_, WINF); } while (0)
    constexpr int NQL = 8;
#define SEAM_K0() do { VMWN(NQL); SWRITE_HK(0, nxt.cref); SBAR(); } while (0)
    f32x16 pA0, pA1, pB0, pB1; float mnA, mnB, alA, alB; bf16x8 pa0, pa1, pa2, pa3;
    SWRITE_HV(0); SBAR();
    if (NT > 1) { SLOAD_H(Kh, Vh, Ch, KBASE(1)); }
    SBAR(); qkt<0>(pA0, pA1, K_lds, CBT(0), r32, hi, S.qr);
    MASKT(pA0, pA1, 0); partialSM(pA0, pA1, m_reg, mnA, alA);
    if (NT > 1) { VMW(); SWRITE_H(1, cref); }
    __syncthreads();
#define HALF_STEP(PX0, PX1, mnX, alX, PY0, PY1, alY, t, KB, VB, SB) do {                                                      \
        SBAR(); qkt<KB>(PX0, PX1, K_lds, CBT(KB), r32, hi, S.qr);                                                                     \
        finishSM(PY0, PY1, alY, l_reg, pa0, pa1, pa2, pa3); SBAR();                                                           \
        if ((t) + 1 < NT) { SLOAD_H(Kh, Vh, Ch, KBASE((t) + 1)); SBAR(); }                                                    \
        pv_tile<VB>(o, vb0, pa0, pa1, pa2, pa3); MASKT(PX0, PX1, (t)); partialSM(PX0, PX1, m_reg, mnX, alX);    \
        __syncthreads();                                                                                                      \
        if ((t) + 1 < NT) { VMW(); SWRITE_H(SB, cref); }                                                                      \
        RESC(alX); __syncthreads(); } while (0)
    for (int t = 1; t + 1 < NT; t += 2) {
        HALF_STEP(pB0, pB1, mnB, alB, pA0, pA1, alA, t, 1, 0, 0);
        HALF_STEP(pA0, pA1, mnA, alA, pB0, pB1, alB, t + 1, 0, 1, 1);
    }
    const bool even = (NT & 1) == 0;
    if (even) { SBAR(); qkt<1>(pB0, pB1, K_lds, CBT(1), r32, hi, S.qr); SBAR(); }
    SLOAD_H(nxt.K, nxt.V, nxt.C, kbn); SBAR();
#pragma unroll
    for (int d0 = 0; d0 < 8; ++d0) S.qr[d0] = load8((const bf16*)((const char*)nxt.Q + (unsigned)(((wid * QBLK + r32) * D + d0 * 16 + hi * 8) * 2)));
    SBAR();
    finishSM(pA0, pA1, alA, l_reg, pa0, pa1, pa2, pa3); SBAR();
    pv_tile<0>(o, vb0, pa0, pa1, pa2, pa3);
    if (even) { MASKT(pB0, pB1, NT - 1); partialSM(pB0, pB1, m_reg, mnB, alB); __syncthreads(); RESC(alB);
        finishSM(pB0, pB1, alB, l_reg, pa0, pa1, pa2, pa3); SBAR(); pv_tile<1>(o, vb0, pa0, pa1, pa2, pa3); }
    SBAR(); SEAM_K0();
    if (hi == 0) li_l[r32] = l_reg; asm volatile("s_waitcnt lgkmcnt(0)" ::: "memory");
    float rli[16];
#pragma unroll
    for (int r = 0; r < 16; ++r) rli[r] = __builtin_amdgcn_rcpf(li_l[crow(r, hi)]);
    unsigned ob = (unsigned)(((wid * QBLK + 4 * hi) * LDO + r32) * 2);
    asm volatile("" : "+v"(ob));
#pragma unroll
    for (int r = 0; r < 16; ++r) { const int orow = (r & 3) + 8 * (r >> 2);
#pragma unroll
        for (int d0 = 0; d0 < 4; ++d0) { const float v = o[d0][r] * rli[r];
            const float vn = __shfl_xor(v, 1);
            if ((r32 & 1) == 0) *(unsigned*)((char*)cur.O + (ob + (unsigned)((orow * LDO + d0 * 32) * 2))) = cvtpk(v, vn); } }
    __syncthreads();
#undef CBT
#undef RESC
#undef KBASE
#undef MASKT
#undef SEAM_K0
#undef HALF_STEP
}
#undef ROW
#undef VMW
#undef VMWN
#undef SLOAD_H
#undef SWRITE_HK
#undef SWRITE_HV
#undef SWRITE_H
#undef KSWZ
#undef SBAR
}
namespace dsa {
constexpr int L = 16384, NQ = 16, CAP = 512, KSEL = 256;
constexpr float LOG2E = 1.4426950408889634f, SCALE = 0.08838834764831845f;
constexpr int CS_OFF = 0;
constexpr int CI_OFF = 32768;
constexpr int KS_OFF = 49152, KS_BUF = 128 * 144;
constexpr int HI_OFF = KS_OFF + 2 * KS_BUF;
constexpr int SEL_OFF = 131072;
constexpr int NV_OFF = SEL_OFF + 8192;
constexpr int TB_OFF = NV_OFF + 64;
constexpr int LUT_OFF = TB_OFF + 1024;
constexpr int END_OFF = LUT_OFF + 128;

typedef short bf16x8 __attribute__((ext_vector_type(8)));
typedef short s16x4 __attribute__((ext_vector_type(4)));
typedef float f32x16 __attribute__((ext_vector_type(16)));
typedef float f32x4 __attribute__((ext_vector_type(4)));
typedef unsigned u32x4 __attribute__((ext_vector_type(4)));
typedef unsigned u32x2 __attribute__((ext_vector_type(2)));

struct Tensors { const bf16* aiq; const float* small; const bf16* kidx; const bf16* ckv; const bf16* qlat; bf16* mix; };

__device__ __forceinline__ unsigned ord_key(float f) { const unsigned u = __float_as_uint(f); return (u & 0x80000000u) ? ~u : (u | 0x80000000u); }
__device__ __forceinline__ float unord_key(unsigned k) { return __uint_as_float((k & 0x80000000u) ? (k & 0x7fffffffu) : ~k); }
__device__ __forceinline__ unsigned lanemask_lt_pop(unsigned long long m, int lane) { return (unsigned)__popcll(m & ((1ull << lane) - 1ull)); }

__device__ __forceinline__ float compact_topk(LAS float* cs, LAS unsigned short* ci, LAS unsigned* hist, int n, int lane) {
    unsigned key[8]; unsigned idx[8];
#pragma unroll
    for (int i = 0; i < 8; ++i) { const int e = lane + 64 * i; const bool v = e < n; key[i] = v ? ord_key(cs[e]) : 0u; idx[i] = v ? (unsigned)ci[e] : 0u; }
    unsigned prefix = 0u, pmask = 0u; unsigned need = KSEL;
#pragma unroll 1
    for (int pass = 0; pass < 4; ++pass) {
        const int sh = 24 - 8 * pass;
        *(LAS u32x4*)(hist + 4 * lane) = (u32x4){0u, 0u, 0u, 0u};
        asm volatile("s_waitcnt lgkmcnt(0)" ::: "memory");
#pragma unroll
        for (int i = 0; i < 8; ++i) if (key[i] != 0u && (key[i] & pmask) == prefix) __hip_atomic_fetch_add(hist + ((key[i] >> sh) & 255u), 1u, __ATOMIC_RELAXED, __HIP_MEMORY_SCOPE_WORKGROUP);
        asm volatile("s_waitcnt lgkmcnt(0)" ::: "memory");
        const u32x4 c = *(LAS u32x4*)(hist + 4 * lane);
        const unsigned s = c.x + c.y + c.z + c.w;
        unsigned incl = s;
#pragma unroll
        for (int off = 1; off < 64; off <<= 1) { const unsigned v = __shfl_down(incl, off); if (lane + off < 64) incl += v; }
        const unsigned excl = incl - s;
        const bool found = (excl < need) && (need <= incl);
        const unsigned long long fm = __ballot(found);
        const int fl = (int)__builtin_ctzll(fm);
        unsigned a = excl; int bin; unsigned nn;
        if (a + c.w >= need) { bin = 3; nn = need - a; } else { a += c.w;
            if (a + c.z >= need) { bin = 2; nn = need - a; } else { a += c.z;
                if (a + c.y >= need) { bin = 1; nn = need - a; } else { a += c.y; bin = 0; nn = need - a; } } }
        bin += 4 * lane;
        const unsigned binu = (unsigned)__builtin_amdgcn_readlane(bin, fl); need = (unsigned)__builtin_amdgcn_readlane((int)nn, fl);
        prefix |= binu << sh; pmask |= 0xffu << sh;
    }
    int base = 0; unsigned eqseen = 0u;
#pragma unroll
    for (int i = 0; i < 8; ++i) {
        const bool gt = key[i] > prefix, eq = key[i] == prefix;
        const unsigned long long meq = __ballot(eq);
        const bool keep = gt || (eq && (eqseen + lanemask_lt_pop(meq, lane)) < need);
        eqseen += (unsigned)__popcll(meq);
        const unsigned long long mk = __ballot(keep);
        const int pos = base + (int)lanemask_lt_pop(mk, lane);
        if (keep) { cs[pos] = unord_key(key[i]); ci[pos] = (unsigned short)idx[i]; }
        base += (int)__popcll(mk);
    }
    asm volatile("s_waitcnt lgkmcnt(0)" ::: "memory");
    return unord_key(prefix);
}

__device__ __forceinline__ void init_tables(LAS unsigned char* lds, const float* t5) {
    const int tid = threadIdx.x;
    if (tid < 256) ((LAS float*)(lds + TB_OFF))[tid] = t5[tid] * LOG2E;
    if (tid < 128) { int bk = tid; if (tid >= 16) { bk = 16 + (int)floorf(__log2f((float)tid * (1.0f / 16.0f)) * (16.0f / 3.0f)); bk = bk > 31 ? 31 : bk; } ((LAS unsigned char*)(lds + LUT_OFF))[tid] = (unsigned char)bk; }
}

__device__ __forceinline__ void unit(LAS unsigned char* lds, const Tensors& T, int b, int t0) {
    const int tid = threadIdx.x, wid = __builtin_amdgcn_readfirstlane(tid >> 6), lane = tid & 63, r32 = lane & 31, hi = lane >> 5;
    const size_t tokb = (size_t)b * L;
    {
        const int tq = t0 + 2 * wid + hi;
        const int aq = t0 + 2 * wid + ((r32 >> 2) & 1), ah = (r32 & 3) + 4 * (r32 >> 3);
        bf16x8 qa[4];
#pragma unroll
        for (int s = 0; s < 4; ++s) qa[s] = *(const bf16x8*)(T.aiq + (tokb + aq) * 1024 + ah * 64 + 16 * s + 8 * hi);
        float w[16];
#pragma unroll
        for (int q4 = 0; q4 < 4; ++q4) { const f32x4 v = *(const f32x4*)(T.small + (tokb + tq) * 128 + 64 + 4 * q4);
#pragma unroll
            for (int j = 0; j < 4; ++j) w[4 * q4 + j] = v[j] * (0.25f * 0.125f); }
        LAS float* csA = (LAS float*)(lds + CS_OFF) + (2 * wid) * CAP; LAS float* csB = csA + CAP;
        LAS unsigned short* ciA = (LAS unsigned short*)(lds + CI_OFF) + (2 * wid) * CAP; LAS unsigned short* ciB = ciA + CAP;
        LAS float* csM = hi ? csB : csA; LAS unsigned short* ciM = hi ? ciB : ciA;
        LAS unsigned* hist = (LAS unsigned*)(lds + HI_OFF) + wid * 256;
        int cntA = 0, cntB = 0; float tauA = -__builtin_inff(), tauB = -__builtin_inff();
        const int tmax = t0 + NQ - 1, nch = tmax / 128 + 1;
        const int pk0 = tid >> 3, pc = tid & 7;
        const bf16* ksrc = T.kidx + (tokb + pk0) * 64 + pc * 8;
        u32x4 st0 = *(const u32x4*)(ksrc), st1 = *(const u32x4*)(ksrc + 64 * 64);
        *(LAS u32x4*)(lds + KS_OFF + pk0 * 144 + pc * 16) = st0; *(LAS u32x4*)(lds + KS_OFF + (pk0 + 64) * 144 + pc * 16) = st1;
        __syncthreads();
#pragma unroll 1
        for (int ch = 0; ch < nch; ++ch) {
            const int buf = ch & 1;
            if (ch + 1 < nch) { st0 = *(const u32x4*)(ksrc + (size_t)(ch + 1) * 128 * 64); st1 = *(const u32x4*)(ksrc + (size_t)(ch + 1) * 128 * 64 + 64 * 64); }
#pragma unroll 1
            for (int tile = 0; tile < 4; ++tile) {
                const int kb = ch * 128 + tile * 32;
                if (kb > tmax) break;
                const LAS unsigned char* kp = lds + KS_OFF + buf * KS_BUF + (tile * 32 + r32) * 144 + hi * 16;
                f32x16 acc = {};
#pragma unroll
                for (int s = 0; s < 4; ++s) { const bf16x8 kf = *(const LAS bf16x8*)(kp + 32 * s); acc = __builtin_amdgcn_mfma_f32_32x32x16_bf16(qa[s], kf, acc, 0, 0, 0); }
                float sc = 0.f;
#pragma unroll
                for (int r = 0; r < 16; ++r) sc = fmaf(w[r], fmaxf(acc[r], 0.f), sc);
                const int key = kb + r32;
                const float tau = hi ? tauB : tauA;
                const bool pass = (key <= tq) && (sc > tau);
                const unsigned long long pm = __ballot(pass);
                const unsigned mlo = (unsigned)pm, mhi = (unsigned)(pm >> 32);
                const unsigned mine = hi ? mhi : mlo;
                const int pos = (hi ? cntB : cntA) + (int)__popc(mine & ((1u << r32) - 1u));
                if (pass) { csM[pos] = sc; ciM[pos] = (unsigned short)key; }
                cntA += (int)__popc(mlo); cntB += (int)__popc(mhi);
                if (cntA > CAP - 32) { asm volatile("s_waitcnt lgkmcnt(0)" ::: "memory"); tauA = compact_topk(csA, ciA, hist, cntA, lane); cntA = KSEL; }
                if (cntB > CAP - 32) { asm volatile("s_waitcnt lgkmcnt(0)" ::: "memory"); tauB = compact_topk(csB, ciB, hist, cntB, lane); cntB = KSEL; }
            }
            if (ch + 1 < nch) { *(LAS u32x4*)(lds + KS_OFF + (buf ^ 1) * KS_BUF + pk0 * 144 + pc * 16) = st0; *(LAS u32x4*)(lds + KS_OFF + (buf ^ 1) * KS_BUF + (pk0 + 64) * 144 + pc * 16) = st1; }
            __syncthreads();
        }
        asm volatile("s_waitcnt lgkmcnt(0)" ::: "memory");
        if (cntA > KSEL) { tauA = compact_topk(csA, ciA, hist, cntA, lane); cntA = KSEL; }
        if (cntB > KSEL) { tauB = compact_topk(csB, ciB, hist, cntB, lane); cntB = KSEL; }
        LAS unsigned short* selA = (LAS unsigned short*)(lds + SEL_OFF) + (2 * wid) * KSEL; LAS unsigned short* selB = selA + KSEL;
#pragma unroll
        for (int i = 0; i < 4; ++i) { const int e = lane + 64 * i; selA[e] = e < cntA ? ciA[e] : (unsigned short)0; selB[e] = e < cntB ? ciB[e] : (unsigned short)0; }
        if (lane == 0) { ((LAS int*)(lds + NV_OFF))[2 * wid] = cntA; ((LAS int*)(lds + NV_OFF))[2 * wid + 1] = cntB; }
    }
    __syncthreads();
    {
        LAS unsigned char* cbuf = lds + wid * 16384;
        const unsigned cbase = (unsigned)(size_t)cbuf;
        const int head = lane & 15, g = lane >> 4;
        const LAS float* tb = (const LAS float*)(lds + TB_OFF); const LAS unsigned char* lut = (const LAS unsigned char*)(lds + LUT_OFF);
        constexpr float C2 = SCALE * LOG2E;
#pragma unroll 1
        for (int qi = 0; qi < 2; ++qi) {
            const int qs = 2 * wid + qi, t = t0 + qs;
            const int nvalid = ((const LAS int*)(lds + NV_OFF))[qs];
            const LAS unsigned short* sel = (const LAS unsigned short*)(lds + SEL_OFF) + qs * KSEL;
            bf16x8 qf[8];
#pragma unroll
            for (int s = 0; s < 8; ++s) { qf[s] = (bf16x8){0, 0, 0, 0, 0, 0, 0, 0}; if (head < 8) qf[s] = *(const bf16x8*)(T.qlat + (tokb + t) * 2048 + head * 256 + 32 * s + 8 * g); }
            f32x4 o[16];
#pragma unroll
            for (int nb = 0; nb < 16; ++nb) o[nb] = (f32x4){0.f, 0.f, 0.f, 0.f};
            float m_run = -1e30f, l_run = 0.f;
#pragma unroll 1
            for (int ch = 0; ch < 8; ++ch) {
#pragma unroll
                for (int i = 0; i < 16; ++i) { const int kap = 2 * i + hi; const int key = (int)sel[ch * 32 + kap]; const int c = r32 ^ ((kap & 7) << 1);
                    __builtin_amdgcn_global_load_lds((const unsigned*)(T.ckv + (tokb + key) * 256 + c * 8), (LAS unsigned*)(cbuf + i * 1024), 16, 0, 0); }
                asm volatile("s_waitcnt vmcnt(0)" ::: "memory");
                f32x4 sa[2];
#pragma unroll
                for (int e = 0; e < 2; ++e) { sa[e] = (f32x4){0.f, 0.f, 0.f, 0.f};
                    const int kap = 8 * ((lane & 15) >> 2) + 4 * e + (lane & 3); const int x = (kap & 7) << 1;
                    const LAS unsigned char* rp = cbuf + kap * 512;
#pragma unroll
                    for (int s = 0; s < 8; ++s) { const bf16x8 a = *(const LAS bf16x8*)(rp + (((4 * s + g) ^ x) << 4)); sa[e] = __builtin_amdgcn_mfma_f32_16x16x32_bf16(a, qf[s], sa[e], 0, 0, 0); } }
                float v[8]; float cmax = -__builtin_inff();
#pragma unroll
                for (int e = 0; e < 2; ++e)
#pragma unroll
                    for (int r = 0; r < 4; ++r) { const int slot = ch * 32 + 8 * g + 4 * e + r; const int key = (int)sel[slot]; const int dist = t - key;
                        const int bk = dist < 128 ? (int)lut[dist < 0 ? 0 : dist] : 31; const float bias = tb[bk * 8 + (head & 7)];
                        const float x = slot < nvalid ? fmaf(sa[e][r], C2, bias) : -__builtin_inff(); v[4 * e + r] = x; cmax = fmaxf(cmax, x); }
                cmax = fmaxf(cmax, __shfl_xor(cmax, 16)); cmax = fmaxf(cmax, __shfl_xor(cmax, 32));
                const float mn = fmaxf(m_run, cmax), alpha = __builtin_amdgcn_exp2f(m_run - mn); m_run = mn;
                float ps = 0.f;
#pragma unroll
                for (int j = 0; j < 8; ++j) { v[j] = __builtin_amdgcn_exp2f(v[j] - mn); ps += v[j]; }
                ps += __shfl_xor(ps, 16); ps += __shfl_xor(ps, 32);
                l_run = l_run * alpha + ps;
#pragma unroll
                for (int nb = 0; nb < 16; ++nb) o[nb] = o[nb] * alpha;
                u32x4 pw; pw.x = pg8::cvt_pk_bf16(v[0], v[1]); pw.y = pg8::cvt_pk_bf16(v[2], v[3]); pw.z = pg8::cvt_pk_bf16(v[4], v[5]); pw.w = pg8::cvt_pk_bf16(v[6], v[7]);
                const bf16x8 pf = *reinterpret_cast<bf16x8*>(&pw);
                const int kap0 = 8 * g + ((lane & 15) >> 2), kap1 = kap0 + 4;
                const unsigned a0 = cbase + kap0 * 512 + (lane & 3) * 8, a1 = cbase + kap1 * 512 + (lane & 3) * 8;
                const unsigned x0 = (unsigned)((kap0 & 7) << 5), x1 = (unsigned)((kap1 & 7) << 5);
#pragma unroll
                for (int nb = 0; nb < 16; ++nb) {
                    s16x4 lo, hh; const unsigned ad0 = a0 + ((unsigned)(nb << 5) ^ x0), ad1 = a1 + ((unsigned)(nb << 5) ^ x1);
                    asm volatile("ds_read_b64_tr_b16 %0, %1" : "=&v"(lo) : "v"(ad0) : "memory");
                    asm volatile("ds_read_b64_tr_b16 %0, %1" : "=&v"(hh) : "v"(ad1) : "memory");
                    asm volatile("s_waitcnt lgkmcnt(0)" ::: "memory"); __builtin_amdgcn_sched_barrier(0);
                    o[nb] = __builtin_amdgcn_mfma_f32_16x16x32_bf16((bf16x8){lo[0], lo[1], lo[2], lo[3], hh[0], hh[1], hh[2], hh[3]}, pf, o[nb], 0, 0, 0);
                }
            }
            const float rl = 1.0f / l_run;
            if (head < 8) { bf16* op = T.mix + (tokb + t) * 3072 + head * 256 + 4 * g;
#pragma unroll
                for (int nb = 0; nb < 16; ++nb) { u32x2 w; w.x = pg8::cvt_pk_bf16(o[nb][0] * rl, o[nb][1] * rl); w.y = pg8::cvt_pk_bf16(o[nb][2] * rl, o[nb][3] * rl); *(u32x2*)(op + 16 * nb) = w; } }
        }
    }
    __syncthreads();
}
}
constexpr int NWAVES = 8;
#ifndef MK_N_LAUNCHES
#define MK_N_LAUNCHES 1
#endif
constexpr int N_PHASES = 9;
constexpr int N_LAUNCHES = MK_N_LAUNCHES;
static_assert(N_LAUNCHES == 1 || N_LAUNCHES == N_PHASES, "MK_N_LAUNCHES is 1 or 9");

constexpr int BATCH = 2, SEQ = 16384, DM = 2048, M = BATCH * SEQ;
constexpr int N_IN = 6656;
constexpr int D_IN_SRC = 5464;
constexpr int K_O = 3072;
constexpr int FF = 5632, FF2 = 11264;
constexpr int NHALO = 1024;
constexpr size_t MiB = 1u << 20;
constexpr size_t WS_CTL = 0, CTL_ZERO_BYTES = 1 * MiB;
constexpr size_t WS_WIN = 2 * MiB, WS_WO = 28 * MiB, WS_WUP = 40 * MiB, WS_WDN = 84 * MiB;
constexpr size_t WS_SMALL = 106 * MiB, WS_KIDX = 122 * MiB, WS_CKV = 126 * MiB, WS_CUM = 142 * MiB, WS_AHALO = 143 * MiB, WS_UHALO = 147 * MiB;
constexpr size_t WS_H = 192 * MiB;
constexpr size_t WS_MIX = 320 * MiB;
constexpr size_t WS_QLAT = 512 * MiB, WS_AKV = 640 * MiB, WS_AIQ = 656 * MiB, WS_BQ = 720 * MiB, WS_BK = 784 * MiB, WS_BV = 848 * MiB;
constexpr size_t WS_ACT = 512 * MiB;
constexpr size_t WS_END = 912 * MiB;
static_assert(WS_WIN + (size_t)N_IN * DM * 2 <= WS_WO && WS_WO + (size_t)DM * K_O * 2 <= WS_WUP && WS_WUP + (size_t)FF2 * DM * 2 <= WS_WDN && WS_WDN + (size_t)DM * FF * 2 <= WS_SMALL, "weights map");
static_assert(WS_BK - WS_BQ == WS_BV - WS_BK, "q/k/v spacing");
static_assert(WS_UHALO + (size_t)NHALO * FF2 * 4 <= WS_H && WS_ACT + (size_t)M * FF * 2 <= WS_END, "ws map");
constexpr int CW_TMO = 0, CW_CODE = 1, CW_QUEUE = 64, CW_NORMQ = 128, CW_NORMK = 192, CW_BAR = 4096;
constexpr size_t CTL_SS1 = 65536, CTL_SS2 = 65536 + 131072;
constexpr int RING_OFF = 0, RING_BYTES = 131072;
constexpr int LDSCTL_OFF = 140544, MISC_OFF = LDSCTL_OFF + 320;
constexpr int LDS_BYTES = 147456;
static_assert(dsa::END_OFF <= LDSCTL_OFF && MISC_OFF + 128 <= LDS_BYTES && fox::LDS_BYTES <= RING_BYTES, "LDS map");

struct Frame {
    LAS unsigned char* lds; volatile LAS unsigned* MISC; gu32* ctl;
    int tid, lane, wave, vcu, G;
};
__device__ __forceinline__ float wave_sum(float v) {
#pragma unroll
    for (int o = 1; o < 64; o <<= 1) v += __shfl_xor(v, o);
    return v;
}
__device__ __forceinline__ void p0_transpose_item(const float* W, int ldw, int c0, bf16* WT, int ldt, int r0, int k0, const float* gk, LAS float* scr, int lane) {
#pragma unroll 8
    for (int i = 0; i < 32; ++i) { const int kk = 2 * i + (lane >> 5); float v = W[(size_t)(k0 + kk) * ldw + c0 + (lane & 31)]; if (gk) v *= gk[k0 + kk]; scr[kk * 33 + (lane & 31)] = v; }
    LDS_WAIT(); asm volatile("" ::: "memory");
    const int c = lane & 7;
#pragma unroll
    for (int j = 0; j < 4; ++j) { const int n = (lane >> 3) + 8 * j; const LAS float* s = scr + (8 * c) * 33 + n;
        v4u o; o.x = pk2(s[0 * 33], s[1 * 33]); o.y = pk2(s[2 * 33], s[3 * 33]); o.z = pk2(s[4 * 33], s[5 * 33]); o.w = pk2(s[6 * 33], s[7 * 33]);
        *(GAS v4u*)(WT + (size_t)(r0 + n) * ldt + k0 + 8 * c) = o; }
    LDS_WAIT(); asm volatile("" ::: "memory");
}
__device__ __forceinline__ void fold_item(Frame& F, const float* A, int lda, const float* B, int ldb, bf16* out, int ldo, int row0, int col0) {
    LAS float* As = (LAS float*)(F.lds); LAS float* Bs = (LAS float*)(F.lds + 64 * 129 * 4);
    { const int r = F.tid >> 3, c = (F.tid & 7) * 16;
#pragma unroll
      for (int q = 0; q < 4; ++q) { const f32x4 v = *(const f32x4*)(A + (size_t)r * lda + c + 4 * q); As[r * 129 + c + 4 * q + 0] = v[0]; As[r * 129 + c + 4 * q + 1] = v[1]; As[r * 129 + c + 4 * q + 2] = v[2]; As[r * 129 + c + 4 * q + 3] = v[3]; } }
    { const int r = F.tid >> 2, c = (F.tid & 3) * 16;
#pragma unroll
      for (int q = 0; q < 4; ++q) *(LAS f32x4*)(Bs + r * 64 + c + 4 * q) = *(const f32x4*)(B + (size_t)r * ldb + c + 4 * q); }
    __syncthreads();
    const int j = F.tid & 63, ig = F.tid >> 6; float acc[8];
#pragma unroll
    for (int ii = 0; ii < 8; ++ii) acc[ii] = 0.f;
#pragma unroll 4
    for (int d = 0; d < 128; ++d) { const float bv = Bs[d * 64 + j];
#pragma unroll
        for (int ii = 0; ii < 8; ++ii) acc[ii] = fmaf(As[(8 * ig + ii) * 129 + d], bv, acc[ii]); }
    v4u o; o.x = pk2(acc[0], acc[1]); o.y = pk2(acc[2], acc[3]); o.z = pk2(acc[4], acc[5]); o.w = pk2(acc[6], acc[7]);
    *(GAS v4u*)(out + (size_t)(row0 + j) * ldo + col0 + 8 * ig) = o;
    __syncthreads();
}
struct Inputs { const float *x, *w_in, *kv_g, *w_uk, *w_uv, *t5, *fgb, *w_o, *g1, *g2, *w_up, *conv_w, *conv_b, *w_down, *gf; };

__device__ __forceinline__ void p0_prologue(Frame& F, const Inputs& I, unsigned char* ws) {
    bf16* WIN = (bf16*)(ws + WS_WIN); bf16* WO = (bf16*)(ws + WS_WO); bf16* WUP = (bf16*)(ws + WS_WUP); bf16* WDN = (bf16*)(ws + WS_WDN); bf16* H = (bf16*)(ws + WS_H);
    for (int it = F.vcu; it < 2048; it += F.G) {
        if (it < 1024) { const int h = it >> 7, kb = (it >> 2) & 31, rb = it & 3;
            fold_item(F, I.w_in + (size_t)(kb * 64) * D_IN_SRC + h * 128, D_IN_SRC, I.w_uk + (size_t)h * 128 * 256 + rb * 64, 256, WIN, DM, h * 256 + rb * 64, kb * 64); }
        else { const int r = it - 1024, h = r >> 7, nb = (r >> 2) & 31, rb = r & 3;
            fold_item(F, I.w_uv + ((size_t)h * 256 + rb * 64) * 128, 128, I.w_o + (size_t)(h * 128) * DM + nb * 64, DM, WO, K_O, nb * 64, h * 256 + rb * 64); }
    }
    LAS float* scr = (LAS float*)(F.lds + RING_OFF + F.wave * 16384);
    const int gw = F.vcu * NWAVES + F.wave, NGW = F.G * NWAVES;
    constexpr int I_IN = 138 * 32, I_O = 16 * 64, I_UP = 352 * 32, I_DN = 88 * 64, NIT = I_IN + I_O + I_UP + I_DN;
    for (int it = gw; it < NIT; it += NGW) {
        int r = it;
        if (r < I_IN) { const int cb = r >> 5, kb = r & 31; int dst, src;
            if (cb < 8) { dst = 2048 + cb * 32; src = 1024 + cb * 32; } else if (cb < 40) { dst = 2304 + (cb - 8) * 32; src = 1280 + (cb - 8) * 32; }
            else if (cb < 72) { dst = 3328 + (cb - 40) * 32; src = 2384 + (cb - 40) * 32; } else if (cb < 104) { dst = 4352 + (cb - 72) * 32; src = 3408 + (cb - 72) * 32; }
            else if (cb < 136) { dst = 5376 + (cb - 104) * 32; src = 4432 + (cb - 104) * 32; } else { dst = 6400 + (cb - 136) * 32; src = 2304 + (cb - 136) * 32; }
            p0_transpose_item(I.w_in, D_IN_SRC, src, WIN, DM, dst, kb * 64, nullptr, scr, F.lane); continue; }
        r -= I_IN;
        if (r < I_O) { const int kb = r >> 6, nb = r & 63;
            p0_transpose_item(I.w_o + (size_t)1024 * DM, DM, nb * 32, WO + 2048, K_O, nb * 32, kb * 64, nullptr, scr, F.lane); continue; }
        r -= I_O;
        if (r < I_UP) { const int cb = r >> 5, kb = r & 31; const int n0 = cb * 32, j = n0 >> 8, c = n0 & 255; const int src = c < 128 ? 128 * j + c : FF + 128 * j + (c - 128);
            p0_transpose_item(I.w_up, FF2, src, WUP, DM, n0, kb * 64, I.g2, scr, F.lane); continue; }
        r -= I_UP;
        { const int kb = r >> 6, nb = r & 63; p0_transpose_item(I.w_down, DM, nb * 32, WDN, FF, nb * 32, kb * 64, nullptr, scr, F.lane); }
    }
    for (int e = (F.vcu * NWAVES + F.wave) * 64 + F.lane; e < 192 * DM; e += NGW * 64) { const int c = 64 + e / DM, k = e % DM;
        float v = 0.f; if (c < 80) v = I.w_in[(size_t)k * D_IN_SRC + 2368 + (c - 64)]; else if (c < 88) v = I.w_in[(size_t)k * D_IN_SRC + 5456 + (c - 80)];
        WIN[(size_t)(6400 + c) * DM + k] = (bf16)f2bf(v); }
    for (int m = gw; m < M; m += NGW) {
        const GAS f32x4* xr = (const GAS f32x4*)(I.x + (size_t)m * DM) + F.lane; const GAS f32x4* gr = (const GAS f32x4*)I.g1 + F.lane;
        f32x4 v[8]; float s = 0.f;
#pragma unroll
        for (int j = 0; j < 8; ++j) { v[j] = xr[64 * j]; s += (v[j].x * v[j].x + v[j].y * v[j].y) + (v[j].z * v[j].z + v[j].w * v[j].w); }
        const float rstd = 1.0f / sqrtf(wave_sum(s) * (1.0f / DM) + 1e-6f);
        GAS unsigned long long* o8 = (GAS unsigned long long*)(H + (size_t)m * DM) + F.lane;
#pragma unroll
        for (int j = 0; j < 8; ++j) { const f32x4 g = gr[64 * j]; o8[64 * j] = (unsigned long long)pk2(v[j].x * rstd * g.x, v[j].y * rstd * g.y) | ((unsigned long long)pk2(v[j].z * rstd * g.z, v[j].w * rstd * g.w) << 32); }
    }
}
__device__ __forceinline__ float log_sigmoid(float x) { return x >= 0.f ? -log1pf(expf(-x)) : x - log1pf(expf(x)); }
__device__ __forceinline__ void p2_misc(Frame& F, const Inputs& I, unsigned char* ws) {
    const float* SMALL = (const float*)(ws + WS_SMALL); float* CUM = (float*)(ws + WS_CUM);
    if (F.vcu >= F.G - 2) {
        const int b = F.vcu - (F.G - 2); LAS float* tot = (LAS float*)(F.lds);
        float fb[8];
#pragma unroll
        for (int h = 0; h < 8; ++h) fb[h] = I.fgb[h];
        const float* sp = SMALL + ((size_t)b * SEQ + (size_t)F.tid * 32) * 128 + 80;
        float s[8];
#pragma unroll
        for (int h = 0; h < 8; ++h) s[h] = 0.f;
#pragma unroll 4
        for (int k = 0; k < 32; ++k) { const f32x4 a = *(const f32x4*)(sp + (size_t)k * 128), c = *(const f32x4*)(sp + (size_t)k * 128 + 4);
            s[0] += log_sigmoid(a[0] + fb[0]); s[1] += log_sigmoid(a[1] + fb[1]); s[2] += log_sigmoid(a[2] + fb[2]); s[3] += log_sigmoid(a[3] + fb[3]);
            s[4] += log_sigmoid(c[0] + fb[4]); s[5] += log_sigmoid(c[1] + fb[5]); s[6] += log_sigmoid(c[2] + fb[6]); s[7] += log_sigmoid(c[3] + fb[7]); }
#pragma unroll
        for (int h = 0; h < 8; ++h) tot[F.tid * 8 + h] = s[h];
        __syncthreads();
        { const int h = F.wave; float loc[8]; float run = 0.f;
#pragma unroll
          for (int k = 0; k < 8; ++k) { loc[k] = run; run += tot[(8 * F.lane + k) * 8 + h]; }
          float incl = run;
#pragma unroll
          for (int o = 1; o < 64; o <<= 1) { const float v = __shfl_up(incl, o); if (F.lane >= o) incl += v; }
          const float excl = incl - run;
          __syncthreads();
#pragma unroll
          for (int k = 0; k < 8; ++k) tot[(8 * F.lane + k) * 8 + h] = excl + loc[k]; }
        __syncthreads();
        float run[8];
#pragma unroll
        for (int h = 0; h < 8; ++h) run[h] = tot[F.tid * 8 + h];
        float* cp = CUM + (size_t)b * 8 * SEQ + (size_t)F.tid * 32;
#pragma unroll 4
        for (int k = 0; k < 32; ++k) { const f32x4 a = *(const f32x4*)(sp + (size_t)k * 128), c = *(const f32x4*)(sp + (size_t)k * 128 + 4);
            run[0] += log_sigmoid(a[0] + fb[0]); run[1] += log_sigmoid(a[1] + fb[1]); run[2] += log_sigmoid(a[2] + fb[2]); run[3] += log_sigmoid(a[3] + fb[3]);
            run[4] += log_sigmoid(c[0] + fb[4]); run[5] += log_sigmoid(c[1] + fb[5]); run[6] += log_sigmoid(c[2] + fb[6]); run[7] += log_sigmoid(c[3] + fb[7]);
#pragma unroll
            for (int h = 0; h < 8; ++h) cp[(size_t)h * SEQ + k] = run[h]; }
        __syncthreads();
        return;
    }
    const int nwg = F.G - 2, gw = F.vcu * NWAVES + F.wave, NGW = nwg * NWAVES;
    const bf16* AKV = (const bf16*)(ws + WS_AKV); bf16* CKV = (bf16*)(ws + WS_CKV); bf16* KIDX = (bf16*)(ws + WS_KIDX);
    const f32x4 g4 = *(const f32x4*)(I.kv_g + 4 * F.lane);
    for (int m = gw; m < M; m += NGW) {
        const unsigned long long raw = *(const GAS unsigned long long*)(AKV + (size_t)m * 256 + 4 * F.lane);
        const float a0 = __uint_as_float((unsigned)(raw & 0xffffu) << 16), a1 = __uint_as_float((unsigned)((raw >> 16) & 0xffffu) << 16), a2 = __uint_as_float((unsigned)((raw >> 32) & 0xffffu) << 16), a3 = __uint_as_float((unsigned)((raw >> 48) & 0xffffu) << 16);
        const float rstd = 1.0f / sqrtf(wave_sum((a0 * a0 + a1 * a1) + (a2 * a2 + a3 * a3)) * (1.0f / 256.0f) + 1e-6f);
        *(GAS unsigned long long*)(CKV + (size_t)m * 256 + 4 * F.lane) = (unsigned long long)pk2(a0 * rstd * g4[0], a1 * rstd * g4[1]) | ((unsigned long long)pk2(a2 * rstd * g4[2], a3 * rstd * g4[3]) << 32);
        if (F.lane < 16) { const f32x4 kv = *(const f32x4*)(SMALL + (size_t)m * 128 + 4 * F.lane);
            *(GAS unsigned long long*)(KIDX + (size_t)m * 64 + 4 * F.lane) = (unsigned long long)pk2(kv[0], kv[1]) | ((unsigned long long)pk2(kv[2], kv[3]) << 32); }
    }
    for (int it = gw; it < 2 * 16 * 64; it += NGW) { const int which = it >> 10, bh = (it >> 6) & 15, ck = it & 63;
        const bf16* base = (const bf16*)(ws + (which ? WS_BK : WS_BQ)) + ((size_t)bh * SEQ + (size_t)ck * 256) * 128;
        float mx = 0.f;
#pragma unroll 4
        for (int i = 0; i < 64; ++i) { const v4u v = *(const GAS v4u*)(base + (size_t)(4 * i + (F.lane >> 4)) * 128 + (F.lane & 15) * 8);
            float s = 0.f; const unsigned wv[4] = {v.x, v.y, v.z, v.w};
#pragma unroll
            for (int q = 0; q < 4; ++q) { const float lo = __uint_as_float(wv[q] << 16), hh = __uint_as_float(wv[q] & 0xffff0000u); s += lo * lo + hh * hh; }
            s += __shfl_xor(s, 1); s += __shfl_xor(s, 2); s += __shfl_xor(s, 4); s += __shfl_xor(s, 8);
            mx = fmaxf(mx, s); }
        mx = fmaxf(mx, __shfl_xor(mx, 16)); mx = fmaxf(mx, __shfl_xor(mx, 32));
        if (F.lane == 0) atomicMax((unsigned*)(F.ctl + (which ? CW_NORMK : CW_NORMQ) + bh), __float_as_uint(mx)); }
}
constexpr int NFOX = 16 * 64, NDSA = 2 * 1024;
__device__ __forceinline__ int queue_fetch(Frame& F) {
    if (F.tid == 0) F.MISC[16] = __hip_atomic_fetch_add(F.ctl + CW_QUEUE, 1u, RLX_AGENT);
    __syncthreads(); const int v = __builtin_amdgcn_readfirstlane((int)F.MISC[16]); __syncthreads(); return v;
}
__device__ __forceinline__ fox::BlockRef fox_ref(Frame& F, unsigned char* ws, int id) {
    const int qb = 63 - (id >> 4), bh = id & 15, b = bh >> 3, h = bh & 7;
    fox::BlockRef r;
    r.Q = (const bf16*)(ws + WS_BQ) + ((size_t)bh * SEQ + (size_t)qb * 256) * 128; r.K = (const bf16*)(ws + WS_BK) + (size_t)bh * SEQ * 128; r.V = (const bf16*)(ws + WS_BV) + (size_t)bh * SEQ * 128;
    r.O = (bf16*)(ws + WS_MIX) + ((size_t)b * SEQ + (size_t)qb * 256) * K_O + 2048 + h * 128; r.ldo = K_O;
    r.C = (const float*)(ws + WS_CUM) + (size_t)bh * SEQ; r.P0 = qb * 256; r.cref = __uint_as_float(__builtin_amdgcn_readfirstlane(__float_as_uint(r.C[r.P0])));
    const float qn = sqrtf(__uint_as_float(__hip_atomic_load(F.ctl + CW_NORMQ + bh, RLX_AGENT))), kn = sqrtf(__uint_as_float(__hip_atomic_load(F.ctl + CW_NORMK + bh, RLX_AGENT)));
    const float lim = __uint_as_float(__builtin_amdgcn_readfirstlane(__float_as_uint(r.cref + 106.0f + 2.0f * qn * kn * fox::SCALE)));
    const int jd = r.P0 / 64; int nf = 0;
    int l4 = F.lane * 4; asm volatile("" : "+v"(l4));
    float cv[4];
#pragma unroll
    for (int i = 0; i < 4; ++i) { const int j = l4 + i; cv[i] = *(const float*)((const char*)r.C + (unsigned)((64 * (j < jd ? j : 0) + 63) * 4)); }
#pragma unroll
    for (int i = 0; i < 4; ++i) { const bool f = (l4 + i < jd) && (cv[i] > lim); nf += (int)__popcll(__ballot(f)); }
    r.jlo = nf;
    return r;
}
__device__ __forceinline__ void p3_mixers(Frame& F, const Inputs& I, unsigned char* ws) {
    dsa::init_tables(F.lds, I.t5);
    __syncthreads();
    int id = queue_fetch(F);
#ifndef NO_FOX
    if (id < NFOX) {
        fox::Seam S; fox::BlockRef cur = fox_ref(F, ws, id);
        fox::fox_prime(cur, (char*)F.lds, S);
        for (;;) {
            const int idn = queue_fetch(F); const bool more = idn < NFOX;
            const fox::BlockRef nxt = more ? fox_ref(F, ws, idn) : cur;
            fox::fox_block(cur, nxt, SEQ, (char*)F.lds, S);
            id = idn; if (!more) break;
            cur = nxt;
        }
    }
#endif
    asm volatile("s_waitcnt vmcnt(0)" ::: "memory"); __syncthreads();
    dsa::Tensors T{(const bf16*)(ws + WS_AIQ), (const float*)(ws + WS_SMALL), (const bf16*)(ws + WS_KIDX), (const bf16*)(ws + WS_CKV), (const bf16*)(ws + WS_QLAT), (bf16*)(ws + WS_MIX)};
#ifndef NO_DSA
    for (; id < NFOX + NDSA; id = queue_fetch(F)) { const int u = id - NFOX; dsa::unit(F.lds, T, u & 1, (1023 - (u >> 1)) * 16); }
#endif
}
__device__ __forceinline__ void p8_final(Frame& F, const Inputs& I, float* out) {
    const int gw = F.vcu * NWAVES + F.wave, NGW = F.G * NWAVES; const float* ss2 = (const float*)((const unsigned char*)F.ctl + CTL_SS2);
    for (int m = gw; m < M; m += NGW) {
        GAS f32x4* xr = (GAS f32x4*)(out + (size_t)m * DM) + F.lane; const GAS f32x4* gr = (const GAS f32x4*)I.gf + F.lane;
        const float rstd = 1.0f / sqrtf(ss2[m] * (1.0f / DM) + 1e-6f);
#pragma unroll
        for (int j = 0; j < 8; ++j) { const f32x4 v = xr[64 * j], g = gr[64 * j]; xr[64 * j] = v * g * rstd; }
    }
}

struct Args { const float* in[15]; float* out; unsigned char* ws; int ph_lo, ph_hi; };
__global__ void __launch_bounds__(NWAVES * 64, 2) layer_fwd(Args args) {
    extern __shared__ __attribute__((aligned(16))) unsigned char lds[];
    Frame F;
    F.lds = (LAS unsigned char*)lds; F.MISC = (volatile LAS unsigned*)(F.lds + MISC_OFF);
    F.tid = threadIdx.x; F.lane = F.tid & 63; F.wave = __builtin_amdgcn_readfirstlane(F.tid >> 6);
    F.G = gridDim.x; { const int bx = blockIdx.x; F.vcu = (F.G % 8 == 0) ? (bx % 8) * (F.G / 8) + bx / 8 : bx; }
    unsigned char* ws = args.ws; F.ctl = (gu32*)(ws + WS_CTL);
    Inputs I{args.in[0], args.in[1], args.in[2], args.in[3], args.in[4], args.in[5], args.in[6], args.in[7], args.in[8], args.in[9], args.in[10], args.in[11], args.in[12], args.in[13], args.in[14]};
    for (int u = F.tid; u < (LDS_BYTES - LDSCTL_OFF) / 4; u += NWAVES * 64) ((LAS unsigned*)(F.lds + LDSCTL_OFF))[u] = 0u;
    __syncthreads();
    XcdBarrier bar; bar.bar = (unsigned*)(F.ctl + CW_BAR); bar.x = 0; bar.st = nullptr;
    if (N_LAUNCHES == 1) bar = xcd_barrier_post((unsigned*)(F.ctl + CW_BAR), F.MISC + 8);
    const int lo = args.ph_lo, hi = args.ph_hi;
#ifndef PH_MASK
#define PH_MASK 0x1ff
#endif
#define IN(k) (((PH_MASK >> (k)) & 1) && lo <= (k) && (k) < hi)
#define SEAM(k) do { if (IN(k) && IN((k) + 1)) xcd_barrier(bar); } while (0)
    float* SS1 = (float*)((unsigned char*)F.ctl + CTL_SS1); float* SS2 = (float*)((unsigned char*)F.ctl + CTL_SS2);
    if (IN(0)) { p0_prologue(F, I, ws); SEAM(0); }
    if (IN(1)) {
        pg8::Gemm g{(const pg8::bf16_t*)(ws + WS_H), (const pg8::bf16_t*)(ws + WS_WIN), M, N_IN, DM}; pg8::StaticOrder S; S.init(M, N_IN, F.G, (int)blockIdx.x);
        pg8::EpiInProj E{(pg8::bf16_t*)(ws + WS_QLAT), (pg8::bf16_t*)(ws + WS_AKV), (pg8::bf16_t*)(ws + WS_AIQ), (pg8::bf16_t*)(ws + WS_BQ), (size_t)(WS_BK - WS_BQ) / 2, (float*)(ws + WS_SMALL)};
        pg8::gemm_phase<pg8::EpiInProj, pg8::StaticOrder, true, true>(F.lds + RING_OFF, g, S, E);
        SEAM(1);
    }
    if (IN(2)) { p2_misc(F, I, ws); SEAM(2); }
    if (IN(3)) { p3_mixers(F, I, ws); SEAM(3); }
    if (IN(4)) {
        pg8::Gemm g{(const pg8::bf16_t*)(ws + WS_MIX), (const pg8::bf16_t*)(ws + WS_WO), M, DM, K_O}; pg8::StaticOrder S; S.init(M, DM, F.G, (int)blockIdx.x);
        pg8::EpiOutProj E{I.x, args.out, (pg8::bf16_t*)(ws + WS_H), (pg8::bf16_t*)(ws + WS_AHALO), SS1};
        pg8::gemm_phase<pg8::EpiOutProj, pg8::StaticOrder, true, true>(F.lds + RING_OFF, g, S, E);
        SEAM(4);
    }
    if (IN(5)) {
        pg8::Gemm g{(const pg8::bf16_t*)(ws + WS_AHALO), (const pg8::bf16_t*)(ws + WS_WUP), NHALO, FF2, DM}; pg8::StaticOrder S; S.init(NHALO, FF2, F.G, (int)blockIdx.x);
        pg8::EpiHalo E{SS1, (float*)(ws + WS_UHALO)};
        pg8::gemm_phase<pg8::EpiHalo, pg8::StaticOrder, true, true>(F.lds + RING_OFF, g, S, E);
        SEAM(5);
    }
    if (IN(6)) {
        pg8::Gemm g{(const pg8::bf16_t*)(ws + WS_H), (const pg8::bf16_t*)(ws + WS_WUP), M, FF2, DM}; pg8::StaticOrder S; S.init(M, FF2, F.G, (int)blockIdx.x);
        pg8::EpiUp E{SS1, (const float*)(ws + WS_UHALO), I.conv_w, I.conv_b, (pg8::bf16_t*)(ws + WS_ACT)};
        pg8::gemm_phase<pg8::EpiUp, pg8::StaticOrder, true, true>(F.lds + RING_OFF, g, S, E);
        SEAM(6);
    }
    if (IN(7)) {
        pg8::Gemm g{(const pg8::bf16_t*)(ws + WS_ACT), (const pg8::bf16_t*)(ws + WS_WDN), M, DM, FF}; pg8::StaticOrder S; S.init(M, DM, F.G, (int)blockIdx.x);
        pg8::EpiDown E{args.out, SS2};
        pg8::gemm_phase<pg8::EpiDown, pg8::StaticOrder, true, true>(F.lds + RING_OFF, g, S, E);
        SEAM(7);
    }
    if (IN(8)) p8_final(F, I, args.out);
#undef IN
#undef SEAM
}

extern "C" void kernel_launch(void* const* d_in, const int* in_sizes, int n_in, void* d_out, int out_size, void* d_ws, size_t ws_size, hipStream_t stream) {
    static int grid = 0;
    if (grid == 0) {
        if (n_in != 15 || in_sizes[0] != M * DM || out_size != M * DM || ws_size < WS_END) { fprintf(stderr, "kernel_launch: unexpected shapes (n_in %d, in0 %d, out %d, ws %zu)\n", n_in, n_in > 0 ? in_sizes[0] : -1, out_size, ws_size); grid = -1; return; }
        int dev = 0, cus = 0, per_cu = 0;
        if (hipGetDevice(&dev) != hipSuccess || hipDeviceGetAttribute(&cus, hipDeviceAttributeMultiprocessorCount, dev) != hipSuccess) { grid = -1; return; }
        if (hipFuncSetAttribute((const void*)layer_fwd, hipFuncAttributeMaxDynamicSharedMemorySize, LDS_BYTES) != hipSuccess) { fprintf(stderr, "kernel_launch: hipFuncSetAttribute failed\n"); grid = -1; return; }
        if (hipOccupancyMaxActiveBlocksPerMultiprocessor(&per_cu, (const void*)layer_fwd, NWAVES * 64, LDS_BYTES) != hipSuccess || per_cu < 1) fprintf(stderr, "kernel_launch: occupancy query reports %d\n", per_cu);
        (void)hipGetLastError();
        grid = cus;
    }
    if (grid < 0) return;
    if (hipMemsetAsync((char*)d_ws + WS_CTL, 0, CTL_ZERO_BYTES, stream) != hipSuccess) return;
    Args a{};
    for (int i = 0; i < 15; ++i) a.in[i] = (const float*)d_in[i];
    a.out = (float*)d_out; a.ws = (unsigned char*)d_ws;
    for (int li = 0; li < N_LAUNCHES; ++li) {
        a.ph_lo = (N_LAUNCHES == 1) ? 0 : li; a.ph_hi = (N_LAUNCHES == 1) ? N_PHASES : li + 1;
        hipLaunchKernelGGL(layer_fwd, dim3(grid), dim3(NWAVES * 64), LDS_BYTES, stream, a);
        if (hipPeekAtLastError() != hipSuccess) { fprintf(stderr, "kernel_launch: launch %d failed\n", li); break; }
    }
}
```

```cpp
#include <hip/hip_runtime.h>
#include <cstdio>
#include <cstdint>
#ifndef PROBE2X
#define PROBE2X 0
#endif
namespace pg8 {
#define PG8_LAS __attribute__((address_space(3)))
typedef unsigned short bf16_t;
typedef short bf16x8 __attribute__((ext_vector_type(8)));
typedef float f32x4 __attribute__((ext_vector_type(4)));
typedef unsigned u32x4 __attribute__((ext_vector_type(4)));
typedef int i32x4 __attribute__((ext_vector_type(4)));
typedef int i32x8 __attribute__((ext_vector_type(8)));
constexpr float MIX_SCALE = 32.0f, WO_SCALE = 1024.0f;
__device__ __forceinline__ i32x8 cat8(bf16x8 a, bf16x8 b) { const i32x4 x = (i32x4)a, y = (i32x4)b; return __builtin_shufflevector(x, y, 0, 1, 2, 3, 4, 5, 6, 7); }
constexpr int BM = 256, BK = 64, HALF = 128, HTB = HALF * BK * 2  , STAGE_BYTES = 8 * HTB, NXCD = 8, WGM = 8;

__host__ __device__ __forceinline__ int lds_byte(int r, int c) { const int st = (r >> 4) * 2 + (c >> 5), rr = r & 15, cc = c & 31, ob = rr * 64 + cc * 2; return st * 1024 + (ob ^ (((ob >> 9) & 1) << 5)); }
__host__ __device__ __forceinline__ void stage_rc(int b, int& R, int& C) { const int st = b / 1024, sb = b % 1024, swz = sb ^ (((sb >> 9) & 1) << 5); R = (st >> 1) * 16 + swz / 64; C = (st & 1) * 32 + (swz % 64) / 2; }
__host__ __device__ __forceinline__ int perm32(int rho) { const int n = rho >> 4, i = rho & 15; return 8 * (i >> 2) + 4 * n + (i & 3); }

struct Unit { int pm, pn; };
struct Gemm { const bf16_t* A; const bf16_t* Bt; int M, N, K; };

struct StaticOrder {
    int nM, nN, nwg, G, c, reps;
    __host__ __device__ void init(int M, int N, int G_, int c_, int reps_ = 1) { nM = M / BM; nN = N / BM; nwg = nM * nN; G = G_; c = c_; reps = reps_; }
    __host__ __device__ bool next(int i, Unit& u) const {
        const long L = (long)i * G + c; if (L >= (long)nwg * reps) return false;
        int wgid = (int)(L % nwg); { const int q = nwg / NXCD, r = nwg % NXCD, xcd = wgid % NXCD, off = wgid / NXCD; wgid = (xcd < r ? xcd * (q + 1) : r * (q + 1) + (xcd - r) * q) + off; }
        const int nig = WGM * nN, gid = wgid / nig, fm = gid * WGM, gsz = (nM - fm) < WGM ? (nM - fm) : WGM;
        u.pm = fm + ((wgid % nig) % gsz); u.pn = (wgid % nig) / gsz; return true;
    }
    __device__ __forceinline__ void a_ready(const Unit&) const {}
    __device__ __forceinline__ void done(const Unit&) const {}
};

__device__ __forceinline__ unsigned cvt_pk_bf16(float lo, float hi) { unsigned r; asm volatile("v_cvt_pk_bf16_f32 %0, %1, %2" : "=v"(r) : "v"(lo), "v"(hi)); return r; }
__device__ __forceinline__ u32x4 pack8bf(const f32x4 v0, const f32x4 v1) { u32x4 w; w.x = cvt_pk_bf16(v0[0], v0[1]); w.y = cvt_pk_bf16(v0[2], v0[3]); w.z = cvt_pk_bf16(v1[0], v1[1]); w.w = cvt_pk_bf16(v1[2], v1[3]); return w; }
__device__ __forceinline__ float dot4(const f32x4 a) { return (a[0] * a[0] + a[1] * a[1]) + (a[2] * a[2] + a[3] * a[3]); }
template <int CTRL> __device__ __forceinline__ float dppf(float v) { return __builtin_bit_cast(float, __builtin_amdgcn_update_dpp(0, __builtin_bit_cast(int, v), CTRL, 0xf, 0xf, false)); }

constexpr float H8_SCALE = 16.0f, WIN8_SCALE = 1024.0f;
template <bool F8>
struct EpiInProjT {
    static constexpr bool PERM = true, AFTER_DRAIN = false;
    bf16_t *aq, *akv, *aiq, *bq; size_t qkv_stride; float* small;
    __device__ __forceinline__ void operator()(const f32x4 (&acc0)[2][2][4][2], const Unit& u, int wr, int wc, int fr, int fq) const {
        const int pn = F8 ? (u.pn < 4 ? u.pn : u.pn + 5) : (u.pn == 5 ? 21 : u.pn + 4), row0 = u.pm * BM + wr * 64 + fr, cl = wc * 32 + 8 * fq;
        f32x4 acc[2][2][4][2];
#pragma unroll
        for (int a = 0; a < 2; ++a)
#pragma unroll
            for (int b = 0; b < 2; ++b)
#pragma unroll
                for (int m = 0; m < 4; ++m)
#pragma unroll
                    for (int n = 0; n < 2; ++n) acc[a][b][m][n] = F8 ? acc0[a][b][m][n] * (1.0f / (H8_SCALE * WIN8_SCALE)) : acc0[a][b][m][n];
        if (pn < 4) {
#pragma unroll
            for (int ai = 0; ai < 2; ++ai)
#pragma unroll
                for (int m = 0; m < 4; ++m) { const int row = row0 + ai * HALF + m * 16;
#pragma unroll
                    for (int bj = 0; bj < 2; ++bj) *(u32x4*)(aq + ((size_t)(2 * pn + bj) * 32768 + row) * 128 + cl) = pack8bf(acc[ai][bj][m][0], acc[ai][bj][m][1]); }
        } else if (pn < 9) {
            bf16_t* dst; int ld, cb;
            if (pn == 4) { dst = akv; ld = 256; cb = 0; } else { dst = aiq; ld = 1024; cb = (pn - 5) * 256; }
#pragma unroll
            for (int ai = 0; ai < 2; ++ai)
#pragma unroll
                for (int m = 0; m < 4; ++m) { bf16_t* rowp = dst + (size_t)(row0 + ai * HALF + m * 16) * ld + cb + cl;
#pragma unroll
                    for (int bj = 0; bj < 2; ++bj) *(u32x4*)(rowp + bj * HALF) = pack8bf(acc[ai][bj][m][0], acc[ai][bj][m][1]); }
        } else if (pn < 21) {
            const int w = (pn - 9) >> 2, hp = (pn - 9) & 3; bf16_t* dst = bq + (size_t)w * qkv_stride;
#pragma unroll
            for (int ai = 0; ai < 2; ++ai)
#pragma unroll
                for (int m = 0; m < 4; ++m) { const int row = row0 + ai * HALF + m * 16, b = row >> 14, t = row & 16383;
#pragma unroll
                    for (int bj = 0; bj < 2; ++bj) *(u32x4*)(dst + ((size_t)(b * 8 + 2 * hp + bj) * 16384 + t) * 128 + cl) = pack8bf(acc[ai][bj][m][0], acc[ai][bj][m][1]); }
        } else {
#pragma unroll
            for (int ai = 0; ai < 2; ++ai)
#pragma unroll
                for (int m = 0; m < 4; ++m) { float* rp = small + (size_t)(row0 + ai * HALF + m * 16) * 128 + cl; *(f32x4*)rp = acc[ai][0][m][0]; *(f32x4*)(rp + 4) = acc[ai][0][m][1]; }
        }
    }
};
typedef EpiInProjT<false> EpiInProj; typedef EpiInProjT<true> EpiInProj8;
struct EpiOutProj {
    static constexpr bool PERM = true, AFTER_DRAIN = false;
    const float* x; bf16_t* x1b; bf16_t* ahalo; float* ss;
    __device__ __forceinline__ void operator()(const f32x4 (&acc)[2][2][4][2], const Unit& u, int wr, int wc, int fr, int fq) const {
        const int row0 = u.pm * BM + wr * 64 + fr, col0 = u.pn * BM + wc * 32 + 8 * fq;
#pragma unroll
        for (int ai = 0; ai < 2; ++ai) {
            f32x4 xv[4][2][2];
#pragma unroll
            for (int m = 0; m < 4; ++m)
#pragma unroll
                for (int bj = 0; bj < 2; ++bj) { const size_t o = (size_t)(row0 + ai * HALF + m * 16) * 2048 + col0 + bj * HALF; xv[m][bj][0] = *(const f32x4*)(x + o); xv[m][bj][1] = *(const f32x4*)(x + o + 4); }
#pragma unroll
            for (int m = 0; m < 4; ++m) { const int row = row0 + ai * HALF + m * 16; float s = 0.f;
#pragma unroll
                for (int bj = 0; bj < 2; ++bj) { const size_t o = (size_t)row * 2048 + col0 + bj * HALF;
                    const f32x4 v0 = xv[m][bj][0] + acc[ai][bj][m][0] * (1.0f / (MIX_SCALE * WO_SCALE)), v1 = xv[m][bj][1] + acc[ai][bj][m][1] * (1.0f / (MIX_SCALE * WO_SCALE));
                    const u32x4 w = pack8bf(v0, v1); *(u32x4*)(x1b + o) = w;
                    if ((row & 63) >= 62) *(u32x4*)(ahalo + (size_t)(2 * (row >> 6) + (row & 1)) * 2048 + col0 + bj * HALF) = w;
                    s += dot4(v0) + dot4(v1); }
                s += __shfl_xor(s, 16); s += __shfl_xor(s, 32);
                if (fq == 0) unsafeAtomicAdd(ss + row, s); } }
    }
};
struct EpiHalo {
    static constexpr bool PERM = true, AFTER_DRAIN = false;
    const float* ss; float* uh;
    __device__ __forceinline__ void operator()(const f32x4 (&acc)[2][2][4][2], const Unit& u, int wr, int wc, int fr, int fq) const {
        const int row0 = u.pm * BM + wr * 64 + fr, col0 = u.pn * BM + wc * 32 + 8 * fq;
        float rsv[2][4];
#pragma unroll
        for (int ai = 0; ai < 2; ++ai)
#pragma unroll
            for (int m = 0; m < 4; ++m) { const int hr = row0 + ai * HALF + m * 16, src = 64 * (hr >> 1) + 62 + (hr & 1); rsv[ai][m] = ss[src]; }
#pragma unroll
        for (int ai = 0; ai < 2; ++ai)
#pragma unroll
            for (int m = 0; m < 4; ++m) { const int hr = row0 + ai * HALF + m * 16;
                const float rs = __builtin_amdgcn_rsqf(rsv[ai][m] * (1.0f / 2048.0f) + 1e-6f);
#pragma unroll
                for (int bj = 0; bj < 2; ++bj) { float* p = uh + (size_t)hr * 11264 + col0 + bj * HALF; *(f32x4*)p = acc[ai][bj][m][0] * rs; *(f32x4*)(p + 4) = acc[ai][bj][m][1] * rs; } }
    }
};
constexpr float ACT_SCALE = 16.0f, WDN_SCALE = 1024.0f;
struct EpiUp {
    static constexpr bool PERM = true, AFTER_DRAIN = false;
    const float* ss; const float* uh; const float* cw; const float* cbias; unsigned char* act;
    __device__ __forceinline__ void operator()(const f32x4 (&acc)[2][2][4][2], const Unit& u, int wr, int wc, int fr, int fq) const {
        const int pn = u.pn, cl = wc * 32 + 8 * fq, rowb0 = u.pm * BM + wr * 64;
        unsigned pk[2][4];
        const unsigned long long m15 = __ballot(fr == 15), m14 = __ballot(fr >= 14);
        float rsv[2][4];
#pragma unroll
        for (int ai = 0; ai < 2; ++ai)
#pragma unroll
            for (int m = 0; m < 4; ++m) rsv[ai][m] = ss[rowb0 + ai * HALF + m * 16 + fr];
#pragma unroll
        for (int ai = 0; ai < 2; ++ai)
#pragma unroll
            for (int m = 0; m < 4; ++m) rsv[ai][m] = __builtin_amdgcn_rsqf(rsv[ai][m] * (1.0f / 2048.0f) + 1e-6f);
#pragma unroll
        for (int n = 0; n < 2; ++n) {
            f32x4 w0[2], w1[2], w2[2], bb[2];
#pragma unroll
            for (int bj = 0; bj < 2; ++bj) { const int oc = bj * 5632 + pn * 128 + cl + 4 * n;
                w0[bj] = *(const f32x4*)(cw + oc); w1[bj] = *(const f32x4*)(cw + 11264 + oc); w2[bj] = *(const f32x4*)(cw + 22528 + oc); bb[bj] = *(const f32x4*)(cbias + oc); }
            f32x4 prevh[2][2];
#pragma unroll
            for (int ai = 0; ai < 2; ++ai) { const int rb = rowb0 + ai * HALF;
                prevh[ai][0] = prevh[ai][1] = (f32x4){0.f, 0.f, 0.f, 0.f};
                if ((rb & 16383) != 0 && fr >= 14) { const int hr = 2 * ((rb >> 6) - 1) + (fr - 14);
#pragma unroll
                    for (int bj = 0; bj < 2; ++bj) prevh[ai][bj] = *(const f32x4*)(uh + (size_t)hr * 11264 + pn * 256 + bj * HALF + cl + 4 * n); } }
#pragma unroll
            for (int ai = 0; ai < 2; ++ai) {
                const int rb = rowb0 + ai * HALF;
                f32x4 prev[2] = {prevh[ai][0], prevh[ai][1]};
#pragma unroll
                for (int m = 0; m < 4; ++m) {
                    const int row = rb + m * 16 + fr; const float rs = rsv[ai][m];
                    f32x4 y[2];
#pragma unroll
                    for (int bj = 0; bj < 2; ++bj) { const f32x4 uc = acc[ai][bj][m][n] * rs;
#pragma unroll
                        for (int j = 0; j < 4; j += 2) {
                            float ya = fmaf(w2[bj][j], uc[j], bb[bj][j]), yb = fmaf(w2[bj][j + 1], uc[j + 1], bb[bj][j + 1]); float t0, t1, r0, r1;
                            asm("v_cndmask_b32_e64 %2, %6, %8, %10\n\tv_cndmask_b32_e64 %3, %7, %9, %10\n\tv_cndmask_b32_e64 %4, %6, %8, %11\n\tv_cndmask_b32_e64 %5, %7, %9, %11\n\t"
                                "v_fmac_f32_dpp %0, %2, %12 row_ror:1 row_mask:0xf bank_mask:0xf\n\tv_fmac_f32_dpp %1, %3, %13 row_ror:1 row_mask:0xf bank_mask:0xf\n\t"
                                "v_fmac_f32_dpp %0, %4, %14 row_ror:2 row_mask:0xf bank_mask:0xf\n\tv_fmac_f32_dpp %1, %5, %15 row_ror:2 row_mask:0xf bank_mask:0xf"
                                : "+v"(ya), "+v"(yb), "=&v"(t0), "=&v"(t1), "=&v"(r0), "=&v"(r1)
                                : "v"(uc[j]), "v"(uc[j + 1]), "v"(prev[bj][j]), "v"(prev[bj][j + 1]), "s"(m15), "s"(m14), "v"(w1[bj][j]), "v"(w1[bj][j + 1]), "v"(w0[bj][j]), "v"(w0[bj][j + 1]));
                            y[bj][j] = ya; y[bj][j + 1] = yb; }
                        prev[bj] = uc; }
                    float a[4];
#pragma unroll
                    for (int j = 0; j < 4; ++j) { const float g = y[0][j]; a[j] = g * __builtin_amdgcn_rcpf(1.0f + __builtin_amdgcn_exp2f(-1.4426950408889634f * g)) * y[1][j]; }
#pragma unroll
                    for (int j = 0; j < 4; ++j) a[j] = __builtin_amdgcn_fmed3f(a[j] * ACT_SCALE, -448.0f, 448.0f);
                    int w8 = __builtin_amdgcn_cvt_pk_fp8_f32(a[0], a[1], 0, false); w8 = __builtin_amdgcn_cvt_pk_fp8_f32(a[2], a[3], w8, true); asm volatile("" : "+v"(w8));
                    if (n == 0) pk[ai][m] = (unsigned)w8;
                    else *(unsigned long long*)(act + (size_t)row * 5632 + pn * 128 + cl) = (unsigned long long)pk[ai][m] | ((unsigned long long)(unsigned)w8 << 32);
                }
            }
        }
    }
};
struct EpiDown {
    static constexpr bool PERM = true, AFTER_DRAIN = false;
    const bf16_t* xin; bf16_t* xout; float* ss;
    __device__ __forceinline__ void operator()(const f32x4 (&acc)[2][2][4][2], const Unit& u, int wr, int wc, int fr, int fq) const {
        const int row0 = u.pm * BM + wr * 64 + fr, col0 = u.pn * BM + wc * 32 + 8 * fq;
#pragma unroll
        for (int ai = 0; ai < 2; ++ai) {
            u32x4 xbv[4][2];
#pragma unroll
            for (int m = 0; m < 4; ++m)
#pragma unroll
                for (int bj = 0; bj < 2; ++bj) xbv[m][bj] = *(const u32x4*)(xin + (size_t)(row0 + ai * HALF + m * 16) * 2048 + col0 + bj * HALF);
#pragma unroll
            for (int m = 0; m < 4; ++m) { const int row = row0 + ai * HALF + m * 16; float s = 0.f;
#pragma unroll
                for (int bj = 0; bj < 2; ++bj) { const size_t o = (size_t)row * 2048 + col0 + bj * HALF;
                    const u32x4 xb = xbv[m][bj];
                    const f32x4 x0 = {__uint_as_float(xb.x << 16), __uint_as_float(xb.x & 0xffff0000u), __uint_as_float(xb.y << 16), __uint_as_float(xb.y & 0xffff0000u)}, x1 = {__uint_as_float(xb.z << 16), __uint_as_float(xb.z & 0xffff0000u), __uint_as_float(xb.w << 16), __uint_as_float(xb.w & 0xffff0000u)};
                    const f32x4 v0 = x0 + acc[ai][bj][m][0] * (1.0f / (ACT_SCALE * WDN_SCALE)), v1 = x1 + acc[ai][bj][m][1] * (1.0f / (ACT_SCALE * WDN_SCALE));
                    *(u32x4*)(xout + o) = pack8bf(v0, v1); s += dot4(v0) + dot4(v1); }
                s += __shfl_xor(s, 16); s += __shfl_xor(s, 32);
                if (fq == 0) unsafeAtomicAdd(ss + row, s); } }
    }
};
template <class Epi, class Sched, bool ALIGN_EPI = false, bool SP2 = false, bool FP8 = false>
__device__ __forceinline__ void gemm_phase(PG8_LAS unsigned char* lds, const Gemm g, const Sched& S, const Epi& E, const int tid  ) {
    const int wid = __builtin_amdgcn_readfirstlane(tid >> 6), lane = tid & 63, wr = wid >> 2, wc = wid & 3, fr = lane & 15, fq = lane >> 4;
    const int K = g.K, nt = K / BK;
    unsigned voffA[2], voffB[2];
#pragma unroll
    for (int i = 0; i < 2; ++i) { int R, C; stage_rc(tid * 16 + i * 8192, R, C); const int Rb = Epi::PERM ? ((R & ~31) + perm32(R & 31)) : R;
        voffA[i] = (unsigned)(R * K + C) * 2u; voffB[i] = (unsigned)(Rb * K + C) * 2u; }
    const size_t kstep = (size_t)(BK * 2);
    const size_t hstep = (size_t)HALF * K * 2;
    const size_t tstep = 2 * hstep;
    const unsigned ldsw = (unsigned)wid * 1024u;
    const int aoff = lds_byte(wr * 64 + fr, fq * 8), boff = lds_byte(wc * 32 + fr, fq * 8);
#define PG8_SA(b, h) (((b) * 2 + (h)) * HTB)
#define PG8_SB(b, h) ((4 + (b) * 2 + (h)) * HTB)
#define PG8_STAGE(bufoff, gbase, voff) do { const char* _gb = (const char*)(gbase); if constexpr (FP8) asm volatile("" : "+s"(_gb));     \
        _Pragma("unroll") for (int _i = 0; _i < 2; ++_i) \
        __builtin_amdgcn_global_load_lds((const unsigned*)(_gb + (voff)[_i]), (PG8_LAS unsigned*)(lds + (bufoff) + ldsw + _i * 8192), 16, 0, 0); } while (0)
#define PG8_LDA(dst, b, h) do { _Pragma("unroll") for (int m = 0; m < 4; ++m) _Pragma("unroll") for (int k = 0; k < 2; ++k) dst[m][k] = *(const PG8_LAS bf16x8*)(lds + PG8_SA(b, h) + aoff + m * 2048 + k * 1024); } while (0)
#define PG8_LDB(dst, b, h) do { _Pragma("unroll") for (int n = 0; n < 2; ++n) _Pragma("unroll") for (int k = 0; k < 2; ++k) dst[n][k] = *(const PG8_LAS bf16x8*)(lds + PG8_SB(b, h) + boff + n * 2048 + k * 1024); } while (0)
#define PG8_MMA(ai, bj, At, Bt) do { __builtin_amdgcn_s_setprio(1); \
        if constexpr (FP8) { _Pragma("unroll") for (int m = 0; m < 4; ++m) _Pragma("unroll") for (int n = 0; n < 2; ++n) \
            acc[ai][bj][m][n] = __builtin_amdgcn_mfma_scale_f32_16x16x128_f8f6f4(cat8(Bt[n][0], Bt[n][1]), cat8(At[m][0], At[m][1]), acc[ai][bj][m][n], 0, 0, 0, 0, 0, 0); } \
        else { _Pragma("unroll") for (int m = 0; m < 4; ++m) _Pragma("unroll") for (int n = 0; n < 2; ++n) _Pragma("unroll") for (int k = 0; k < 2; ++k) \
            acc[ai][bj][m][n] = __builtin_amdgcn_mfma_f32_16x16x32_bf16(Bt[n][k], At[m][k], acc[ai][bj][m][n], 0, 0, 0); } \
        __builtin_amdgcn_s_setprio(0); } while (0)
#define PG8_WAIT_V(n) asm volatile("s_waitcnt vmcnt(" #n ")" ::: "memory")
#define PG8_WAIT_L(n) asm volatile("s_waitcnt lgkmcnt(" #n ")" ::: "memory")
#define PG8_BAR __builtin_amdgcn_s_barrier()
#define PG8_SCHED __builtin_amdgcn_sched_barrier(0)
    Unit cur, nxt; int ui = 0;
    if (!S.next(0, cur)) return;
    f32x4 acc[2][2][4][2];
#pragma unroll
    for (int a = 0; a < 2; ++a)
#pragma unroll
        for (int b = 0; b < 2; ++b)
#pragma unroll
            for (int m = 0; m < 4; ++m)
#pragma unroll
                for (int n = 0; n < 2; ++n) acc[a][b][m][n] = (f32x4){0.f, 0.f, 0.f, 0.f};
    bf16x8 At[4][2], B0[2][2], B1[2][2];
    const char* cA = (const char*)g.A + (size_t)cur.pm * tstep; const char* cB = (const char*)g.Bt + (size_t)cur.pn * tstep;
    S.a_ready(cur);
    if constexpr (SP2) {
        PG8_STAGE(PG8_SB(0, 0), cB, voffB); PG8_STAGE(PG8_SB(0, 1), cB + hstep, voffB); PG8_STAGE(PG8_SA(0, 0), cA, voffA); PG8_STAGE(PG8_SA(0, 1), cA + hstep, voffA);
        if (wr == 1) PG8_BAR;
        PG8_WAIT_V(2); PG8_BAR;
        PG8_STAGE(PG8_SB(1, 0), cB + kstep, voffB); PG8_STAGE(PG8_SA(1, 0), cA + kstep, voffA); PG8_STAGE(PG8_SB(1, 1), cB + hstep + kstep, voffB);
        PG8_WAIT_V(6); PG8_BAR;
    } else {
        PG8_STAGE(PG8_SB(0, 0), cB, voffB); PG8_STAGE(PG8_SA(0, 0), cA, voffA); PG8_STAGE(PG8_SB(0, 1), cB + hstep, voffB); PG8_STAGE(PG8_SA(0, 1), cA + hstep, voffA);
        if (wr == 1) PG8_BAR;
        PG8_WAIT_V(4); PG8_BAR;
        PG8_STAGE(PG8_SB(1, 0), cB + kstep, voffB); PG8_STAGE(PG8_SA(1, 0), cA + kstep, voffA); PG8_STAGE(PG8_SB(1, 1), cB + hstep + kstep, voffB);
        PG8_WAIT_V(6); PG8_BAR;
    }
    for (;;) {
        const bool has_next = S.next(ui + 1, nxt);
        const char* nA = has_next ? (const char*)g.A + (size_t)nxt.pm * tstep : cA; const char* nB = has_next ? (const char*)g.Bt + (size_t)nxt.pn * tstep : cB;
        for (int t = 0; t < nt; t += 2) {
            const bool last = (t == nt - 2);
            const char* a1 = cA + (size_t)(t + 1) * kstep;
            const char* a2 = last ? nA : cA + (size_t)(t + 2) * kstep; const char* b2 = last ? nB : cB + (size_t)(t + 2) * kstep;
            const char* a3 = a2 + kstep; const char* b3 = b2 + kstep;
            if (last && has_next) S.a_ready(nxt);
            if constexpr (SP2) {
            PG8_LDB(B0, 0, 0); PG8_LDB(B1, 0, 1); PG8_SCHED; PG8_LDA(At, 0, 0); PG8_STAGE(PG8_SA(1, 1), a1 + hstep, voffA);
            PG8_WAIT_V(8); PG8_WAIT_L(0); PG8_BAR; PG8_MMA(0, 0, At, B0); PG8_MMA(0, 1, At, B1); PG8_BAR; PG8_SCHED;
            PG8_LDA(At, 0, 1); PG8_STAGE(PG8_SB(0, 0), b2, voffB); PG8_STAGE(PG8_SB(0, 1), b2 + hstep, voffB); PG8_STAGE(PG8_SA(0, 0), a2, voffA);
            PG8_WAIT_V(8); PG8_WAIT_L(0); PG8_BAR; PG8_MMA(1, 0, At, B0); PG8_MMA(1, 1, At, B1); PG8_BAR; PG8_SCHED;
            PG8_LDB(B0, 1, 0); PG8_LDB(B1, 1, 1); PG8_SCHED; PG8_LDA(At, 1, 0); PG8_STAGE(PG8_SA(0, 1), a2 + hstep, voffA);
            PG8_WAIT_V(8); PG8_WAIT_L(0); PG8_BAR; PG8_MMA(0, 0, At, B0); PG8_MMA(0, 1, At, B1); PG8_BAR; PG8_SCHED;
            PG8_LDA(At, 1, 1); PG8_STAGE(PG8_SB(1, 0), b3, voffB); PG8_STAGE(PG8_SB(1, 1), b3 + hstep, voffB); PG8_STAGE(PG8_SA(1, 0), a3, voffA);
            PG8_WAIT_V(8); PG8_WAIT_L(0); PG8_BAR; PG8_MMA(1, 0, At, B0); PG8_MMA(1, 1, At, B1); PG8_BAR; PG8_SCHED;
            } else {
            PG8_LDB(B0, 0, 0); PG8_SCHED; PG8_LDA(At, 0, 0); PG8_STAGE(PG8_SA(1, 1), a1 + hstep, voffA);
            PG8_WAIT_L(8); PG8_BAR; PG8_WAIT_L(0); PG8_MMA(0, 0, At, B0); PG8_BAR; PG8_SCHED;
            PG8_LDB(B1, 0, 1); PG8_STAGE(PG8_SB(0, 0), b2, voffB);
            PG8_BAR; PG8_WAIT_L(0); PG8_MMA(0, 1, At, B1); PG8_BAR;
            PG8_LDA(At, 0, 1); PG8_STAGE(PG8_SA(0, 0), a2, voffA);
            PG8_BAR; PG8_WAIT_L(0); PG8_MMA(1, 0, At, B0); PG8_BAR; PG8_SCHED;
            PG8_STAGE(PG8_SB(0, 1), b2 + hstep, voffB);
            PG8_WAIT_V(6); PG8_BAR; PG8_MMA(1, 1, At, B1); PG8_BAR;
            PG8_LDB(B0, 1, 0); PG8_SCHED; PG8_LDA(At, 1, 0); PG8_STAGE(PG8_SA(0, 1), a2 + hstep, voffA);
            PG8_WAIT_L(8); PG8_BAR; PG8_WAIT_L(0); PG8_MMA(0, 0, At, B0); PG8_BAR; PG8_SCHED;
            PG8_LDB(B1, 1, 1); PG8_STAGE(PG8_SB(1, 0), b3, voffB);
            PG8_BAR; PG8_WAIT_L(0); PG8_MMA(0, 1, At, B1); PG8_BAR;
            PG8_LDA(At, 1, 1); PG8_STAGE(PG8_SA(1, 0), a3, voffA);
            PG8_BAR; PG8_WAIT_L(0); PG8_MMA(1, 0, At, B0); PG8_BAR; PG8_SCHED;
            PG8_STAGE(PG8_SB(1, 1), b3 + hstep, voffB);
            PG8_WAIT_V(6); PG8_BAR; PG8_MMA(1, 1, At, B1); PG8_BAR;
            }
        }
        if constexpr (ALIGN_EPI) { if (wr == 0) PG8_BAR; }
        if constexpr (!Epi::AFTER_DRAIN) {
            if constexpr (FP8) { int l2 = lane; asm volatile("" : "+v"(l2)); E(acc, cur, wr, wc, l2 & 15, l2 >> 4); }
            else E(acc, cur, wr, wc, fr, fq);
            S.done(cur); }
        if (!has_next) break;
#pragma unroll
        for (int a = 0; a < 2; ++a)
#pragma unroll
            for (int b = 0; b < 2; ++b)
#pragma unroll
                for (int m = 0; m < 4; ++m)
#pragma unroll
                    for (int n = 0; n < 2; ++n) acc[a][b][m][n] = (f32x4){0.f, 0.f, 0.f, 0.f};
        cur = nxt; cA = nA; cB = nB; ++ui;
        if constexpr (ALIGN_EPI) { if (wr == 1) PG8_BAR; }
    }
    PG8_WAIT_V(0);
    if constexpr (!ALIGN_EPI) { if (wr == 0) PG8_BAR; }
    PG8_BAR;
    if constexpr (Epi::AFTER_DRAIN) { E.fused(acc, cur, wr, wc, fr, fq, lds, wid, lane); S.done(cur); }
#undef PG8_SA
#undef PG8_SB
#undef PG8_STAGE
#undef PG8_LDA
#undef PG8_LDB
#undef PG8_MMA
#undef PG8_WAIT_V
#undef PG8_WAIT_L
#undef PG8_BAR
#undef PG8_SCHED
}
}
#define GAS __attribute__((address_space(1)))
#define LAS __attribute__((address_space(3)))
typedef unsigned short bf16;
typedef unsigned v4u __attribute__((ext_vector_type(4)));
typedef float f32x4 __attribute__((ext_vector_type(4)));
typedef short bf16x8 __attribute__((ext_vector_type(8)));
typedef GAS unsigned gu32;
typedef GAS unsigned long long gu64;
#define RLX_AGENT __ATOMIC_RELAXED, __HIP_MEMORY_SCOPE_AGENT
#define LDS_WAIT() asm volatile("s_waitcnt lgkmcnt(0)" ::: "memory")
#define VM_WAIT() asm volatile("s_waitcnt vmcnt(0)" ::: "memory")
__device__ __forceinline__ unsigned long long rt() { return __builtin_amdgcn_s_memrealtime(); }
__device__ __forceinline__ unsigned f2bf(float f) { unsigned u = __builtin_bit_cast(unsigned, f); return (u + 0x7fffu + ((u >> 16) & 1u)) >> 16; }
__device__ __forceinline__ unsigned pk2(float lo, float hi) { return f2bf(lo) | (f2bf(hi) << 16); }

#define XB_TMO      128
#define XB_XCNT(j)  (256  + 64 * (j))
#define XB_XSUB(j)  (1280 + 64 * (j))
#define XB_XGEN(j)  (2304 + 64 * (j))
#define XB_TOP      3328
#define XB_TOPGEN   3392
#define XCD_BAR_WORDS 3456
#define XB_SPIN_CAP (1u << 18)

__device__ __forceinline__ unsigned xb_ld(unsigned* p)              { return __hip_atomic_load(p, __ATOMIC_RELAXED, __HIP_MEMORY_SCOPE_AGENT); }
__device__ __forceinline__ unsigned xb_add(unsigned* p, unsigned v) { return __hip_atomic_fetch_add(p, v, __ATOMIC_RELAXED, __HIP_MEMORY_SCOPE_AGENT); }
__device__ __forceinline__ unsigned xb_xcc_id() { return (unsigned)__builtin_amdgcn_s_getreg((3 << 11) | 20) & 0xFu; }
#define XB_SPIN(cond, bar) do { unsigned _sp = 0; while (cond) { __builtin_amdgcn_s_sleep(1); \
    if ((++_sp & 255u) == 0u) { if (xb_ld(&(bar)[XB_TMO])) break; if (_sp > XB_SPIN_CAP) { atomicAdd(&(bar)[XB_TMO], 1u); break; } } } } while (0)

struct XcdBarrier {
    unsigned* bar; unsigned x;
    volatile LAS unsigned* st;
};

__device__ __forceinline__ XcdBarrier xcd_barrier_post(unsigned* bar, volatile LAS unsigned* st, const bool xb_t0  ) {
    XcdBarrier b; b.bar = bar; b.x = xb_xcc_id(); b.st = st;
    if (xb_t0) (void)xb_add(&bar[XB_XCNT(b.x)], 1u);
    return b;
}
__device__ __forceinline__ void xcd_barrier_complete(unsigned* bar, unsigned x, unsigned& nloc, unsigned& nx) {
    const unsigned G = gridDim.x * gridDim.y * gridDim.z;
    unsigned sum, cnt, mine, sp = 0u;
    for (;;) {
        sum = 0u; cnt = 0u; mine = 0u;
#pragma unroll
        for (unsigned j = 0; j < 16; ++j) { const unsigned c = xb_ld(&bar[XB_XCNT(j)]); sum += c; cnt += (c > 0u) ? 1u : 0u; mine = (j == x) ? c : mine; }
        if (sum == G) break;
        __builtin_amdgcn_s_sleep(1);
        if ((++sp & 255u) == 0u) { if (xb_ld(&bar[XB_TMO])) break; if (sp > XB_SPIN_CAP) { atomicAdd(&bar[XB_TMO], 1u); break; } }
    }
    nloc = mine > 0u ? mine : 1u; nx = cnt > 0u ? cnt : 1u;
}

__device__ __forceinline__ void xcd_barrier(const XcdBarrier& b, const bool xb_t0) {
    asm volatile("s_waitcnt vmcnt(0)" ::: "memory");
    __syncthreads();
    if (xb_t0) {
        unsigned* bar = b.bar;
        __builtin_amdgcn_s_waitcnt(0);
        unsigned nloc = b.st[0], nx = b.st[1];
        if (nloc == 0u) { xcd_barrier_complete(bar, b.x, nloc, nx); b.st[0] = nloc; b.st[1] = nx; }
        const unsigned old = xb_add(&bar[XB_XSUB(b.x)], 1u);
        const unsigned gen = old / nloc;
        if (old + 1u == (gen + 1u) * nloc) {
            __builtin_amdgcn_fence(__ATOMIC_RELEASE, "agent");
            asm volatile("s_waitcnt vmcnt(0)" ::: "memory");
            const unsigned og = xb_add(&bar[XB_TOP], 1u);
            const unsigned tg = og / nx;
            if (og + 1u == (tg + 1u) * nx) xb_add(&bar[XB_TOPGEN], 1u);
            else XB_SPIN(xb_ld(&bar[XB_TOPGEN]) == tg, bar);
            __builtin_amdgcn_fence(__ATOMIC_ACQUIRE, "agent");
            xb_add(&bar[XB_XGEN(b.x)], 1u);
            asm volatile("s_waitcnt vmcnt(0)" ::: "memory");
        } else {
            XB_SPIN(xb_ld(&bar[XB_XGEN(b.x)]) == gen, bar);
            __builtin_amdgcn_fence(__ATOMIC_ACQUIRE, "agent");
            asm volatile("s_waitcnt vmcnt(0)" ::: "memory");
        }
    }
    __syncthreads();
}
namespace fox {
constexpr int D = 128;
constexpr float SCALE = 0.08838834764831845f, LOG2E = 1.4426950408889634f;
constexpr float THR = 8.f;
constexpr int NW = 8, QBLK = 32, KVBLK = 64, QB = NW * QBLK;
constexpr int SHM_V = KVBLK * D * 2, SHM_K = KVBLK * D * 2;
constexpr int CB_OFF = 2 * SHM_V + 2 * SHM_K, WS_OFF = CB_OFF + 512;
constexpr int LDS_BYTES = WS_OFF + NW * 64 * 4;
constexpr unsigned WINF = 0x7fffffffu;
constexpr int LDO = 2048;

typedef unsigned short bf16;
typedef short bf16x8 __attribute__((ext_vector_type(8)));
typedef short s16x4 __attribute__((ext_vector_type(4)));
typedef float f32x16 __attribute__((ext_vector_type(16)));
typedef float f32x4 __attribute__((ext_vector_type(4)));
typedef unsigned u32x4 __attribute__((ext_vector_type(4)));
typedef unsigned u32x2 __attribute__((ext_vector_type(2)));

#define KSWZ(row, colB) ((row) * 256 + ((colB) ^ (((row) & 7) << 4)))
#define SBAR() __builtin_amdgcn_sched_barrier(0)
__device__ __forceinline__ int v_st(int k, int c) { const int kk = (k & ~0xC) | ((k & 4) << 1) | ((k & 8) >> 1); return ((kk >> 3) * 4 + (c >> 5)) * 512 + ((kk & 7) * 32 + (c & 31)) * 2; }
__device__ __forceinline__ int v_rd_base(int lane) { return ((lane & 3) << 3) | (((lane >> 2) & 3) << 6) | (((lane >> 4) & 1) << 5) | (((lane >> 5) & 1) << 8); }
constexpr int v_rd_off(int d0, int ks, int half) { return d0 * 512 + ks * 4096 + half * 2048; }
__device__ __forceinline__ int crow(int r, int hi) { return (r & 3) + 8 * (r >> 2) + 4 * hi; }
__device__ __forceinline__ unsigned cvtpk(float lo, float hi) { unsigned r; asm volatile("v_cvt_pk_bf16_f32 %0, %1, %2" : "=v"(r) : "v"(lo), "v"(hi)); return r; }
__device__ __forceinline__ bf16x8 load8(const bf16* p) { return *reinterpret_cast<const bf16x8*>(p); }
__device__ __forceinline__ void mask_tile(f32x16& p0, f32x16& p1, int dq, unsigned W) {
    const float NEG = -__builtin_inff();
#pragma unroll
    for (int r = 0; r < 16; ++r) {
        const int c = (r & 3) + 8 * (r >> 2);
        if ((unsigned)(dq - c) >= W) p0[r] = NEG;
        if ((unsigned)(dq - c - 32) >= W) p1[r] = NEG;
    }
}
__device__ __forceinline__ void partialSM(f32x16& p0, f32x16& p1, float& m_reg, float& mn, float& alpha) {
    float pmax = p0[0]; for (int r = 1; r < 16; ++r) pmax = fmaxf(pmax, p0[r]); for (int r = 0; r < 16; ++r) pmax = fmaxf(pmax, p1[r]);
    { auto rr = __builtin_amdgcn_permlane32_swap(__float_as_uint(pmax), __float_as_uint(pmax), false, false);
      pmax = fmaxf(__uint_as_float(rr[0]), __uint_as_float(rr[1])); }
    constexpr float C2 = LOG2E * SCALE;
    if (__builtin_expect(__all((pmax - m_reg) * SCALE <= THR), 1)) { mn = m_reg; alpha = 1.f; }
    else { mn = fmaxf(m_reg, pmax); alpha = __builtin_amdgcn_exp2f((m_reg - mn) * C2); m_reg = mn; }
    const float mnL = -mn * C2;
    for (int r = 0; r < 16; ++r) p0[r] = fmaf(p0[r], C2, mnL); for (int r = 0; r < 16; ++r) p1[r] = fmaf(p1[r], C2, mnL);
    for (int r = 0; r < 16; ++r) p0[r] = __builtin_amdgcn_exp2f(p0[r]);
}
__device__ __forceinline__ void finishSM(f32x16& p0, f32x16& p1, float alpha, float& l_reg, bf16x8& pa0, bf16x8& pa1, bf16x8& pa2, bf16x8& pa3) {
    for (int r = 0; r < 16; ++r) p1[r] = __builtin_amdgcn_exp2f(p1[r]);
    float ps = 0; for (int r = 0; r < 16; ++r) ps += p0[r]; for (int r = 0; r < 16; ++r) ps += p1[r];
    { auto rr = __builtin_amdgcn_permlane32_swap(__float_as_uint(ps), __float_as_uint(ps), false, false);
      ps = __uint_as_float(rr[0]) + __uint_as_float(rr[1]); }
    l_reg = l_reg * alpha + ps;
#define PK4(P, B_, OUT) do { unsigned a0 = cvtpk(P[B_+0], P[B_+1]), a1 = cvtpk(P[B_+2], P[B_+3]);                          \
        unsigned b0 = cvtpk(P[B_+4], P[B_+5]), b1 = cvtpk(P[B_+6], P[B_+7]);                                             \
        auto r0 = __builtin_amdgcn_permlane32_swap(a0, b0, false, false); auto r1 = __builtin_amdgcn_permlane32_swap(a1, b1, false, false); \
        u32x4 w = {r0[0], r1[0], r0[1], r1[1]}; OUT = *reinterpret_cast<bf16x8*>(&w); } while (0)
    PK4(p0, 0, pa0); PK4(p0, 8, pa1); PK4(p1, 0, pa2); PK4(p1, 8, pa3);
#undef PK4
}
template <int KB>
__device__ __forceinline__ void qkt(f32x16& p0, f32x16& p1, const char* K_lds, const float* cb, int r32, int hi, const bf16x8* qr) {
#pragma unroll
    for (int g = 0; g < 4; ++g) { const f32x4 b0 = *(const f32x4*)(cb + 8 * g + 4 * hi), b1 = *(const f32x4*)(cb + 32 + 8 * g + 4 * hi);
#pragma unroll
        for (int j = 0; j < 4; ++j) { p0[4 * g + j] = b0[j]; p1[4 * g + j] = b1[j]; } }
    const char* kb[4];
#pragma unroll
    for (int dd = 0; dd < 4; ++dd) kb[dd] = K_lds + KB * SHM_K + KSWZ(r32, (dd * 16 + hi * 8) * 2);
#pragma unroll
    for (int d0 = 0; d0 < 8; ++d0) { const char* a = kb[d0 & 3] + (d0 >> 2) * 128;
        bf16x8 b0 = *reinterpret_cast<const bf16x8*>(a);
        bf16x8 b1 = *reinterpret_cast<const bf16x8*>(a + 32 * 256);
        p0 = __builtin_amdgcn_mfma_f32_32x32x16_bf16(b0, qr[d0], p0, 0, 0, 0);
        p1 = __builtin_amdgcn_mfma_f32_32x32x16_bf16(b1, qr[d0], p1, 0, 0, 0); }
}
template <int VB>
__device__ __forceinline__ void pv_tile(f32x16* o, int vb0, bf16x8 pa0, bf16x8 pa1, bf16x8 pa2, bf16x8 pa3) {
#define TRRD(dst, off) asm volatile("ds_read_b64_tr_b16 %0, %1 offset:%2" : "=&v"(dst) : "v"(vb0), "i"(off) : "memory")
#define PV_D0(d0) do { s16x4 l0, l1, l2, l3, h0, h1, h2, h3; constexpr int b_ = VB * SHM_V + v_rd_off(d0, 0, 0);     \
        TRRD(l0, b_); TRRD(h0, b_ + 2048); TRRD(l1, b_ + 4096); TRRD(h1, b_ + 6144); TRRD(l2, b_ + 8192); TRRD(h2, b_ + 10240); TRRD(l3, b_ + 12288); TRRD(h3, b_ + 14336); \
        asm volatile("s_waitcnt lgkmcnt(0)" ::: "memory"); SBAR();             \
        o[d0] = __builtin_amdgcn_mfma_f32_32x32x16_bf16((bf16x8){l0[0], l0[1], l0[2], l0[3], h0[0], h0[1], h0[2], h0[3]}, pa0, o[d0], 0, 0, 0);   \
        o[d0] = __builtin_amdgcn_mfma_f32_32x32x16_bf16((bf16x8){l1[0], l1[1], l1[2], l1[3], h1[0], h1[1], h1[2], h1[3]}, pa1, o[d0], 0, 0, 0);   \
        o[d0] = __builtin_amdgcn_mfma_f32_32x32x16_bf16((bf16x8){l2[0], l2[1], l2[2], l2[3], h2[0], h2[1], h2[2], h2[3]}, pa2, o[d0], 0, 0, 0);   \
        o[d0] = __builtin_amdgcn_mfma_f32_32x32x16_bf16((bf16x8){l3[0], l3[1], l3[2], l3[3], h3[0], h3[1], h3[2], h3[3]}, pa3, o[d0], 0, 0, 0); } while (0)
    PV_D0(0); PV_D0(1); PV_D0(2); PV_D0(3);
#undef PV_D0
#undef TRRD
}

struct BlockRef { const bf16* Q; const bf16* K; const bf16* V; bf16* O; const float* C; float cref; int P0, jlo, ldo; };
struct Seam { bf16x8 qr[8]; bf16x8 st_v0, st_v1, st_k0, st_k1; float st_c; };
#define ROW(p, k0, rr) ((const bf16*)((const char*)(p) + (unsigned)((((k0) + (rr)) * D + sc) * 2)))
#define VMW() asm volatile("s_waitcnt vmcnt(0)" ::: "memory")
#define VMWN(n) asm volatile("s_waitcnt vmcnt(%0)" :: "i"(n) : "memory")
#define SLOAD_H(Kp, Vp, Cp, k0) do { S.st_v0 = load8(ROW(Vp, k0, sr)); S.st_v1 = load8(ROW(Vp, k0, 32 + sr));              \
                         S.st_k0 = load8(ROW(Kp, k0, sr)); S.st_k1 = load8(ROW(Kp, k0, 32 + sr));                          \
                         if (tid < 64) S.st_c = *(const float*)((const char*)(Cp) + (unsigned)(((k0) + tid) * 4)); } while (0)
#define SWRITE_HK(bf, cref_) do { *(bf16x8*)(K_lds + (bf) * SHM_K + kws) = S.st_k0; *(bf16x8*)(K_lds + (bf) * SHM_K + kws + 32 * 256) = S.st_k1; \
                         if (tid < 64) *(float*)(C_lds + (bf) * 256 + tid * 4) = ((cref_) - S.st_c) * (1.0f / SCALE); } while (0)
#define SWRITE_HV(bf) do { *(bf16x8*)(V_lds + (bf) * SHM_V + vst0) = S.st_v0; *(bf16x8*)(V_lds + (bf) * SHM_V + vst1) = S.st_v1; } while (0)
#define SWRITE_H(bf, cref_) do { SWRITE_HV(bf); SWRITE_HK(bf, cref_); } while (0)
__device__ __forceinline__ void fox_prime(const BlockRef& cur, char* lds, Seam& S, const int tid) {
    const int wid = __builtin_amdgcn_readfirstlane(tid >> 6), lane = tid & 63, r32 = lane & 31, hi = lane >> 5;
    const int sr = tid >> 4, sc = (tid & 15) * 8, kws = KSWZ(sr, sc * 2); char* K_lds = lds + 2 * SHM_V; char* C_lds = lds + CB_OFF;
    const int kb0 = cur.jlo * KVBLK;
    for (int d0 = 0; d0 < 8; ++d0) S.qr[d0] = load8((const bf16*)((const char*)cur.Q + (unsigned)(((wid * QBLK + r32) * D + d0 * 16 + hi * 8) * 2)));
    SLOAD_H(cur.K, cur.V, cur.C, kb0); VMW(); SWRITE_HK(0, cur.cref);
    __syncthreads();
}
__device__ __forceinline__ void fox_block(const BlockRef& cur, const BlockRef& nxt, int skv, char* lds, Seam& S, const int tid) {
    const int wid = __builtin_amdgcn_readfirstlane(tid >> 6), lane = tid & 63, r32 = lane & 31, hi = lane >> 5;
    const int j_lo = cur.jlo;
    int j_hi = (cur.P0 + QB - 1) / KVBLK + 1; if (j_hi > skv / KVBLK) j_hi = skv / KVBLK;
    const int NT = j_hi - j_lo;
    const int kbn = nxt.jlo * KVBLK;
    const int qlo = cur.P0 + wid * QBLK, qm = qlo + r32 - 4 * hi;
    char* V_lds = lds; char* K_lds = lds + 2 * SHM_V; char* C_lds = lds + CB_OFF;
    float m_reg = -1e30f, l_reg = 0; f32x16 o[4] = {};
    const int sr = tid >> 4, sc = (tid & 15) * 8, vst0 = v_st(sr, sc), vst1 = v_st(32 + sr, sc), kws = KSWZ(sr, sc * 2);
    const int vb0 = (int)(uintptr_t)V_lds + v_rd_base(lane);
    const bf16* Kh = cur.K; const bf16* Vh = cur.V; const float* Ch = cur.C; const float cref = cur.cref;
#define CBT(bf) ((const float*)(C_lds + (bf) * 256))
#define RESC(a) do { if (__any((a) < 1.f)) { for (int d_ = 0; d_ < 4; ++d_) for (int r = 0; r < 16; ++r) o[d_][r] *= (a); } } while (0)
#define KBASE(t) ((j_lo + (t)) * KVBLK)
#define MASKT(P0_, P1_, t) do { const int kb_ = KBASE(t); if (kb_ + KVBLK - 1 > qlo) mask_tile(P0_, P1_, qm - kb_, WINF); } while (0)
    constexpr int NQL = 8;
#define SEAM_K0() do { VMWN(NQL); SWRITE_HK(0, nxt.cref); SBAR(); } while (0)
    f32x16 pA0, pA1, pB0, pB1; float mnA, mnB, alA, alB; bf16x8 pa0, pa1, pa2, pa3;
    SWRITE_HV(0); SBAR();
    if (NT > 1) { SLOAD_H(Kh, Vh, Ch, KBASE(1)); }
    SBAR(); qkt<0>(pA0, pA1, K_lds, CBT(0), r32, hi, S.qr);
    MASKT(pA0, pA1, 0); partialSM(pA0, pA1, m_reg, mnA, alA);
    if (NT > 1) { VMW(); SWRITE_H(1, cref); }
    __syncthreads();
#define HALF_STEP(PX0, PX1, mnX, alX, PY0, PY1, alY, t, KB, VB, SB) do {                                                      \
        SBAR(); qkt<KB>(PX0, PX1, K_lds, CBT(KB), r32, hi, S.qr);                                                                     \
        finishSM(PY0, PY1, alY, l_reg, pa0, pa1, pa2, pa3); SBAR();                                                           \
        if ((t) + 1 < NT) { SLOAD_H(Kh, Vh, Ch, KBASE((t) + 1)); SBAR(); }                                                    \
        pv_tile<VB>(o, vb0, pa0, pa1, pa2, pa3); MASKT(PX0, PX1, (t)); partialSM(PX0, PX1, m_reg, mnX, alX);    \
        __syncthreads();                                                                                                      \
        if ((t) + 1 < NT) { VMW(); SWRITE_H(SB, cref); }                                                                      \
        RESC(alX); __syncthreads(); } while (0)
    for (int t = 1; t + 1 < NT; t += 2) {
        HALF_STEP(pB0, pB1, mnB, alB, pA0, pA1, alA, t, 1, 0, 0);
        HALF_STEP(pA0, pA1, mnA, alA, pB0, pB1, alB, t + 1, 0, 1, 1);
    }
    const bool even = (NT & 1) == 0;
    if (even) { SBAR(); qkt<1>(pB0, pB1, K_lds, CBT(1), r32, hi, S.qr); SBAR(); }
    SLOAD_H(nxt.K, nxt.V, nxt.C, kbn); SBAR();
#pragma unroll
    for (int d0 = 0; d0 < 8; ++d0) S.qr[d0] = load8((const bf16*)((const char*)nxt.Q + (unsigned)(((wid * QBLK + r32) * D + d0 * 16 + hi * 8) * 2)));
    SBAR();
    finishSM(pA0, pA1, alA, l_reg, pa0, pa1, pa2, pa3); SBAR();
    pv_tile<0>(o, vb0, pa0, pa1, pa2, pa3);
    if (even) { MASKT(pB0, pB1, NT - 1); partialSM(pB0, pB1, m_reg, mnB, alB); __syncthreads(); RESC(alB);
        finishSM(pB0, pB1, alB, l_reg, pa0, pa1, pa2, pa3); SBAR(); pv_tile<1>(o, vb0, pa0, pa1, pa2, pa3); }
    SBAR(); SEAM_K0();
    const float rl = __builtin_amdgcn_rcpf(l_reg) * pg8::MIX_SCALE;
    unsigned ob = (unsigned)((wid * QBLK + r32) * LDO + 4 * hi);
    asm volatile("" : "+v"(ob));
#pragma unroll
    for (int d0 = 0; d0 < 4; ++d0)
#pragma unroll
        for (int g4 = 0; g4 < 4; ++g4) { int w8 = __builtin_amdgcn_cvt_pk_fp8_f32(o[d0][4 * g4] * rl, o[d0][4 * g4 + 1] * rl, 0, false); w8 = __builtin_amdgcn_cvt_pk_fp8_f32(o[d0][4 * g4 + 2] * rl, o[d0][4 * g4 + 3] * rl, w8, true);
            *(unsigned*)((char*)cur.O + (ob + (unsigned)(d0 * 32 + 8 * g4))) = (unsigned)w8; }
    __syncthreads();
#undef CBT
#undef RESC
#undef KBASE
#undef MASKT
#undef SEAM_K0
#undef HALF_STEP
}
#undef ROW
#undef VMW
#undef VMWN
#undef SLOAD_H
#undef SWRITE_HK
#undef SWRITE_HV
#undef SWRITE_H
#undef KSWZ
#undef SBAR
}
namespace dsa {
constexpr int L = 16384, NQ = 32, CAP = 640, KSEL = 256, EPL = CAP / 64  ;
#ifndef PROBE2X
#define PROBE2X 0
#endif
constexpr int ATT_REPS = ((PROBE2X >> 10) & 1) + 1, IDX_REPS = ((PROBE2X >> 11) & 1) + 1, CMP_REPS = ((PROBE2X >> 12) & 1) + 1, DMA_REPS = ((PROBE2X >> 15) & 1) + 1, CPT_REPS = ((PROBE2X >> 13) & 1) + 1;
constexpr float LOG2E = 1.4426950408889634f, SCALE = 0.08838834764831845f;
constexpr int CE_OFF = 0;
constexpr int KS_OFF = CE_OFF + NQ * CAP * 4, KS_BUF = 128 * 128, KS_NBUF = 3;
static_assert(KS_OFF + KS_NBUF * KS_BUF <= 131072, "indexer scratch inside the 128 KiB overlay");
constexpr int SEL_OFF = 131072;
constexpr int NV_OFF = SEL_OFF + 16384;
constexpr int TB_OFF = NV_OFF + 128;
constexpr int LUT_OFF = TB_OFF + 1024;
constexpr int HI_OFF = LUT_OFF + 128;
constexpr int FLG_OFF = HI_OFF + 8192;
constexpr int DMY_OFF = FLG_OFF + 16;
constexpr int END_OFF = DMY_OFF + 2048;
static_assert(SEL_OFF >= 131072 && END_OFF <= 161024, "DSA LDS map");

typedef short bf16x8 __attribute__((ext_vector_type(8)));
typedef short s16x4 __attribute__((ext_vector_type(4)));
typedef float f32x16 __attribute__((ext_vector_type(16)));
typedef float f32x4 __attribute__((ext_vector_type(4)));
typedef unsigned u32x4 __attribute__((ext_vector_type(4)));
typedef unsigned u32x2 __attribute__((ext_vector_type(2)));

typedef __bf16 bf2_t __attribute__((ext_vector_type(2)));
typedef float f2_t __attribute__((ext_vector_type(2)));
typedef short s2_t __attribute__((ext_vector_type(2)));
__device__ __forceinline__ unsigned pkrelu(float a, float b) { const f2_t v = {a, b}; const s2_t z = {0, 0}; return __builtin_bit_cast(unsigned, __builtin_elementwise_max(__builtin_bit_cast(s2_t, __builtin_convertvector(v, bf2_t)), z)); }
__device__ __forceinline__ unsigned pkbf(float a, float b) { const f2_t v = {a, b}; return __builtin_bit_cast(unsigned, __builtin_convertvector(v, bf2_t)); }
__device__ __forceinline__ unsigned bf_rne(float f) { const unsigned u = __float_as_uint(f); return (u + 0x7fffu + ((u >> 16) & 1u)) >> 16; }
__device__ __forceinline__ unsigned clamp_bf2(unsigned w) { const float lo = fminf(fmaxf(__uint_as_float(w << 16), -448.0f), 448.0f), hh = fminf(fmaxf(__uint_as_float(w & 0xffff0000u), -448.0f), 448.0f); return (__float_as_uint(lo) >> 16) | (__float_as_uint(hh) & 0xffff0000u); }
__device__ __forceinline__ unsigned pk4f8(f32x4 v) { int w = __builtin_amdgcn_cvt_pk_fp8_f32(__builtin_amdgcn_fmed3f(v[0], -448.0f, 448.0f), __builtin_amdgcn_fmed3f(v[1], -448.0f, 448.0f), 0, false);
    return (unsigned)__builtin_amdgcn_cvt_pk_fp8_f32(__builtin_amdgcn_fmed3f(v[2], -448.0f, 448.0f), __builtin_amdgcn_fmed3f(v[3], -448.0f, 448.0f), w, true); }
struct Tensors { const bf16* aiq; const float* small; const bf16* kidx; const unsigned char* ckv8; const unsigned char* qlat8; bf16* olat; };

__device__ __forceinline__ unsigned ord_key(float f) { const unsigned u = __float_as_uint(f); return (u & 0x80000000u) ? ~u : (u | 0x80000000u); }
__device__ __forceinline__ float unord_key(unsigned k) { return __uint_as_float((k & 0x80000000u) ? (k & 0x7fffffffu) : ~k); }
__device__ __forceinline__ unsigned lanemask_lt_pop(unsigned long long m, int lane) { return (unsigned)__popcll(m & ((1ull << lane) - 1ull)); }

template <int CTRL, int RM> __device__ __forceinline__ unsigned dppu(unsigned v, unsigned idn) { return (unsigned)__builtin_amdgcn_update_dpp((int)idn, (int)v, CTRL, RM, 0xf, false); }
__device__ __forceinline__ unsigned wave_incl_scan_add(unsigned v) {
    v += dppu<0x111, 0xf>(v, 0u); v += dppu<0x112, 0xf>(v, 0u); v += dppu<0x114, 0xf>(v, 0u); v += dppu<0x118, 0xf>(v, 0u);
    v += dppu<0x142, 0xa>(v, 0u); v += dppu<0x143, 0xc>(v, 0u); return v; }
__device__ __forceinline__ unsigned wave_min_u32(unsigned v) {
    v = min(v, dppu<0x111, 0xf>(v, 0xffffffffu)); v = min(v, dppu<0x112, 0xf>(v, 0xffffffffu)); v = min(v, dppu<0x114, 0xf>(v, 0xffffffffu)); v = min(v, dppu<0x118, 0xf>(v, 0xffffffffu));
    v = min(v, dppu<0x142, 0xa>(v, 0xffffffffu)); v = min(v, dppu<0x143, 0xc>(v, 0xffffffffu)); return (unsigned)__builtin_amdgcn_readlane((int)v, 63); }
__device__ __forceinline__ unsigned wave_max_u32(unsigned v) {
    v = max(v, dppu<0x111, 0xf>(v, 0u)); v = max(v, dppu<0x112, 0xf>(v, 0u)); v = max(v, dppu<0x114, 0xf>(v, 0u)); v = max(v, dppu<0x118, 0xf>(v, 0u));
    v = max(v, dppu<0x142, 0xa>(v, 0u)); v = max(v, dppu<0x143, 0xc>(v, 0u)); return (unsigned)__builtin_amdgcn_readlane((int)v, 63); }
__device__ __forceinline__ void hist_add(unsigned hist_addr, unsigned bin) { asm volatile("ds_add_u32 %0, %1" :: "v"(hist_addr + bin * 4u), "v"(1u) : "memory"); }
__device__ __forceinline__ void hist_add_if(bool on, unsigned hist_addr, unsigned bin, unsigned dmy_addr) { const unsigned ad = on ? hist_addr + bin * 4u : dmy_addr; asm volatile("ds_add_u32 %0, %1" :: "v"(ad), "v"(1u) : "memory"); }
__device__ __forceinline__ unsigned hist_find(LAS unsigned* hist, unsigned need, int lane, unsigned& nib) {
    asm volatile("s_waitcnt lgkmcnt(0)" ::: "memory");
    const u32x4 c = *(LAS u32x4*)(hist + 4 * (63 - lane));
    const unsigned s = c.x + c.y + c.z + c.w, incl = wave_incl_scan_add(s), excl = incl - s;
    const bool found = (excl < need) && (need <= incl);
    const unsigned long long fm = __ballot(found);
    const int fl = (int)__builtin_ctzll(fm | 0x8000000000000000ull);
    unsigned a = excl; int bin; unsigned nn;
    if (a + c.w >= need) { bin = 3; nn = need - a; } else { a += c.w;
        if (a + c.z >= need) { bin = 2; nn = need - a; } else { a += c.z;
            if (a + c.y >= need) { bin = 1; nn = need - a; } else { a += c.y; bin = 0; nn = need - a; } } }
    bin += 4 * (63 - lane);
    nib = (unsigned)__builtin_amdgcn_readlane((int)nn, fl);
    return (unsigned)__builtin_amdgcn_readlane(bin, fl);
}
#define DSA_LOAD_LIST() unsigned key[EPL];                                                                                      \
    _Pragma("unroll") for (int i = 0; i < EPL; ++i) { const int e = lane + 64 * i; const unsigned kv_ = ce[e < n ? e : 0]; key[i] = e < n ? kv_ : 0u; }
__device__ __forceinline__ float compact_exact(LAS unsigned* ce, LAS unsigned* hist, LAS unsigned* dmy  , int n, int lane) {
    DSA_LOAD_LIST();
    const unsigned haddr = (unsigned)(size_t)hist, daddr = (unsigned)(size_t)dmy;
    unsigned prefix = 0u, pmask = 0u; unsigned need = KSEL;
#pragma unroll 1
    for (int pass = 0; pass < 4; ++pass) {
        const int sh = 24 - 8 * pass;
        *(LAS u32x4*)(hist + 4 * lane) = (u32x4){0u, 0u, 0u, 0u};
        asm volatile("s_waitcnt lgkmcnt(0)" ::: "memory");
#pragma unroll
        for (int i = 0; i < EPL; ++i) hist_add_if(key[i] != 0u && (key[i] & pmask) == prefix, haddr, (key[i] >> sh) & 255u, daddr);
        unsigned nib; const unsigned binu = hist_find(hist, need, lane, nib); need = nib;
        prefix |= binu << sh; pmask |= 0xffu << sh;
    }
    int base = 0; unsigned eqseen = 0u;
#pragma unroll
    for (int i = 0; i < EPL; ++i) {
        const bool gt = key[i] > prefix, eq = key[i] == prefix;
        const unsigned long long meq = __ballot(eq);
        const bool keep = gt || (eq && (eqseen + lanemask_lt_pop(meq, lane)) < need);
        eqseen += (unsigned)__popcll(meq);
        const unsigned long long mk = __ballot(keep);
        const int pos = base + (int)lanemask_lt_pop(mk, lane);
        *(keep ? ce + pos : dmy) = key[i];
        base += (int)__popcll(mk);
    }
    asm volatile("s_waitcnt lgkmcnt(0)" ::: "memory");
    return unord_key((prefix & 0xffffc000u) - 1u);
}
__device__ __forceinline__ float compact_approx(LAS unsigned* ce, LAS unsigned* hist, LAS unsigned* dmy  , int n, int lane, int& n_out) {
    DSA_LOAD_LIST();
    const unsigned haddr = (unsigned)(size_t)hist, daddr = (unsigned)(size_t)dmy;
    unsigned kmn = 0xffffffffu, kmx = 0u;
#pragma unroll
    for (int i = 0; i < EPL; ++i) if (key[i] != 0u) { kmn = min(kmn, key[i]); kmx = max(kmx, key[i]); }
    kmn = wave_min_u32(kmn); kmx = wave_max_u32(kmx);
    const int lz = __builtin_clz((kmx - kmn) | 1u), sh = lz < 24 ? 24 - lz : 0;
    *(LAS u32x4*)(hist + 4 * lane) = (u32x4){0u, 0u, 0u, 0u};
    asm volatile("s_waitcnt lgkmcnt(0)" ::: "memory");
#pragma unroll
    for (int i = 0; i < EPL; ++i) hist_add_if(key[i] != 0u, haddr, (key[i] - kmn) >> sh, daddr);
    unsigned nib; const unsigned b = hist_find(hist, KSEL, lane, nib);
    const unsigned tkey = kmn + (b << sh);
    int base = 0;
#pragma unroll
    for (int i = 0; i < EPL; ++i) {
        const bool keep = key[i] != 0u && key[i] >= tkey;
        const unsigned long long mk = __ballot(keep);
        const int pos = base + (int)lanemask_lt_pop(mk, lane);
        *(keep ? ce + pos : dmy) = key[i];
        base += (int)__popcll(mk);
    }
    asm volatile("s_waitcnt lgkmcnt(0)" ::: "memory");
    n_out = base;
    return unord_key((tkey & 0xffffc000u) - 1u);
}
#undef DSA_LOAD_LIST

__device__ __forceinline__ void init_tables(LAS unsigned char* lds, const float* t5, const int tid) {
    if (tid < 256) ((LAS float*)(lds + TB_OFF))[tid] = t5[tid] * LOG2E;
    if (tid < 128) { int bk = tid; if (tid >= 16) { bk = 16 + (int)floorf(__log2f((float)tid * (1.0f / 16.0f)) * (16.0f / 3.0f)); bk = bk > 31 ? 31 : bk; } ((LAS unsigned char*)(lds + LUT_OFF))[tid] = (unsigned char)bk; }
}

__device__ __forceinline__ void unit(LAS unsigned char* lds, const Tensors& T, int b, int t0, const int tid) {
    const int wid = __builtin_amdgcn_readfirstlane(tid >> 6), lane = tid & 63, r32 = lane & 31, hi = lane >> 5;
    const size_t tokb = (size_t)b * L;
    {
        int tqv[2]; bf16x8 qa[2][4]; bf16x8 wf[2][2];
#pragma unroll
        for (int B = 0; B < 2; ++B) {
            tqv[B] = t0 + 4 * wid + 2 * B + hi;
            const int aq = t0 + 4 * wid + 2 * B + ((r32 >> 2) & 1), ah = (r32 & 3) + 4 * (r32 >> 3);
#pragma unroll
            for (int s = 0; s < 4; ++s) qa[B][s] = *(const bf16x8*)(T.aiq + (tokb + aq) * 1024 + ah * 64 + 16 * s + 8 * hi);
            float w[16];
#pragma unroll
            for (int q4 = 0; q4 < 4; ++q4) { const f32x4 v = *(const f32x4*)(T.small + (tokb + tqv[B]) * 128 + 64 + 4 * q4);
#pragma unroll
                for (int j = 0; j < 4; ++j) w[4 * q4 + j] = v[j] * (0.25f * 0.125f); }
            const bool rh = r32 == 4 * hi, rl = r32 == 4 * hi + 1;
#pragma unroll
            for (int s = 0; s < 2; ++s) { u32x4 pw;
#pragma unroll
                for (int jj = 0; jj < 4; ++jj) { const float a = w[8 * s + 2 * jj], b2 = w[8 * s + 2 * jj + 1]; const unsigned ah2 = bf_rne(a), bh2 = bf_rne(b2);
                    const unsigned al = bf_rne(a - __uint_as_float(ah2 << 16)), bl = bf_rne(b2 - __uint_as_float(bh2 << 16));
                    pw[jj] = rh ? (ah2 | (bh2 << 16)) : (rl ? (al | (bl << 16)) : 0u); }
                wf[B][s] = __builtin_bit_cast(bf16x8, pw); }
        }
        LAS unsigned* ceW = (LAS unsigned*)(lds + CE_OFF) + (4 * wid) * CAP;
        LAS unsigned* ceM0 = ceW + hi * CAP; LAS unsigned* ceM1 = ceW + (2 + hi) * CAP;
        LAS unsigned* hist = (LAS unsigned*)(lds + HI_OFF) + wid * 256;
        LAS unsigned* dmy = (LAS unsigned*)(lds + DMY_OFF) + wid * 64 + lane;
        int cnt0 = 0, cnt1 = 0, cnt2 = 0, cnt3 = 0; float tau0 = -__builtin_inff(), tau1 = tau0, tau2 = tau0, tau3 = tau0, tauv0 = tau0, tauv1 = tau0;
        const int tmax = t0 + NQ - 1, nch = tmax / 128 + 1;
        const int dk = lane >> 3, dpc = lane & 7, k0l = 16 * wid + dk, k1l = k0l + 8;
        const bf16* src0 = T.kidx + (tokb + k0l) * 64 + ((dpc ^ ((k0l >> 1) & 7)) * 8);
        const bf16* src1 = T.kidx + (tokb + k1l) * 64 + ((dpc ^ ((k1l >> 1) & 7)) * 8);
        LAS unsigned char* ring = lds + KS_OFF;
        LAS unsigned* flg = (LAS unsigned*)(lds + FLG_OFF);
#define DMA_CHUNK(c, slot) do { const int cc_ = (c) < nch ? (c) : nch - 1; LAS unsigned char* d_ = ring + (slot) * KS_BUF + wid * 2048;                  \
            __builtin_amdgcn_global_load_lds((const unsigned*)(src0 + (size_t)cc_ * 8192), (LAS unsigned*)d_, 16, 0, 0);                               \
            __builtin_amdgcn_global_load_lds((const unsigned*)(src1 + (size_t)cc_ * 8192), (LAS unsigned*)(d_ + 1024), 16, 0, 0); } while (0)
        int boff[4];
#pragma unroll
        for (int s = 0; s < 4; ++s) boff[s] = r32 * 128 + (((2 * s + hi) ^ ((r32 >> 1) & 7)) << 4);
#pragma unroll 1
        for (int irep = 0; irep < IDX_REPS; ++irep) {
        if (irep) { __syncthreads(); cnt0 = cnt1 = cnt2 = cnt3 = 0; tau0 = tau1 = tau2 = tau3 = tauv0 = tauv1 = -__builtin_inff(); }
        if (tid < 3) flg[tid] = 0u;
        DMA_CHUNK(0, 0); DMA_CHUNK(1, 1);
#define LOADK(kf, tile) do { _Pragma("unroll") for (int s = 0; s < 4; ++s) kf[s] = *(const LAS bf16x8*)(kbuf + (tile) * 4096 + boff[s]); } while (0)
#define MFMA4(acc, B, kf) do { acc = f32x16{}; _Pragma("unroll") for (int s = 0; s < 4; ++s) acc = __builtin_amdgcn_mfma_f32_32x32x16_bf16(qa[B][s], kf[s], acc, 0, 0, 0); } while (0)
#define MFMA8(accP, accQ, kf) do { MFMA4(accP, 0, kf); MFMA4(accQ, 1, kf); } while (0)
#define SB() __builtin_amdgcn_sched_barrier(0)
#define SCORE1(acc, tile, B, tauv_, ceM_, cA_, cB_) do { u32x4 x0_, x1_;                                                                                    \
            x0_.x = pkrelu(acc[0], acc[1]); x0_.y = pkrelu(acc[2], acc[3]); x0_.z = pkrelu(acc[4], acc[5]); x0_.w = pkrelu(acc[6], acc[7]);               \
            x1_.x = pkrelu(acc[8], acc[9]); x1_.y = pkrelu(acc[10], acc[11]); x1_.z = pkrelu(acc[12], acc[13]); x1_.w = pkrelu(acc[14], acc[15]);         \
            f32x16 y_ = __builtin_amdgcn_mfma_f32_32x32x16_bf16(wf[B][0], __builtin_bit_cast(bf16x8, x0_), f32x16{}, 0, 0, 0);                            \
            y_ = __builtin_amdgcn_mfma_f32_32x32x16_bf16(wf[B][1], __builtin_bit_cast(bf16x8, x1_), y_, 0, 0, 0);                                         \
            const float sc = y_[0] + y_[1]; const int key = kbase + (tile) * 32 + r32;                                                                  \
            const bool pass = (key <= tqv[B]) && (sc > tauv_);                                                                                      \
            const unsigned long long pm = __ballot(pass); const unsigned mlo = (unsigned)pm, mhi = (unsigned)(pm >> 32);                            \
            const int nlo_ = (int)__popc(mlo);                                                                                                      \
            const unsigned pos = __builtin_amdgcn_mbcnt_hi(mhi, __builtin_amdgcn_mbcnt_lo(mlo, (unsigned)(hi ? cB_ - nlo_ : cA_)));                  \
            if (pass) ceM_[pos] = (ord_key(sc) & 0xffffc000u) | (unsigned)key;                                                                       \
            cA_ += nlo_; cB_ += (int)__popc(mhi); } while (0)
#define SCORE2(accP, accQ, tile) do { SCORE1(accP, tile, 0, tauv0, ceM0, cnt0, cnt1); SCORE1(accQ, tile, 1, tauv1, ceM1, cnt2, cnt3); } while (0)
#define COMPACT_ROUND() do { asm volatile("s_waitcnt lgkmcnt(0)" ::: "memory");                                                                      \
            _Pragma("nounroll") for (int q_ = 0; q_ < 4; ++q_) { const int cq_ = q_ == 0 ? cnt0 : (q_ == 1 ? cnt1 : (q_ == 2 ? cnt2 : cnt3)); if (cq_ > KSEL) {   \
                LAS unsigned* ce_ = ceW + q_ * CAP; int nn_; float t_ = compact_approx(ce_, hist, dmy, cq_, lane, nn_);   \
                if (nn_ > CAP - 256) { t_ = compact_exact(ce_, hist, dmy, nn_, lane); nn_ = KSEL; }       \
                if (q_ == 0) { tau0 = t_; cnt0 = nn_; } else if (q_ == 1) { tau1 = t_; cnt1 = nn_; } else if (q_ == 2) { tau2 = t_; cnt2 = nn_; } else { tau3 = t_; cnt3 = nn_; } } }   \
            tauv0 = hi ? tau1 : tau0; tauv1 = hi ? tau3 : tau2; } while (0)
#define COMPACT_FINAL() do { asm volatile("s_waitcnt lgkmcnt(0)" ::: "memory");                                                                      \
            _Pragma("nounroll") for (int q_ = 0; q_ < 4; ++q_) { const int cq_ = q_ == 0 ? cnt0 : (q_ == 1 ? cnt1 : (q_ == 2 ? cnt2 : cnt3)); if (cq_ > KSEL) {   \
                compact_exact(ceW + q_ * CAP, hist, dmy, cq_, lane);                                                    \
                if (q_ == 0) cnt0 = KSEL; else if (q_ == 1) cnt1 = KSEL; else if (q_ == 2) cnt2 = KSEL; else cnt3 = KSEL; } } } while (0)
        constexpr int FLAG_LIM = CAP - 160;
        asm volatile("s_waitcnt vmcnt(2) lgkmcnt(0)" ::: "memory"); __builtin_amdgcn_s_barrier(); asm volatile("" ::: "memory");
        DMA_CHUNK(2, 2);
        f32x16 accA0, accA1, accB0, accB1; bf16x8 k0[4], k1[4];
        { const LAS unsigned char* kbuf = ring; LOADK(k0, 0); LOADK(k1, 1); SB(); MFMA8(accA0, accA1, k0); SB(); LOADK(k0, 2); SB(); MFMA8(accB0, accB1, k1); SB(); LOADK(k1, 3); SB(); }
        int slot = 0;
#pragma unroll 1
        for (int ch = 0; ch < nch; ++ch) {
            const int kbase = ch * 128; const int nslot = slot == KS_NBUF - 1 ? 0 : slot + 1;
            const LAS unsigned char* kbuf = ring + nslot * KS_BUF;
            SCORE2(accA0, accA1, 0); MFMA8(accA0, accA1, k0);
            asm volatile("s_waitcnt vmcnt(2) lgkmcnt(0)" ::: "memory");
            __builtin_amdgcn_s_barrier(); asm volatile("" ::: "memory");
            DMA_CHUNK(ch + 3, slot);
            const unsigned fraw = ch == 0 ? 0u : flg[(ch + 2) % 3];
            if (tid == 0) flg[(ch + 1) % 3] = 0u;
            LOADK(k0, 0); SB();
            if (__builtin_amdgcn_readfirstlane((int)fraw)) COMPACT_ROUND();
            SCORE2(accB0, accB1, 1); MFMA8(accB0, accB1, k1); LOADK(k1, 1);
            SCORE2(accA0, accA1, 2); MFMA8(accA0, accA1, k0); LOADK(k0, 2);
            SCORE2(accB0, accB1, 3); MFMA8(accB0, accB1, k1); LOADK(k1, 3);
            if (cnt0 > FLAG_LIM || cnt1 > FLAG_LIM || cnt2 > FLAG_LIM || cnt3 > FLAG_LIM) { if (lane == 0) flg[ch % 3] = 1u; }
            slot = nslot;
        }
        asm volatile("s_waitcnt vmcnt(0) lgkmcnt(0)" ::: "memory");
        COMPACT_FINAL();
        }
#undef DMA_CHUNK
#undef MFMA4
#undef MFMA8
#undef LOADK
#undef SB
#undef SCORE1
#undef SCORE2
#undef COMPACT_ROUND
#undef COMPACT_FINAL
#pragma unroll
        for (int j = 0; j < 4; ++j) { const int cj = j == 0 ? cnt0 : (j == 1 ? cnt1 : (j == 2 ? cnt2 : cnt3));
            LAS unsigned short* selJ = (LAS unsigned short*)(lds + SEL_OFF) + (4 * wid + j) * KSEL; const LAS unsigned* ceJ = ceW + j * CAP;
#pragma unroll
            for (int i = 0; i < 4; ++i) { const int e = lane + 64 * i; selJ[e] = e < cj ? (unsigned short)(ceJ[e] & 0x3fffu) : (unsigned short)0; }
            if (lane == 0) ((LAS int*)(lds + NV_OFF))[4 * wid + j] = cj; }
    }
    __syncthreads();
    {
        int lane_o = lane; asm volatile("" : "+v"(lane_o));
        LAS unsigned char* cbuf = lds + wid * 16384;
        const unsigned cbase = (unsigned)(size_t)cbuf;
        const int head = lane_o & 15, g = lane_o >> 4;
        const LAS float* tb = (const LAS float*)(lds + TB_OFF); const LAS unsigned char* lut = (const LAS unsigned char*)(lds + LUT_OFF);
        constexpr float C2 = SCALE * LOG2E;
#define GATHER(chunk, bufsel) do { _Pragma("unroll") for (int i = 0; i < 8; ++i) { const int kap = 4 * i + g; const int key = (int)sel[(chunk) * 32 + kap]; const int c = head ^ (kap & 15);   \
            __builtin_amdgcn_global_load_lds((const unsigned*)(T.ckv8 + (tokb + key) * 256 + c * 16), (LAS unsigned*)(cbuf + (bufsel) * 8192 + i * 1024), 16, 0, 0); } } while (0)
#pragma unroll 1
        for (int qq = 0; qq < 4 * ATT_REPS; ++qq) { const int qi = qq & 3;
            const int qs = 4 * wid + qi, t = t0 + qs;
            const int nvalid = ((const LAS int*)(lds + NV_OFF))[qs];
            const LAS unsigned short* sel = (const LAS unsigned short*)(lds + SEL_OFF) + qs * KSEL;
            if (qi == 0) GATHER(0, 0);
            long qf[8];
#pragma unroll
            for (int s = 0; s < 8; ++s) { qf[s] = 0; if (head < 8) qf[s] = *(const long*)(T.qlat8 + ((size_t)head * (2 * L) + tokb + t) * 256 + 32 * s + 8 * g); }
            f32x4 o[16];
#pragma unroll
            for (int nb = 0; nb < 16; ++nb) o[nb] = (f32x4){0.f, 0.f, 0.f, 0.f};
            float m_run = -1e30f, l_run = 0.f;
#pragma unroll 1
            for (int ch = 0; ch < 8; ++ch) {
                const int bs = ch & 1;
                if (ch + 1 < 8) { GATHER(ch + 1, bs ^ 1); asm volatile("s_waitcnt vmcnt(8)" ::: "memory"); }
                else if (qi < 3) { const LAS unsigned short* selc = sel; sel = selc + KSEL; GATHER(0, 0); sel = selc; asm volatile("s_waitcnt vmcnt(8)" ::: "memory"); }
                else asm volatile("s_waitcnt vmcnt(0)" ::: "memory");
                const LAS unsigned char* cb = cbuf + bs * 8192;
                f32x4 sa[2];
#pragma unroll
                for (int e = 0; e < 2; ++e) { sa[e] = (f32x4){0.f, 0.f, 0.f, 0.f};
                    const int kap = 8 * ((lane_o & 15) >> 2) + 4 * e + (lane_o & 3); const int x = kap & 15;
                    const LAS unsigned char* rp = cb + kap * 256 + (g & 1) * 8;
#pragma unroll
                    for (int s = 0; s < 8; ++s) { const long a = *(const LAS long*)(rp + (((2 * s + (g >> 1)) ^ x) << 4)); sa[e] = __builtin_amdgcn_mfma_f32_16x16x32_fp8_fp8(a, qf[s], sa[e], 0, 0, 0); } }
                float v[8]; float cmax = -__builtin_inff();
#pragma unroll
                for (int e = 0; e < 2; ++e)
#pragma unroll
                    for (int r = 0; r < 4; ++r) { const int slot = ch * 32 + 8 * g + 4 * e + r; const int key = (int)sel[slot]; const int dist = t - key;
                        const int bk = dist < 128 ? (int)lut[dist < 0 ? 0 : dist] : 31; const float bias = tb[bk * 8 + (head & 7)];
                        const float x = slot < nvalid ? fmaf(sa[e][r], C2, bias) : -__builtin_inff(); v[4 * e + r] = x; cmax = fmaxf(cmax, x); }
                cmax = fmaxf(cmax, __shfl_xor(cmax, 16)); cmax = fmaxf(cmax, __shfl_xor(cmax, 32));
                const float mn = fmaxf(m_run, cmax), alpha = __builtin_amdgcn_exp2f(m_run - mn); m_run = mn;
                float ps = 0.f;
#pragma unroll
                for (int j = 0; j < 8; ++j) { v[j] = __builtin_amdgcn_exp2f(v[j] - mn); ps += v[j]; }
                ps += __shfl_xor(ps, 16); ps += __shfl_xor(ps, 32);
                l_run = l_run * alpha + ps;
#pragma unroll
                for (int nb = 0; nb < 16; ++nb) o[nb] = o[nb] * alpha;
                int plo = __builtin_amdgcn_cvt_pk_fp8_f32(v[0] * 256.0f, v[1] * 256.0f, 0, false); plo = __builtin_amdgcn_cvt_pk_fp8_f32(v[2] * 256.0f, v[3] * 256.0f, plo, true);
                int phi = __builtin_amdgcn_cvt_pk_fp8_f32(v[4] * 256.0f, v[5] * 256.0f, 0, false); phi = __builtin_amdgcn_cvt_pk_fp8_f32(v[6] * 256.0f, v[7] * 256.0f, phi, true);
                const long pf = (long)(((unsigned long long)(unsigned)phi << 32) | (unsigned)plo);
                const int kapv = 8 * g + ((lane_o & 15) >> 1);
                const unsigned av = cbase + bs * 8192 + kapv * 256 + (lane_o & 1) * 8; const unsigned xv = (unsigned)((kapv & 15) << 4);
#pragma unroll
                for (int nh = 0; nh < 2; ++nh) {
                    unsigned long long ar[8];
#pragma unroll
                    for (int i = 0; i < 8; ++i) { const unsigned ad = av + ((unsigned)((8 * nh + i) << 4) ^ xv); asm volatile("ds_read_b64_tr_b8 %0, %1" : "=&v"(ar[i]) : "v"(ad) : "memory"); }
                    asm volatile("s_waitcnt lgkmcnt(0)" ::: "memory"); __builtin_amdgcn_sched_barrier(0);
#pragma unroll
                    for (int i = 0; i < 8; ++i) o[8 * nh + i] = __builtin_amdgcn_mfma_f32_16x16x32_fp8_fp8((long)ar[i], pf, o[8 * nh + i], 0, 0, 0);
                }
            }
            const float rl = 1.0f / (256.0f * l_run);
            if (head < 8) { bf16* op = T.olat + ((size_t)head * (2 * L) + tokb + t) * 256 + 4 * g;
#pragma unroll
                for (int nb = 0; nb < 16; ++nb) { u32x2 w; w.x = pg8::cvt_pk_bf16(o[nb][0] * rl, o[nb][1] * rl); w.y = pg8::cvt_pk_bf16(o[nb][2] * rl, o[nb][3] * rl); *(u32x2*)(op + 16 * nb) = w; } }
        }
#undef GATHER
    }
    __syncthreads();
}
template <int KD, int NBW, bool OUT8 = false>
__device__ __forceinline__ void absorb(const bf16* Wt, const bf16* X, int ldx, bf16* out, int ldo, int tg0, int tg_step, int ntg, int lane, int reps = 1  , float oscale = 1.0f  ) {
    constexpr int KS = KD / 32; const int r16 = lane & 15, g = lane >> 4;
    bf16x8 a[NBW][KS];
#pragma unroll
    for (int nb = 0; nb < NBW; ++nb)
#pragma unroll
        for (int s = 0; s < KS; ++s) a[nb][s] = *(const bf16x8*)(Wt + (size_t)(16 * nb + r16) * KD + 32 * s + 8 * g);
#pragma unroll 1
    for (int tgg = tg0; tgg < ntg * reps; tgg += tg_step) { const int tg = tgg % ntg;
        const size_t tok = (size_t)tg * 16 + r16;
        bf16x8 b[KS];
#pragma unroll
        for (int s = 0; s < KS; ++s) b[s] = *(const bf16x8*)(X + tok * ldx + 32 * s + 8 * g);
#pragma unroll
        for (int nb = 0; nb < NBW; ++nb) { f32x4 acc = (f32x4){0.f, 0.f, 0.f, 0.f};
#pragma unroll
            for (int s = 0; s < KS; ++s) acc = __builtin_amdgcn_mfma_f32_16x16x32_bf16(a[nb][s], b[s], acc, 0, 0, 0);
            if constexpr (OUT8) *(unsigned*)((unsigned char*)out + tok * ldo + 16 * nb + 4 * g) = pk4f8(acc * oscale);
            else { u32x2 w; w.x = pkbf(acc[0], acc[1]); w.y = pkbf(acc[2], acc[3]); *(u32x2*)(out + tok * ldo + 16 * nb + 4 * g) = w; } }
    }
}
template <int KD, int NB, bool OUT8 = false>
__device__ __forceinline__ void absorb_wg(LAS unsigned char* lds, const bf16* Wt, const bf16* X, int ldx, bf16* out, int ldo, int tg_begin, int tg_per_wave, int tid, int reps = 1  , float oscale = 1.0f  ) {
    constexpr int KS = KD / 32, CPR = KD / 8  , ROWB = KD * 2;
    const int wid = __builtin_amdgcn_readfirstlane(tid >> 6), lane = tid & 63, r16 = lane & 15, g = lane >> 4;
#pragma unroll
    for (int i = 0; i < (16 * NB * CPR) / 512; ++i) { const int q = tid + 512 * i, n = q / CPR, c = q % CPR;
        *(LAS u32x4*)(lds + n * ROWB + ((c ^ (n & 15)) << 4)) = *(const u32x4*)(Wt + (size_t)n * KD + c * 8); }
    __syncthreads();
    const unsigned arow0 = (unsigned)(size_t)lds + r16 * ROWB;
    bf16x8 b[KS];
    { const size_t tok = (size_t)(tg_begin + wid * tg_per_wave) * 16 + r16;
#pragma unroll
      for (int s = 0; s < KS; ++s) b[s] = *(const bf16x8*)(X + tok * ldx + 32 * s + 8 * g); }
#pragma unroll 1
    for (int ii = 0; ii < tg_per_wave * reps; ++ii) { const int i = ii % tg_per_wave;
        const size_t tok = (size_t)(tg_begin + wid * tg_per_wave + i) * 16 + r16;
        unsigned arow_u = arow0; asm volatile("" : "+v"(arow_u));
        const LAS unsigned char* arow = (const LAS unsigned char*)(size_t)arow_u;
        bf16x8 bn[KS];
        { const size_t tokn = (size_t)(tg_begin + wid * tg_per_wave + (ii + 1 < tg_per_wave * reps ? (ii + 1) % tg_per_wave : i)) * 16 + r16;
#pragma unroll
          for (int s = 0; s < KS; ++s) bn[s] = *(const bf16x8*)(X + tokn * ldx + 32 * s + 8 * g); }
#pragma unroll
        for (int nb = 0; nb < NB; ++nb) { f32x4 acc = (f32x4){0.f, 0.f, 0.f, 0.f};
#pragma unroll
            for (int s = 0; s < KS; ++s) { const bf16x8 a = *(const LAS bf16x8*)(arow + nb * 16 * ROWB + (((4 * s + g) ^ r16) << 4)); acc = __builtin_amdgcn_mfma_f32_16x16x32_bf16(a, b[s], acc, 0, 0, 0); }
            if constexpr (OUT8) *(unsigned*)((unsigned char*)out + tok * ldo + 16 * nb + 4 * g) = pk4f8(acc * oscale);
            else { u32x2 w; w.x = pkbf(acc[0], acc[1]); w.y = pkbf(acc[2], acc[3]); *(u32x2*)(out + tok * ldo + 16 * nb + 4 * g) = w; } }
#pragma unroll
        for (int s = 0; s < KS; ++s) b[s] = bn[s];
    }
    __syncthreads();
}
}
constexpr int NWAVES = 8;
#ifndef MK_N_LAUNCHES
#define MK_N_LAUNCHES 1
#endif
constexpr int N_PHASES = 10;
constexpr int N_LAUNCHES = MK_N_LAUNCHES;
static_assert(N_LAUNCHES == 1 || N_LAUNCHES == N_PHASES, "MK_N_LAUNCHES is 1 or 10");

constexpr int BATCH = 2, SEQ = 16384, DM = 2048, M = BATCH * SEQ;
constexpr int N_INB = 1536, N_IN8 = 4096;
constexpr int N_IN = 5632;
constexpr int D_IN_SRC = 5464;
constexpr int K_O = 2048;
constexpr int FF = 5632, FF2 = 11264;
constexpr int NHALO = 1024;
constexpr size_t MiB = 1u << 20;
constexpr size_t WS_CTL = 0, CTL_ZERO_BYTES = 1 * MiB;
constexpr size_t WS_WIN = 2 * MiB, WS_WIN8 = 10 * MiB, WS_WO = 28 * MiB, WS_WUP = 40 * MiB, WS_WDN = 84 * MiB;
constexpr size_t WS_SMALL = 106 * MiB, WS_KIDX = 122 * MiB, WS_CKV = 126 * MiB, WS_CUM = 142 * MiB, WS_AHALO = 143 * MiB, WS_UHALO = 147 * MiB;
constexpr size_t WS_WUKT = 36 * MiB, WS_WUVT = 36 * MiB + 512 * 1024;
constexpr size_t WS_H = 192 * MiB;
constexpr size_t WS_OLAT = WS_H;
constexpr size_t WS_H8 = 320 * MiB;
constexpr size_t WS_MIX = 320 * MiB;
constexpr size_t WS_X2B = 320 * MiB;
constexpr size_t WS_AQ = 448 * MiB;
constexpr size_t WS_QLAT = 512 * MiB, WS_AKV = 640 * MiB, WS_AIQ = 656 * MiB, WS_BQ = 720 * MiB, WS_BK = 784 * MiB, WS_BV = 848 * MiB;
constexpr size_t WS_ACT = 512 * MiB;
constexpr size_t WS_END = 912 * MiB;
static_assert(WS_WIN + (size_t)N_INB * DM * 2 <= WS_WIN8 && WS_WIN8 + (size_t)N_IN8 * DM <= WS_WO && WS_WO + (size_t)DM * K_O * 2 <= WS_WUP && WS_WUP + (size_t)FF2 * DM * 2 <= WS_WDN && WS_WDN + (size_t)DM * FF * 2 <= WS_SMALL, "weights map");
static_assert(WS_BK - WS_BQ == WS_BV - WS_BK, "q/k/v spacing");
static_assert(WS_UHALO + (size_t)NHALO * FF2 * 4 <= WS_H && WS_ACT + (size_t)M * FF * 2 <= WS_END, "ws map");
constexpr int CW_TMO = 0, CW_CODE = 1, CW_QUEUE = 64  , CW_NORMQ = 320, CW_NORMK = 384, CW_QBLK = 512  , CW_DMIN = 1536  , CW_BAR = 4096;
constexpr size_t CTL_SS1 = 65536, CTL_SS2 = 65536 + 131072;
constexpr int RING_OFF = 0, RING_BYTES = 131072;
constexpr int LDSCTL_OFF = 161024, MISC_OFF = LDSCTL_OFF + 320;
constexpr int LDS_BYTES = 163840;
static_assert(dsa::END_OFF <= LDSCTL_OFF && MISC_OFF + 128 <= LDS_BYTES && fox::LDS_BYTES <= RING_BYTES, "LDS map");

__device__ __forceinline__ int fresh_lane() { int l; asm volatile("v_mbcnt_lo_u32_b32 %0, -1, 0\n\tv_mbcnt_hi_u32_b32 %0, -1, %0" : "=v"(l)); return l; }
struct Frame {
    LAS unsigned char* lds; volatile LAS unsigned* MISC; gu32* ctl;
    int tid, lane, wave, vcu, G;
    __device__ __forceinline__ void refresh() { lane = fresh_lane(); tid = wave * 64 + lane; }
};
__device__ __forceinline__ float wave_sum(float v) {
#pragma unroll
    for (int o = 1; o < 64; o <<= 1) v += __shfl_xor(v, o);
    return v;
}
__device__ __forceinline__ void p0_transpose_item(const float* W, int ldw, int c0, bf16* WT, int ldt, int r0, int k0, const float* gk, LAS float* scr, int lane) {
#pragma unroll
    for (int i = 0; i < 32; ++i) { const int kk = 2 * i + (lane >> 5); float v = W[(size_t)(k0 + kk) * ldw + c0 + (lane & 31)]; if (gk) v *= gk[k0 + kk]; scr[kk * 33 + (lane & 31)] = v; }
    LDS_WAIT(); asm volatile("" ::: "memory");
    const int c = lane & 7;
#pragma unroll
    for (int j = 0; j < 4; ++j) { const int n = (lane >> 3) + 8 * j; const LAS float* s = scr + (8 * c) * 33 + n;
        v4u o; o.x = pk2(s[0 * 33], s[1 * 33]); o.y = pk2(s[2 * 33], s[3 * 33]); o.z = pk2(s[4 * 33], s[5 * 33]); o.w = pk2(s[6 * 33], s[7 * 33]);
        *(GAS v4u*)(WT + (size_t)(r0 + n) * ldt + k0 + 8 * c) = o; }
    LDS_WAIT(); asm volatile("" ::: "memory");
}
__device__ __forceinline__ float clamp8(float v) { return __builtin_amdgcn_fmed3f(v, -448.0f, 448.0f); }
__device__ __forceinline__ void p0_transpose_item8(const float* W, int ldw, int c0, unsigned char* WT8, int ldt, int r0, int k0, float scale, LAS float* scr, int lane) {
#pragma unroll
    for (int i = 0; i < 32; ++i) { const int kk = 2 * i + (lane >> 5); scr[kk * 33 + (lane & 31)] = W[(size_t)(k0 + kk) * ldw + c0 + (lane & 31)] * scale; }
    LDS_WAIT(); asm volatile("" ::: "memory");
    const int c = lane & 7;
#pragma unroll
    for (int j = 0; j < 4; ++j) { const int n = (lane >> 3) + 8 * j; const LAS float* s = scr + (8 * c) * 33 + n;
        int lo = __builtin_amdgcn_cvt_pk_fp8_f32(s[0 * 33], s[1 * 33], 0, false); lo = __builtin_amdgcn_cvt_pk_fp8_f32(s[2 * 33], s[3 * 33], lo, true);
        int hi = __builtin_amdgcn_cvt_pk_fp8_f32(s[4 * 33], s[5 * 33], 0, false); hi = __builtin_amdgcn_cvt_pk_fp8_f32(s[6 * 33], s[7 * 33], hi, true);
        *(GAS unsigned long long*)(WT8 + (size_t)(r0 + n) * ldt + k0 + 8 * c) = (unsigned long long)(unsigned)lo | ((unsigned long long)(unsigned)hi << 32); }
    LDS_WAIT(); asm volatile("" ::: "memory");
}
__device__ __forceinline__ void fold_item(Frame& F, const float* A, int lda, const float* B, int ldb, bf16* out, int ldo, int row0, int col0) {
    LAS float* As = (LAS float*)(F.lds); LAS float* Bs = (LAS float*)(F.lds + 64 * 129 * 4);
    { const int r = F.tid >> 3, c = (F.tid & 7) * 16;
#pragma unroll
      for (int q = 0; q < 4; ++q) { const f32x4 v = *(const f32x4*)(A + (size_t)r * lda + c + 4 * q); As[r * 129 + c + 4 * q + 0] = v[0]; As[r * 129 + c + 4 * q + 1] = v[1]; As[r * 129 + c + 4 * q + 2] = v[2]; As[r * 129 + c + 4 * q + 3] = v[3]; } }
    { const int r = F.tid >> 2, c = (F.tid & 3) * 16;
#pragma unroll
      for (int q = 0; q < 4; ++q) *(LAS f32x4*)(Bs + r * 64 + c + 4 * q) = *(const f32x4*)(B + (size_t)r * ldb + c + 4 * q); }
    __syncthreads();
    const int j = F.tid & 63, ig = F.tid >> 6; float acc[8];
#pragma unroll
    for (int ii = 0; ii < 8; ++ii) acc[ii] = 0.f;
#pragma unroll 4
    for (int d = 0; d < 128; ++d) { const float bv = Bs[d * 64 + j];
#pragma unroll
        for (int ii = 0; ii < 8; ++ii) acc[ii] = fmaf(As[(8 * ig + ii) * 129 + d], bv, acc[ii]); }
    v4u o; o.x = pk2(acc[0], acc[1]); o.y = pk2(acc[2], acc[3]); o.z = pk2(acc[4], acc[5]); o.w = pk2(acc[6], acc[7]);
    *(GAS v4u*)(out + (size_t)(row0 + j) * ldo + col0 + 8 * ig) = o;
    __syncthreads();
}
struct Inputs { const float *x, *w_in, *kv_g, *w_uk, *w_uv, *t5, *fgb, *w_o, *g1, *g2, *w_up, *conv_w, *conv_b, *w_down, *gf; };

__device__ __forceinline__ void p0_prologue(Frame& F, const Inputs& I, unsigned char* ws) {
    F.refresh();
    bf16* WIN = (bf16*)(ws + WS_WIN); bf16* H = (bf16*)(ws + WS_H);
    bf16* WUKT = (bf16*)(ws + WS_WUKT); bf16* WUVT = (bf16*)(ws + WS_WUVT);
    LAS float* scr = (LAS float*)(F.lds + RING_OFF + F.wave * 16384);
    const int gw = F.vcu * NWAVES + F.wave, NGW = F.G * NWAVES;
    constexpr int I_IN = 170 * 32, I_UK = 8 * 2 * 8, I_UV = 8 * 4 * 4, NIT = I_IN + I_UK + I_UV;
    constexpr int P0R = ((PROBE2X >> 16) & 1) + 1;
    for (int it = gw; it < NIT * P0R; it += NGW) {
        int r = it % NIT;
        if (r < I_IN) { const int cb = r >> 5, kb = r & 31;
            if (cb < 32 || (cb >= 72 && cb < 168)) {
                const int dst = cb < 32 ? cb * 32 : 1024 + (cb - 72) * 32, src = cb < 32 ? cb * 32 : 2384 + (cb - 72) * 32;
                p0_transpose_item8(I.w_in, D_IN_SRC, src, ws + WS_WIN8, DM, dst, kb * 64, pg8::WIN8_SCALE, scr, F.lane); continue; }
            const int dst = cb < 72 ? (cb - 32) * 32 : 1280 + (cb - 168) * 32, src = cb < 72 ? cb * 32 : 2304 + (cb - 168) * 32;
            p0_transpose_item(I.w_in, D_IN_SRC, src, WIN, DM, dst, kb * 64, nullptr, scr, F.lane); continue; }
        r -= I_IN;
        if (r < I_UK) { const int h = r >> 4, kb = (r >> 3) & 1, nb = r & 7;
            p0_transpose_item(I.w_uk + (size_t)h * 128 * 256, 256, nb * 32, WUKT + (size_t)h * 256 * 128, 128, nb * 32, kb * 64, nullptr, scr, F.lane); continue; }
        r -= I_UK;
        { const int h = r >> 4, kb = (r >> 2) & 3, nb = r & 3;
            p0_transpose_item(I.w_uv + (size_t)h * 256 * 128, 128, nb * 32, WUVT + (size_t)h * 128 * 256, 256, nb * 32, kb * 64, nullptr, scr, F.lane); }
    }
    for (int e = (F.vcu * NWAVES + F.wave) * 64 + F.lane; e < 192 * DM; e += NGW * 64) { const int c = 64 + e / DM, k = e % DM;
        float v = 0.f; if (c < 80) v = I.w_in[(size_t)k * D_IN_SRC + 2368 + (c - 64)]; else if (c < 88) v = I.w_in[(size_t)k * D_IN_SRC + 5456 + (c - 80)];
        WIN[(size_t)(1280 + c) * DM + k] = (bf16)f2bf(v); }
    for (int mm = gw; mm < M * P0R; mm += NGW) { const int m = mm % M;
        const GAS f32x4* xr = (const GAS f32x4*)(I.x + (size_t)m * DM) + F.lane; const GAS f32x4* gr = (const GAS f32x4*)I.g1 + F.lane;
        f32x4 v[8]; float s = 0.f;
#pragma unroll
        for (int j = 0; j < 8; ++j) { v[j] = xr[64 * j]; s += (v[j].x * v[j].x + v[j].y * v[j].y) + (v[j].z * v[j].z + v[j].w * v[j].w); }
        const float rstd = __builtin_amdgcn_rsqf(wave_sum(s) * (1.0f / DM) + 1e-6f);
        GAS unsigned long long* o8 = (GAS unsigned long long*)(H + (size_t)m * DM) + F.lane;
#pragma unroll
        for (int j = 0; j < 8; ++j) { const f32x4 g = gr[64 * j]; const float h0 = v[j].x * rstd * g.x, h1 = v[j].y * rstd * g.y, h2 = v[j].z * rstd * g.z, h3 = v[j].w * rstd * g.w;
            o8[64 * j] = (unsigned long long)pk2(h0, h1) | ((unsigned long long)pk2(h2, h3) << 32);
            int w8 = __builtin_amdgcn_cvt_pk_fp8_f32(clamp8(h0 * pg8::H8_SCALE), clamp8(h1 * pg8::H8_SCALE), 0, false); w8 = __builtin_amdgcn_cvt_pk_fp8_f32(clamp8(h2 * pg8::H8_SCALE), clamp8(h3 * pg8::H8_SCALE), w8, true);
            ((GAS int*)(ws + WS_H8 + (size_t)m * DM))[F.lane + 64 * j] = w8; }
    }
}
__device__ __forceinline__ void late_weights(Frame& F, const Inputs& I, unsigned char* ws, int gw, int NGW, bool with_down_only) {
    bf16* WO = (bf16*)(ws + WS_WO); bf16* WUP = (bf16*)(ws + WS_WUP); bf16* WDN = (bf16*)(ws + WS_WDN);
    LAS float* scr = (LAS float*)(F.lds + RING_OFF + F.wave * 16384);
    constexpr int I_O = 32 * 64, I_UP = 352 * 32, I_DN = 88 * 64;
    const int it0 = with_down_only ? I_O + I_UP : 0, it1 = with_down_only ? I_O + I_UP + I_DN : I_O + I_UP;
    for (int it = it0 + gw; it < it1; it += NGW) {
        int r = it;
        if (r < I_O) { const int kb = r >> 6, nb = r & 63; p0_transpose_item8(I.w_o, DM, nb * 32, (unsigned char*)WO, K_O, nb * 32, kb * 64, pg8::WO_SCALE, scr, F.lane); continue; }
        r -= I_O;
        if (r < I_UP) { const int cb = r >> 5, kb = r & 31; const int n0 = cb * 32, j = n0 >> 8, c = n0 & 255; const int src = c < 128 ? 128 * j + c : FF + 128 * j + (c - 128);
            p0_transpose_item(I.w_up, FF2, src, WUP, DM, n0, kb * 64, I.g2, scr, F.lane); continue; }
        r -= I_UP;
        { const int kb = r >> 6, nb = r & 63; p0_transpose_item8(I.w_down, DM, nb * 32, (unsigned char*)WDN, FF, nb * 32, kb * 64, pg8::WDN_SCALE, scr, F.lane); }
    }
}
__device__ __forceinline__ float log_sigmoid(float x) { return x >= 0.f ? -log1pf(expf(-x)) : x - log1pf(expf(x)); }
constexpr int NCUMWG = 16;
__device__ __forceinline__ void p2_misc(Frame& F, const Inputs& I, unsigned char* ws) {
    F.refresh();
    { const int h = F.vcu >> 5, part = F.vcu & 31;
      if (F.G == 256) dsa::absorb_wg<128, 16, true>(F.lds, (const bf16*)(ws + WS_WUKT) + (size_t)h * 256 * 128, (const bf16*)(ws + WS_AQ) + (size_t)h * M * 128, 128, (bf16*)(ws + WS_QLAT + (size_t)h * M * 256), 256, part * 64, 8, F.tid);
      else { const int gw0 = F.vcu * NWAVES + F.wave, combo = gw0 & 31, hh = combo >> 2, qd = combo & 3;
        dsa::absorb<128, 4, true>((const bf16*)(ws + WS_WUKT) + ((size_t)hh * 256 + qd * 64) * 128, (const bf16*)(ws + WS_AQ) + (size_t)hh * M * 128, 128, (bf16*)(ws + WS_QLAT + (size_t)hh * M * 256 + qd * 64), 256, gw0 >> 5, (F.G * NWAVES) >> 5, M / 16, F.lane); } }
    const float* SMALL = (const float*)(ws + WS_SMALL); float* CUM = (float*)(ws + WS_CUM);
    if (F.vcu >= F.G - NCUMWG) {
        const int bh = F.vcu - (F.G - NCUMWG), b = bh >> 3, h = bh & 7; LAS float* tot = (LAS float*)(F.lds);
        const float fb = I.fgb[h];
        const float* sp = SMALL + ((size_t)b * SEQ + (size_t)F.tid * 32) * 128 + 80 + h;
        float lf[32]; float s = 0.f;
#pragma unroll
        for (int k = 0; k < 32; ++k) { lf[k] = log_sigmoid(sp[(size_t)k * 128] + fb); s += lf[k]; }
        tot[F.tid] = s;
        __syncthreads();
        if (F.wave == 0) { float loc[8]; float run = 0.f;
#pragma unroll
            for (int k = 0; k < 8; ++k) { loc[k] = run; run += tot[8 * F.lane + k]; }
            float incl = run;
#pragma unroll
            for (int o = 1; o < 64; o <<= 1) { const float v = __shfl_up(incl, o); if (F.lane >= o) incl += v; }
            const float excl = incl - run;
#pragma unroll
            for (int k = 0; k < 8; ++k) tot[8 * F.lane + k] = excl + loc[k]; }
        __syncthreads();
        float run = tot[F.tid];
        float* cp = CUM + (size_t)bh * SEQ + (size_t)F.tid * 32;
#pragma unroll
        for (int k = 0; k < 32; k += 4) { f32x4 o; run += lf[k]; o[0] = run; run += lf[k + 1]; o[1] = run; run += lf[k + 2]; o[2] = run; run += lf[k + 3]; o[3] = run; *(f32x4*)(cp + k) = o; }
        __syncthreads();
        return;
    }
    const int nwg = F.G - NCUMWG, gw = F.vcu * NWAVES + F.wave, NGW = nwg * NWAVES;
    const bf16* AKV = (const bf16*)(ws + WS_AKV); unsigned char* CKV8 = (unsigned char*)(ws + WS_CKV); bf16* KIDX = (bf16*)(ws + WS_KIDX);
    const f32x4 g4 = *(const f32x4*)(I.kv_g + 4 * F.lane);
    constexpr int P2R = ((PROBE2X >> 17) & 1) + 1;
    for (int mm = gw; mm < M * P2R; mm += 4 * NGW) {
        unsigned long long raw[4]; f32x4 kv[4];
#pragma unroll
        for (int u = 0; u < 4; ++u) { const int m = (mm + u * NGW) % M; raw[u] = *(const GAS unsigned long long*)(AKV + (size_t)m * 256 + 4 * F.lane);
            kv[u] = (f32x4){0.f, 0.f, 0.f, 0.f}; if (F.lane < 16) kv[u] = *(const f32x4*)(SMALL + (size_t)m * 128 + 4 * F.lane); }
#pragma unroll
        for (int u = 0; u < 4; ++u) { if (mm + u * NGW >= M * P2R) break; const int m = (mm + u * NGW) % M;
            const float a0 = __uint_as_float((unsigned)(raw[u] & 0xffffu) << 16), a1 = __uint_as_float((unsigned)((raw[u] >> 16) & 0xffffu) << 16), a2 = __uint_as_float((unsigned)((raw[u] >> 32) & 0xffffu) << 16), a3 = __uint_as_float((unsigned)((raw[u] >> 48) & 0xffffu) << 16);
            const float rstd = __builtin_amdgcn_rsqf(wave_sum((a0 * a0 + a1 * a1) + (a2 * a2 + a3 * a3)) * (1.0f / 256.0f) + 1e-6f);
            { int w8 = __builtin_amdgcn_cvt_pk_fp8_f32(a0 * rstd * g4[0], a1 * rstd * g4[1], 0, false); w8 = __builtin_amdgcn_cvt_pk_fp8_f32(a2 * rstd * g4[2], a3 * rstd * g4[3], w8, true);
              *(GAS unsigned*)(CKV8 + (size_t)m * 256 + 4 * F.lane) = (unsigned)w8; }
            if (F.lane < 16) *(GAS unsigned long long*)(KIDX + (size_t)m * 64 + 4 * F.lane) = (unsigned long long)pk2(kv[u][0], kv[u][1]) | ((unsigned long long)pk2(kv[u][2], kv[u][3]) << 32); }
    }
    for (int itt = gw; itt < 16 * 64 * P2R; itt += NGW) { const int it = itt % 1024; const int bh = it >> 6, ck = it & 63;
        const bf16* qb_ = (const bf16*)(ws + WS_BQ) + ((size_t)bh * SEQ + (size_t)ck * 256) * 128; const bf16* kb_ = (const bf16*)(ws + WS_BK) + ((size_t)bh * SEQ + (size_t)ck * 256) * 128;
        float mq = 0.f, mk = 0.f, dmn = 3.0e38f;
#pragma unroll 4
        for (int i = 0; i < 64; ++i) { const size_t ro = (size_t)(4 * i + (F.lane >> 4)) * 128 + (F.lane & 15) * 8;
            const v4u vq = *(const GAS v4u*)(qb_ + ro), vk = *(const GAS v4u*)(kb_ + ro);
            float sq = 0.f, sk = 0.f, sd = 0.f; const unsigned wq[4] = {vq.x, vq.y, vq.z, vq.w}, wk[4] = {vk.x, vk.y, vk.z, vk.w};
#pragma unroll
            for (int q = 0; q < 4; ++q) { const float ql = __uint_as_float(wq[q] << 16), qh = __uint_as_float(wq[q] & 0xffff0000u), kl = __uint_as_float(wk[q] << 16), kh = __uint_as_float(wk[q] & 0xffff0000u);
                sq += ql * ql + qh * qh; sk += kl * kl + kh * kh; sd += ql * kl + qh * kh; }
#pragma unroll
            for (int o = 1; o < 16; o <<= 1) { sq += __shfl_xor(sq, o); sk += __shfl_xor(sk, o); sd += __shfl_xor(sd, o); }
            mq = fmaxf(mq, sq); mk = fmaxf(mk, sk); dmn = fminf(dmn, sd); }
        mq = fmaxf(mq, __shfl_xor(mq, 16)); mq = fmaxf(mq, __shfl_xor(mq, 32)); mk = fmaxf(mk, __shfl_xor(mk, 16)); mk = fmaxf(mk, __shfl_xor(mk, 32)); dmn = fminf(dmn, __shfl_xor(dmn, 16)); dmn = fminf(dmn, __shfl_xor(dmn, 32));
        if (F.lane == 0) { atomicMax((unsigned*)(F.ctl + CW_NORMK + bh), __float_as_uint(mk)); __hip_atomic_store(F.ctl + CW_QBLK + it, __float_as_uint(mq), RLX_AGENT); __hip_atomic_store(F.ctl + CW_DMIN + it, __float_as_uint(dmn), RLX_AGENT); } }
    late_weights(F, I, ws, gw, NGW, false);
}
constexpr int NFOX = 16 * 64, NDSA = 2 * 512;
constexpr int NFOX_Q = NFOX * (((PROBE2X >> 3) & 1) + 1), NDSA_Q = NDSA * (((PROBE2X >> 9) & 1) + 1);
__device__ __forceinline__ int queue_fetch(Frame& F, int q) {
    if (F.tid == 0) F.MISC[16] = __hip_atomic_fetch_add(F.ctl + CW_QUEUE + 64 * q, 1u, RLX_AGENT);
    __syncthreads(); const int v = __builtin_amdgcn_readfirstlane((int)F.MISC[16]); __syncthreads(); return v;
}
__device__ __forceinline__ fox::BlockRef fox_ref(Frame& F, unsigned char* ws, int id) {
    const int idm = id % NFOX, qb = 63 - (idm >> 4), bh = idm & 15, b = bh >> 3, h = bh & 7;
    fox::BlockRef r;
    r.Q = (const bf16*)(ws + WS_BQ) + ((size_t)bh * SEQ + (size_t)qb * 256) * 128; r.K = (const bf16*)(ws + WS_BK) + (size_t)bh * SEQ * 128; r.V = (const bf16*)(ws + WS_BV) + (size_t)bh * SEQ * 128;
    r.O = (bf16*)(ws + WS_MIX + ((size_t)b * SEQ + (size_t)qb * 256) * K_O + 1024 + h * 128); r.ldo = K_O;
    r.C = (const float*)(ws + WS_CUM) + (size_t)bh * SEQ; r.P0 = qb * 256; r.cref = __uint_as_float(__builtin_amdgcn_readfirstlane(__float_as_uint(r.C[r.P0])));
    const float qn = sqrtf(__uint_as_float(__hip_atomic_load(F.ctl + CW_QBLK + bh * 64 + qb, RLX_AGENT))), kn = sqrtf(__uint_as_float(__hip_atomic_load(F.ctl + CW_NORMK + bh, RLX_AGENT)));
    const float dmn = __uint_as_float(__hip_atomic_load(F.ctl + CW_DMIN + bh * 64 + qb, RLX_AGENT));
    const float lim = __uint_as_float(__builtin_amdgcn_readfirstlane(__float_as_uint(r.cref + 28.5f + (qn * kn - dmn) * fox::SCALE)));
    const int jd = r.P0 / 64; int nf = 0;
    int l4 = F.lane * 4; asm volatile("" : "+v"(l4));
    float cv[4];
#pragma unroll
    for (int i = 0; i < 4; ++i) { const int j = l4 + i; cv[i] = *(const float*)((const char*)r.C + (unsigned)((64 * (j < jd ? j : 0) + 63) * 4)); }
#pragma unroll
    for (int i = 0; i < 4; ++i) { const bool f = (l4 + i < jd) && (cv[i] > lim); nf += (int)__popcll(__ballot(f)); }
    r.jlo = ((PROBE2X >> 20) & 1) ? (nf > 16 ? nf - 16 : 0) : nf;
    return r;
}
__device__ __forceinline__ void p3_fox(Frame& F, unsigned char* ws, int q) {
    F.refresh();
    int id = (int)blockIdx.x; const int G_ = (int)gridDim.x; (void)q;
    if (id < NFOX_Q) {
        fox::Seam S; fox::BlockRef cur = fox_ref(F, ws, id);
        fox::fox_prime(cur, (char*)F.lds, S, F.tid);
        for (;;) {
            id += G_; const int idn = id; const bool more = idn < NFOX_Q;
            const fox::BlockRef nxt = more ? fox_ref(F, ws, idn) : cur;
            fox::fox_block(cur, nxt, SEQ, (char*)F.lds, S, F.tid);
            if (!more) break;
            cur = nxt;
        }
    }
    asm volatile("s_waitcnt vmcnt(0)" ::: "memory"); __syncthreads();
}
__device__ __forceinline__ void p3_dsa(Frame& F, const Inputs& I, unsigned char* ws) {
    F.refresh();
    dsa::init_tables(F.lds, I.t5, F.tid);
    __syncthreads();
    dsa::Tensors T{(const bf16*)(ws + WS_AIQ), (const float*)(ws + WS_SMALL), (const bf16*)(ws + WS_KIDX), (const unsigned char*)(ws + WS_CKV), (const unsigned char*)(ws + WS_QLAT), (bf16*)(ws + WS_OLAT)};
    const int bpref = ((int)blockIdx.x >> 2) & 1;
    _Pragma("nounroll") for (int pass = 0; pass < 2; ++pass) { const int b = bpref ^ pass;
        for (int uq = queue_fetch(F, 2 + b); uq < NDSA_Q / 2; uq = queue_fetch(F, 2 + b)) { const int u = uq % (NDSA / 2); dsa::unit(F.lds, T, b, (511 - u) * 32, F.tid); } }
}
__device__ __forceinline__ void p4_oa(Frame& F, unsigned char* ws) {
    F.refresh();
    const int h = F.vcu >> 5, part = F.vcu & 31;
    if (F.G == 256) { dsa::absorb_wg<256, 8, true>(F.lds, (const bf16*)(ws + WS_WUVT) + (size_t)h * 128 * 256, (const bf16*)(ws + WS_OLAT) + (size_t)h * M * 256, 256, (bf16*)(ws + WS_MIX + h * 128), K_O, part * 64, 8, F.tid, ((PROBE2X >> 18) & 1) + 1, pg8::MIX_SCALE); return; }
    const int gw0 = F.vcu * NWAVES + F.wave, combo = gw0 & 31, hh = combo >> 2, pr = combo & 3;
    dsa::absorb<256, 2, true>((const bf16*)(ws + WS_WUVT) + ((size_t)hh * 128 + pr * 32) * 256, (const bf16*)(ws + WS_OLAT) + (size_t)hh * M * 256, 256, (bf16*)(ws + WS_MIX + hh * 128 + pr * 32), K_O, gw0 >> 5, (F.G * NWAVES) >> 5, M / 16, F.lane, 1, pg8::MIX_SCALE);
}
__device__ __forceinline__ void p8_final(Frame& F, const Inputs& I, float* out, const bf16* x2b) {
    F.refresh();
    const int gw = F.vcu * NWAVES + F.wave, NGW = F.G * NWAVES; const float* ss2 = (const float*)((const unsigned char*)F.ctl + CTL_SS2);
    f32x4 gv[4][2];
    { const GAS f32x4* gr = (const GAS f32x4*)I.gf + 2 * F.lane;
#pragma unroll
      for (int j = 0; j < 4; ++j) { gv[j][0] = gr[128 * j]; gv[j][1] = gr[128 * j + 1]; } }
    v4u vn[4]; float sn = 0.f;
    if (gw < M) { const GAS v4u* xr = (const GAS v4u*)(x2b + (size_t)gw * DM) + F.lane;
#pragma unroll
        for (int j = 0; j < 4; ++j) vn[j] = xr[64 * j];
        sn = ss2[gw]; }
    for (int m = gw; m < M; m += NGW) {
        GAS f32x4* orow = (GAS f32x4*)(out + (size_t)m * DM) + 2 * F.lane;
        v4u vc[4]; const float sc = sn;
#pragma unroll
        for (int j = 0; j < 4; ++j) vc[j] = vn[j];
        if (m + NGW < M) { const GAS v4u* xr = (const GAS v4u*)(x2b + (size_t)(m + NGW) * DM) + F.lane;
#pragma unroll
            for (int j = 0; j < 4; ++j) vn[j] = xr[64 * j];
            sn = ss2[m + NGW]; }
        const float rstd = __builtin_amdgcn_rsqf(sc * (1.0f / DM) + 1e-6f);
#pragma unroll
        for (int j = 0; j < 4; ++j) { const v4u v = vc[j]; const f32x4 g0 = gv[j][0], g1 = gv[j][1];
            const f32x4 a = {__uint_as_float(v.x << 16), __uint_as_float(v.x & 0xffff0000u), __uint_as_float(v.y << 16), __uint_as_float(v.y & 0xffff0000u)};
            const f32x4 b = {__uint_as_float(v.z << 16), __uint_as_float(v.z & 0xffff0000u), __uint_as_float(v.w << 16), __uint_as_float(v.w & 0xffff0000u)};
            orow[128 * j] = a * g0 * rstd; orow[128 * j + 1] = b * g1 * rstd; }
    }
}

struct Args { const float* in[15]; float* out; unsigned char* ws; int ph_lo, ph_hi; };
__global__ void __launch_bounds__(NWAVES * 64, 2) layer_fwd(Args args) {
    extern __shared__ __attribute__((aligned(16))) unsigned char lds[];
    Frame F;
    F.lds = (LAS unsigned char*)lds; F.MISC = (volatile LAS unsigned*)(F.lds + MISC_OFF);
    F.wave = __builtin_amdgcn_readfirstlane((int)threadIdx.x >> 6); F.refresh();
    F.G = gridDim.x; { const int bx = blockIdx.x; F.vcu = (F.G % 8 == 0) ? (bx % 8) * (F.G / 8) + bx / 8 : bx; }
    unsigned char* ws = args.ws; F.ctl = (gu32*)(ws + WS_CTL);
    Inputs I{args.in[0], args.in[1], args.in[2], args.in[3], args.in[4], args.in[5], args.in[6], args.in[7], args.in[8], args.in[9], args.in[10], args.in[11], args.in[12], args.in[13], args.in[14]};
    for (int u = F.tid; u < (LDS_BYTES - LDSCTL_OFF) / 4; u += NWAVES * 64) ((LAS unsigned*)(F.lds + LDSCTL_OFF))[u] = 0u;
    __syncthreads();
    XcdBarrier bar; bar.bar = (unsigned*)(F.ctl + CW_BAR); bar.x = 0; bar.st = nullptr;
    if (N_LAUNCHES == 1) bar = xcd_barrier_post((unsigned*)(F.ctl + CW_BAR), F.MISC + 8, F.tid == 0);
    const int lo = args.ph_lo, hi = args.ph_hi;
#ifndef PH_MASK
#define PH_MASK 0x3ff
#endif
#define IN(k) (((PH_MASK >> (k)) & 1) && lo <= (k) && (k) < hi)
#define SEAM(k) do { if (IN(k) && IN((k) + 1)) xcd_barrier(bar, F.wave * 64 + fresh_lane() == 0); } while (0)
    float* SS1 = (float*)((unsigned char*)F.ctl + CTL_SS1); float* SS2 = (float*)((unsigned char*)F.ctl + CTL_SS2);
    if (IN(0)) { p0_prologue(F, I, ws); SEAM(0); }
    if (IN(1)) {
        { pg8::Gemm g{(const pg8::bf16_t*)(ws + WS_H), (const pg8::bf16_t*)(ws + WS_WIN), M, N_INB, DM}; pg8::StaticOrder S; S.init(M, N_INB, F.G, (int)blockIdx.x, ((PROBE2X >> 1) & 1) + 1);
          pg8::EpiInProj E{(pg8::bf16_t*)(ws + WS_AQ), (pg8::bf16_t*)(ws + WS_AKV), (pg8::bf16_t*)(ws + WS_AIQ), (pg8::bf16_t*)(ws + WS_BQ), (size_t)(WS_BK - WS_BQ) / 2, (float*)(ws + WS_SMALL)};
          pg8::gemm_phase<pg8::EpiInProj, pg8::StaticOrder, true, true>(F.lds + RING_OFF, g, S, E, F.wave * 64 + fresh_lane()); }
        { pg8::Gemm g{(const pg8::bf16_t*)(ws + WS_H8), (const pg8::bf16_t*)(ws + WS_WIN8), M, N_IN8, DM / 2}; pg8::StaticOrder S; S.init(M, N_IN8, F.G, (int)blockIdx.x, ((PROBE2X >> 1) & 1) + 1);
          pg8::EpiInProj8 E{(pg8::bf16_t*)(ws + WS_AQ), (pg8::bf16_t*)(ws + WS_AKV), (pg8::bf16_t*)(ws + WS_AIQ), (pg8::bf16_t*)(ws + WS_BQ), (size_t)(WS_BK - WS_BQ) / 2, (float*)(ws + WS_SMALL)};
          pg8::gemm_phase<pg8::EpiInProj8, pg8::StaticOrder, true, true, true>(F.lds + RING_OFF, g, S, E, F.wave * 64 + fresh_lane()); }
        SEAM(1);
    }
    if (IN(2)) { p2_misc(F, I, ws); SEAM(2); }
    if (IN(3)) {
        _Pragma("nounroll") for (int rep = 0; rep < 1; ++rep) p3_fox(F, ws, rep);
        p3_dsa(F, I, ws);
        SEAM(3);
    }
    if (IN(4)) { _Pragma("nounroll") for (int rep = 0; rep < ((PROBE2X >> 18) & 1) + 1; ++rep) { if (rep) xcd_barrier(bar, F.wave * 64 + fresh_lane() == 0); p4_oa(F, ws); } SEAM(4); }
    if (IN(5)) {
        pg8::Gemm g{(const pg8::bf16_t*)(ws + WS_MIX), (const pg8::bf16_t*)(ws + WS_WO), M, DM, K_O / 2}; pg8::StaticOrder S; S.init(M, DM, F.G, (int)blockIdx.x);
        pg8::EpiOutProj E{I.x, (pg8::bf16_t*)(ws + WS_H), (pg8::bf16_t*)(ws + WS_AHALO), SS1};
        pg8::gemm_phase<pg8::EpiOutProj, pg8::StaticOrder, true, true, true>(F.lds + RING_OFF, g, S, E, F.wave * 64 + fresh_lane());
        SEAM(5);
    }
    if (IN(6)) {
        pg8::Gemm g{(const pg8::bf16_t*)(ws + WS_AHALO), (const pg8::bf16_t*)(ws + WS_WUP), NHALO, FF2, DM}; pg8::StaticOrder S; S.init(NHALO, FF2, F.G, (int)blockIdx.x);
        pg8::EpiHalo E{SS1, (float*)(ws + WS_UHALO)};
        pg8::gemm_phase<pg8::EpiHalo, pg8::StaticOrder, true, true>(F.lds + RING_OFF, g, S, E, F.wave * 64 + fresh_lane());
        constexpr int NHU = (NHALO / 256) * (FF2 / 256);
        if ((int)blockIdx.x >= NHU) { F.refresh(); late_weights(F, I, ws, ((int)blockIdx.x - NHU) * NWAVES + F.wave, ((int)gridDim.x - NHU) * NWAVES, true); }
        SEAM(6);
    }
    if (IN(7)) {
        pg8::Gemm g{(const pg8::bf16_t*)(ws + WS_H), (const pg8::bf16_t*)(ws + WS_WUP), M, FF2, DM}; pg8::StaticOrder S; S.init(M, FF2, F.G, (int)blockIdx.x, ((PROBE2X >> 6) & 1) + 1);
        pg8::EpiUp E{SS1, (const float*)(ws + WS_UHALO), I.conv_w, I.conv_b, ws + WS_ACT};
        pg8::gemm_phase<pg8::EpiUp, pg8::StaticOrder, true, true>(F.lds + RING_OFF, g, S, E, F.wave * 64 + fresh_lane());
        SEAM(7);
    }
    if (IN(8)) {
        pg8::Gemm g{(const pg8::bf16_t*)(ws + WS_ACT), (const pg8::bf16_t*)(ws + WS_WDN), M, DM, FF / 2}; pg8::StaticOrder S; S.init(M, DM, F.G, (int)blockIdx.x);
        pg8::EpiDown E{(const pg8::bf16_t*)(ws + WS_H), (pg8::bf16_t*)(ws + WS_X2B), SS2};
        pg8::gemm_phase<pg8::EpiDown, pg8::StaticOrder, true, true, true>(F.lds + RING_OFF, g, S, E, F.wave * 64 + fresh_lane());
        SEAM(8);
    }
    if (IN(9)) p8_final(F, I, args.out, (const bf16*)(ws + WS_X2B));
#undef IN
#undef SEAM
}

extern "C" void kernel_launch(void* const* d_in, const int* in_sizes, int n_in, void* d_out, int out_size, void* d_ws, size_t ws_size, hipStream_t stream) {
    static int grid = 0;
    if (grid == 0) {
        if (n_in != 15 || in_sizes[0] != M * DM || out_size != M * DM || ws_size < WS_END) { fprintf(stderr, "kernel_launch: unexpected shapes (n_in %d, in0 %d, out %d, ws %zu)\n", n_in, n_in > 0 ? in_sizes[0] : -1, out_size, ws_size); grid = -1; return; }
        int dev = 0, cus = 0, per_cu = 0;
        if (hipGetDevice(&dev) != hipSuccess || hipDeviceGetAttribute(&cus, hipDeviceAttributeMultiprocessorCount, dev) != hipSuccess) { grid = -1; return; }
        if (hipFuncSetAttribute((const void*)layer_fwd, hipFuncAttributeMaxDynamicSharedMemorySize, LDS_BYTES) != hipSuccess) { fprintf(stderr, "kernel_launch: hipFuncSetAttribute failed\n"); grid = -1; return; }
        if (hipOccupancyMaxActiveBlocksPerMultiprocessor(&per_cu, (const void*)layer_fwd, NWAVES * 64, LDS_BYTES) != hipSuccess || per_cu < 1) fprintf(stderr, "kernel_launch: occupancy query reports %d\n", per_cu);
        (void)hipGetLastError();
        grid = cus;
    }
    if (grid < 0) return;
    if (hipMemsetAsync((char*)d_ws + WS_CTL, 0, CTL_ZERO_BYTES, stream) != hipSuccess) return;
    Args a{};
    for (int i = 0; i < 15; ++i) a.in[i] = (const float*)d_in[i];
    a.out = (float*)d_out; a.ws = (unsigned char*)d_ws;
    for (int li = 0; li < N_LAUNCHES; ++li) {
        a.ph_lo = (N_LAUNCHES == 1) ? 0 : li; a.ph_hi = (N_LAUNCHES == 1) ? N_PHASES : li + 1;
        hipLaunchKernelGGL(layer_fwd, dim3(grid), dim3(NWAVES * 64), LDS_BYTES, stream, a);
        if (hipPeekAtLastError() != hipSuccess) { fprintf(stderr, "kernel_launch: launch %d failed\n", li); break; }
    }
}
```

```cpp
#include <hip/hip_runtime.h>
#include <cstdio>
#include <cstdint>
#ifndef PROBE2X
#define PROBE2X 0
#endif
namespace pg8 {
#define PG8_LAS __attribute__((address_space(3)))
typedef unsigned short bf16_t;
typedef short bf16x8 __attribute__((ext_vector_type(8)));
typedef float f32x4 __attribute__((ext_vector_type(4)));
typedef unsigned u32x4 __attribute__((ext_vector_type(4)));
typedef int i32x4 __attribute__((ext_vector_type(4)));
typedef int i32x8 __attribute__((ext_vector_type(8)));
constexpr float MIX_SCALE = 32.0f, WO_SCALE = 1024.0f;
__device__ __forceinline__ i32x8 cat8(bf16x8 a, bf16x8 b) { const i32x4 x = (i32x4)a, y = (i32x4)b; return __builtin_shufflevector(x, y, 0, 1, 2, 3, 4, 5, 6, 7); }
constexpr int BM = 256, BK = 64, HALF = 128, HTB = HALF * BK * 2  , STAGE_BYTES = 8 * HTB, NXCD = 8, WGM = 8;

__host__ __device__ __forceinline__ int lds_byte(int r, int c) { const int st = (r >> 4) * 2 + (c >> 5), rr = r & 15, cc = c & 31, ob = rr * 64 + cc * 2; return st * 1024 + (ob ^ (((ob >> 9) & 1) << 5)); }
__host__ __device__ __forceinline__ void stage_rc(int b, int& R, int& C) { const int st = b / 1024, sb = b % 1024, swz = sb ^ (((sb >> 9) & 1) << 5); R = (st >> 1) * 16 + swz / 64; C = (st & 1) * 32 + (swz % 64) / 2; }
__host__ __device__ __forceinline__ int perm32(int rho) { const int n = rho >> 4, i = rho & 15; return 8 * (i >> 2) + 4 * n + (i & 3); }

struct Unit { int pm, pn; };
struct Gemm { const bf16_t* A; const bf16_t* Bt; int M, N, K; };

struct StaticOrder {
    int nM, nN, nwg, G, c, reps;
    __host__ __device__ void init(int M, int N, int G_, int c_, int reps_ = 1) { nM = M / BM; nN = N / BM; nwg = nM * nN; G = G_; c = c_; reps = reps_; }
    __host__ __device__ bool next(int i, Unit& u) const {
        const long L = (long)i * G + c; if (L >= (long)nwg * reps) return false;
        int wgid = (int)(L % nwg); { const int q = nwg / NXCD, r = nwg % NXCD, xcd = wgid % NXCD, off = wgid / NXCD; wgid = (xcd < r ? xcd * (q + 1) : r * (q + 1) + (xcd - r) * q) + off; }
        const int nig = WGM * nN, gid = wgid / nig, fm = gid * WGM, gsz = (nM - fm) < WGM ? (nM - fm) : WGM;
        u.pm = fm + ((wgid % nig) % gsz); u.pn = (wgid % nig) / gsz; return true;
    }
    __device__ __forceinline__ void a_ready(const Unit&) const {}
    __device__ __forceinline__ void done(const Unit&) const {}
};

__device__ __forceinline__ unsigned cvt_pk_bf16(float lo, float hi) { unsigned r; asm volatile("v_cvt_pk_bf16_f32 %0, %1, %2" : "=v"(r) : "v"(lo), "v"(hi)); return r; }
__device__ __forceinline__ u32x4 pack8bf(const f32x4 v0, const f32x4 v1) { u32x4 w; w.x = cvt_pk_bf16(v0[0], v0[1]); w.y = cvt_pk_bf16(v0[2], v0[3]); w.z = cvt_pk_bf16(v1[0], v1[1]); w.w = cvt_pk_bf16(v1[2], v1[3]); return w; }
__device__ __forceinline__ float dot4(const f32x4 a) { return (a[0] * a[0] + a[1] * a[1]) + (a[2] * a[2] + a[3] * a[3]); }
template <int CTRL> __device__ __forceinline__ float dppf(float v) { return __builtin_bit_cast(float, __builtin_amdgcn_update_dpp(0, __builtin_bit_cast(int, v), CTRL, 0xf, 0xf, false)); }

constexpr float H8_SCALE = 16.0f, WIN8_SCALE = 1024.0f;
template <bool F8>
struct EpiInProjT {
    static constexpr bool PERM = true, AFTER_DRAIN = false;
    bf16_t *aq, *akv, *aiq, *bq; size_t qkv_stride; float* small;
    __device__ __forceinline__ void operator()(const f32x4 (&acc0)[2][2][4][2], const Unit& u, int wr, int wc, int fr, int fq) const {
        const int pn = F8 ? (u.pn < 4 ? u.pn : u.pn + 5) : (u.pn == 5 ? 21 : u.pn + 4), row0 = u.pm * BM + wr * 64 + fr, cl = wc * 32 + 8 * fq;
        f32x4 acc[2][2][4][2];
#pragma unroll
        for (int a = 0; a < 2; ++a)
#pragma unroll
            for (int b = 0; b < 2; ++b)
#pragma unroll
                for (int m = 0; m < 4; ++m)
#pragma unroll
                    for (int n = 0; n < 2; ++n) acc[a][b][m][n] = F8 ? acc0[a][b][m][n] * (1.0f / (H8_SCALE * WIN8_SCALE)) : acc0[a][b][m][n];
        if (pn < 4) {
#pragma unroll
            for (int ai = 0; ai < 2; ++ai)
#pragma unroll
                for (int m = 0; m < 4; ++m) { const int row = row0 + ai * HALF + m * 16;
#pragma unroll
                    for (int bj = 0; bj < 2; ++bj) *(u32x4*)(aq + ((size_t)(2 * pn + bj) * 32768 + row) * 128 + cl) = pack8bf(acc[ai][bj][m][0], acc[ai][bj][m][1]); }
        } else if (pn < 9) {
            bf16_t* dst; int ld, cb;
            if (pn == 4) { dst = akv; ld = 256; cb = 0; } else { dst = aiq; ld = 1024; cb = (pn - 5) * 256; }
#pragma unroll
            for (int ai = 0; ai < 2; ++ai)
#pragma unroll
                for (int m = 0; m < 4; ++m) { bf16_t* rowp = dst + (size_t)(row0 + ai * HALF + m * 16) * ld + cb + cl;
#pragma unroll
                    for (int bj = 0; bj < 2; ++bj) *(u32x4*)(rowp + bj * HALF) = pack8bf(acc[ai][bj][m][0], acc[ai][bj][m][1]); }
        } else if (pn < 21) {
            const int w = (pn - 9) >> 2, hp = (pn - 9) & 3; bf16_t* dst = bq + (size_t)w * qkv_stride;
#pragma unroll
            for (int ai = 0; ai < 2; ++ai)
#pragma unroll
                for (int m = 0; m < 4; ++m) { const int row = row0 + ai * HALF + m * 16, b = row >> 14, t = row & 16383;
#pragma unroll
                    for (int bj = 0; bj < 2; ++bj) *(u32x4*)(dst + ((size_t)(b * 8 + 2 * hp + bj) * 16384 + t) * 128 + cl) = pack8bf(acc[ai][bj][m][0], acc[ai][bj][m][1]); }
        } else {
#pragma unroll
            for (int ai = 0; ai < 2; ++ai)
#pragma unroll
                for (int m = 0; m < 4; ++m) { float* rp = small + (size_t)(row0 + ai * HALF + m * 16) * 128 + cl; *(f32x4*)rp = acc[ai][0][m][0]; *(f32x4*)(rp + 4) = acc[ai][0][m][1]; }
        }
    }
};
typedef EpiInProjT<false> EpiInProj; typedef EpiInProjT<true> EpiInProj8;
struct EpiOutProj {
    static constexpr bool PERM = true, AFTER_DRAIN = false;
    const float* x; bf16_t* x1b; bf16_t* ahalo; float* ss;
    __device__ __forceinline__ void operator()(const f32x4 (&acc)[2][2][4][2], const Unit& u, int wr, int wc, int fr, int fq) const {
        const int row0 = u.pm * BM + wr * 64 + fr, col0 = u.pn * BM + wc * 32 + 8 * fq;
#pragma unroll
        for (int ai = 0; ai < 2; ++ai) {
            f32x4 xv[4][2][2];
#pragma unroll
            for (int m = 0; m < 4; ++m)
#pragma unroll
                for (int bj = 0; bj < 2; ++bj) { const size_t o = (size_t)(row0 + ai * HALF + m * 16) * 2048 + col0 + bj * HALF; xv[m][bj][0] = *(const f32x4*)(x + o); xv[m][bj][1] = *(const f32x4*)(x + o + 4); }
#pragma unroll
            for (int m = 0; m < 4; ++m) { const int row = row0 + ai * HALF + m * 16; float s = 0.f;
#pragma unroll
                for (int bj = 0; bj < 2; ++bj) { const size_t o = (size_t)row * 2048 + col0 + bj * HALF;
                    const f32x4 v0 = xv[m][bj][0] + acc[ai][bj][m][0] * (1.0f / (MIX_SCALE * WO_SCALE)), v1 = xv[m][bj][1] + acc[ai][bj][m][1] * (1.0f / (MIX_SCALE * WO_SCALE));
                    const u32x4 w = pack8bf(v0, v1); *(u32x4*)(x1b + o) = w;
                    if ((row & 63) >= 62) *(u32x4*)(ahalo + (size_t)(2 * (row >> 6) + (row & 1)) * 2048 + col0 + bj * HALF) = w;
                    s += dot4(v0) + dot4(v1); }
                s += __shfl_xor(s, 16); s += __shfl_xor(s, 32);
                if (fq == 0) unsafeAtomicAdd(ss + row, s); } }
    }
};
struct EpiHalo {
    static constexpr bool PERM = true, AFTER_DRAIN = false;
    const float* ss; float* uh;
    __device__ __forceinline__ void operator()(const f32x4 (&acc)[2][2][4][2], const Unit& u, int wr, int wc, int fr, int fq) const {
        const int row0 = u.pm * BM + wr * 64 + fr, col0 = u.pn * BM + wc * 32 + 8 * fq;
        float rsv[2][4];
#pragma unroll
        for (int ai = 0; ai < 2; ++ai)
#pragma unroll
            for (int m = 0; m < 4; ++m) { const int hr = row0 + ai * HALF + m * 16, src = 64 * (hr >> 1) + 62 + (hr & 1); rsv[ai][m] = ss[src]; }
#pragma unroll
        for (int ai = 0; ai < 2; ++ai)
#pragma unroll
            for (int m = 0; m < 4; ++m) { const int hr = row0 + ai * HALF + m * 16;
                const float rs = __builtin_amdgcn_rsqf(rsv[ai][m] * (1.0f / 2048.0f) + 1e-6f);
#pragma unroll
                for (int bj = 0; bj < 2; ++bj) { float* p = uh + (size_t)hr * 11264 + col0 + bj * HALF; *(f32x4*)p = acc[ai][bj][m][0] * rs; *(f32x4*)(p + 4) = acc[ai][bj][m][1] * rs; } }
    }
};
constexpr float ACT_SCALE = 16.0f, WDN_SCALE = 1024.0f;
struct EpiUp {
    static constexpr bool PERM = true, AFTER_DRAIN = false;
    const float* ss; const float* uh; const float* cw; const float* cbias; unsigned char* act;
    __device__ __forceinline__ void operator()(const f32x4 (&acc)[2][2][4][2], const Unit& u, int wr, int wc, int fr, int fq) const {
        const int pn = u.pn, cl = wc * 32 + 8 * fq, rowb0 = u.pm * BM + wr * 64;
        unsigned pk[2][4];
        const unsigned long long m15 = __ballot(fr == 15), m14 = __ballot(fr >= 14);
        float rsv[2][4];
#pragma unroll
        for (int ai = 0; ai < 2; ++ai)
#pragma unroll
            for (int m = 0; m < 4; ++m) rsv[ai][m] = ss[rowb0 + ai * HALF + m * 16 + fr];
#pragma unroll
        for (int ai = 0; ai < 2; ++ai)
#pragma unroll
            for (int m = 0; m < 4; ++m) rsv[ai][m] = __builtin_amdgcn_rsqf(rsv[ai][m] * (1.0f / 2048.0f) + 1e-6f);
#pragma unroll
        for (int n = 0; n < 2; ++n) {
            f32x4 w0[2], w1[2], w2[2], bb[2];
#pragma unroll
            for (int bj = 0; bj < 2; ++bj) { const int oc = bj * 5632 + pn * 128 + cl + 4 * n;
                w0[bj] = *(const f32x4*)(cw + oc); w1[bj] = *(const f32x4*)(cw + 11264 + oc); w2[bj] = *(const f32x4*)(cw + 22528 + oc); bb[bj] = *(const f32x4*)(cbias + oc); }
            f32x4 prevh[2][2];
#pragma unroll
            for (int ai = 0; ai < 2; ++ai) { const int rb = rowb0 + ai * HALF;
                prevh[ai][0] = prevh[ai][1] = (f32x4){0.f, 0.f, 0.f, 0.f};
                if ((rb & 16383) != 0 && fr >= 14) { const int hr = 2 * ((rb >> 6) - 1) + (fr - 14);
#pragma unroll
                    for (int bj = 0; bj < 2; ++bj) prevh[ai][bj] = *(const f32x4*)(uh + (size_t)hr * 11264 + pn * 256 + bj * HALF + cl + 4 * n); } }
#pragma unroll
            for (int ai = 0; ai < 2; ++ai) {
                const int rb = rowb0 + ai * HALF;
                f32x4 prev[2] = {prevh[ai][0], prevh[ai][1]};
#pragma unroll
                for (int m = 0; m < 4; ++m) {
                    const int row = rb + m * 16 + fr; const float rs = rsv[ai][m];
                    f32x4 y[2];
#pragma unroll
                    for (int bj = 0; bj < 2; ++bj) { const f32x4 uc = acc[ai][bj][m][n] * rs;
#pragma unroll
                        for (int j = 0; j < 4; j += 2) {
                            float ya = fmaf(w2[bj][j], uc[j], bb[bj][j]), yb = fmaf(w2[bj][j + 1], uc[j + 1], bb[bj][j + 1]); float t0, t1, r0, r1;
                            asm("v_cndmask_b32_e64 %2, %6, %8, %10\n\tv_cndmask_b32_e64 %3, %7, %9, %10\n\tv_cndmask_b32_e64 %4, %6, %8, %11\n\tv_cndmask_b32_e64 %5, %7, %9, %11\n\t"
                                "v_fmac_f32_dpp %0, %2, %12 row_ror:1 row_mask:0xf bank_mask:0xf\n\tv_fmac_f32_dpp %1, %3, %13 row_ror:1 row_mask:0xf bank_mask:0xf\n\t"
                                "v_fmac_f32_dpp %0, %4, %14 row_ror:2 row_mask:0xf bank_mask:0xf\n\tv_fmac_f32_dpp %1, %5, %15 row_ror:2 row_mask:0xf bank_mask:0xf"
                                : "+v"(ya), "+v"(yb), "=&v"(t0), "=&v"(t1), "=&v"(r0), "=&v"(r1)
                                : "v"(uc[j]), "v"(uc[j + 1]), "v"(prev[bj][j]), "v"(prev[bj][j + 1]), "s"(m15), "s"(m14), "v"(w1[bj][j]), "v"(w1[bj][j + 1]), "v"(w0[bj][j]), "v"(w0[bj][j + 1]));
                            y[bj][j] = ya; y[bj][j + 1] = yb; }
                        prev[bj] = uc; }
                    float a[4];
#pragma unroll
                    for (int j = 0; j < 4; ++j) { const float g = y[0][j]; a[j] = g * __builtin_amdgcn_rcpf(1.0f + __builtin_amdgcn_exp2f(-1.4426950408889634f * g)) * y[1][j]; }
#pragma unroll
                    for (int j = 0; j < 4; ++j) a[j] = __builtin_amdgcn_fmed3f(a[j] * ACT_SCALE, -448.0f, 448.0f);
                    int w8 = __builtin_amdgcn_cvt_pk_fp8_f32(a[0], a[1], 0, false); w8 = __builtin_amdgcn_cvt_pk_fp8_f32(a[2], a[3], w8, true); asm volatile("" : "+v"(w8));
                    if (n == 0) pk[ai][m] = (unsigned)w8;
                    else *(unsigned long long*)(act + (size_t)row * 5632 + pn * 128 + cl) = (unsigned long long)pk[ai][m] | ((unsigned long long)(unsigned)w8 << 32);
                }
            }
        }
    }
};
struct EpiDown {
    static constexpr bool PERM = true, AFTER_DRAIN = false;
    const bf16_t* xin; bf16_t* xout; float* ss;
    __device__ __forceinline__ void operator()(const f32x4 (&acc)[2][2][4][2], const Unit& u, int wr, int wc, int fr, int fq) const {
        const int row0 = u.pm * BM + wr * 64 + fr, col0 = u.pn * BM + wc * 32 + 8 * fq;
#pragma unroll
        for (int ai = 0; ai < 2; ++ai) {
            u32x4 xbv[4][2];
#pragma unroll
            for (int m = 0; m < 4; ++m)
#pragma unroll
                for (int bj = 0; bj < 2; ++bj) xbv[m][bj] = *(const u32x4*)(xin + (size_t)(row0 + ai * HALF + m * 16) * 2048 + col0 + bj * HALF);
#pragma unroll
            for (int m = 0; m < 4; ++m) { const int row = row0 + ai * HALF + m * 16; float s = 0.f;
#pragma unroll
                for (int bj = 0; bj < 2; ++bj) { const size_t o = (size_t)row * 2048 + col0 + bj * HALF;
                    const u32x4 xb = xbv[m][bj];
                    const f32x4 x0 = {__uint_as_float(xb.x << 16), __uint_as_float(xb.x & 0xffff0000u), __uint_as_float(xb.y << 16), __uint_as_float(xb.y & 0xffff0000u)}, x1 = {__uint_as_float(xb.z << 16), __uint_as_float(xb.z & 0xffff0000u), __uint_as_float(xb.w << 16), __uint_as_float(xb.w & 0xffff0000u)};
                    const f32x4 v0 = x0 + acc[ai][bj][m][0] * (1.0f / (ACT_SCALE * WDN_SCALE)), v1 = x1 + acc[ai][bj][m][1] * (1.0f / (ACT_SCALE * WDN_SCALE));
                    *(u32x4*)(xout + o) = pack8bf(v0, v1); s += dot4(v0) + dot4(v1); }
                s += __shfl_xor(s, 16); s += __shfl_xor(s, 32);
                if (fq == 0) unsafeAtomicAdd(ss + row, s); } }
    }
};
template <class Epi, class Sched, bool ALIGN_EPI = false, bool SP2 = false, bool FP8 = false>
__device__ __forceinline__ void gemm_phase(PG8_LAS unsigned char* lds, const Gemm g, const Sched& S, const Epi& E, const int tid  ) {
    const int wid = __builtin_amdgcn_readfirstlane(tid >> 6), lane = tid & 63, wr = wid >> 2, wc = wid & 3, fr = lane & 15, fq = lane >> 4;
    const int K = g.K, nt = K / BK;
    unsigned voffA[2], voffB[2];
#pragma unroll
    for (int i = 0; i < 2; ++i) { int R, C; stage_rc(tid * 16 + i * 8192, R, C); const int Rb = Epi::PERM ? ((R & ~31) + perm32(R & 31)) : R;
        voffA[i] = (unsigned)(R * K + C) * 2u; voffB[i] = (unsigned)(Rb * K + C) * 2u; }
    const size_t kstep = (size_t)(BK * 2);
    const size_t hstep = (size_t)HALF * K * 2;
    const size_t tstep = 2 * hstep;
    const unsigned ldsw = (unsigned)wid * 1024u;
    const int aoff = lds_byte(wr * 64 + fr, fq * 8), boff = lds_byte(wc * 32 + fr, fq * 8);
#define PG8_SA(b, h) (((b) * 2 + (h)) * HTB)
#define PG8_SB(b, h) ((4 + (b) * 2 + (h)) * HTB)
#define PG8_STAGE(bufoff, gbase, voff) do { const char* _gb = (const char*)(gbase); if constexpr (FP8) asm volatile("" : "+s"(_gb));     \
        _Pragma("unroll") for (int _i = 0; _i < 2; ++_i) \
        __builtin_amdgcn_global_load_lds((const unsigned*)(_gb + (voff)[_i]), (PG8_LAS unsigned*)(lds + (bufoff) + ldsw + _i * 8192), 16, 0, 0); } while (0)
#define PG8_LDA(dst, b, h) do { _Pragma("unroll") for (int m = 0; m < 4; ++m) _Pragma("unroll") for (int k = 0; k < 2; ++k) dst[m][k] = *(const PG8_LAS bf16x8*)(lds + PG8_SA(b, h) + aoff + m * 2048 + k * 1024); } while (0)
#define PG8_LDB(dst, b, h) do { _Pragma("unroll") for (int n = 0; n < 2; ++n) _Pragma("unroll") for (int k = 0; k < 2; ++k) dst[n][k] = *(const PG8_LAS bf16x8*)(lds + PG8_SB(b, h) + boff + n * 2048 + k * 1024); } while (0)
#define PG8_MMA(ai, bj, At, Bt) do { __builtin_amdgcn_s_setprio(1); \
        if constexpr (FP8) { _Pragma("unroll") for (int m = 0; m < 4; ++m) _Pragma("unroll") for (int n = 0; n < 2; ++n) \
            acc[ai][bj][m][n] = __builtin_amdgcn_mfma_scale_f32_16x16x128_f8f6f4(cat8(Bt[n][0], Bt[n][1]), cat8(At[m][0], At[m][1]), acc[ai][bj][m][n], 0, 0, 0, 0, 0, 0); } \
        else { _Pragma("unroll") for (int m = 0; m < 4; ++m) _Pragma("unroll") for (int n = 0; n < 2; ++n) _Pragma("unroll") for (int k = 0; k < 2; ++k) \
            acc[ai][bj][m][n] = __builtin_amdgcn_mfma_f32_16x16x32_bf16(Bt[n][k], At[m][k], acc[ai][bj][m][n], 0, 0, 0); } \
        __builtin_amdgcn_s_setprio(0); } while (0)
#define PG8_WAIT_V(n) asm volatile("s_waitcnt vmcnt(" #n ")" ::: "memory")
#define PG8_WAIT_L(n) asm volatile("s_waitcnt lgkmcnt(" #n ")" ::: "memory")
#define PG8_BAR __builtin_amdgcn_s_barrier()
#define PG8_SCHED __builtin_amdgcn_sched_barrier(0)
    Unit cur, nxt; int ui = 0;
    if (!S.next(0, cur)) return;
    f32x4 acc[2][2][4][2];
#pragma unroll
    for (int a = 0; a < 2; ++a)
#pragma unroll
        for (int b = 0; b < 2; ++b)
#pragma unroll
            for (int m = 0; m < 4; ++m)
#pragma unroll
                for (int n = 0; n < 2; ++n) acc[a][b][m][n] = (f32x4){0.f, 0.f, 0.f, 0.f};
    bf16x8 At[4][2], B0[2][2], B1[2][2];
    const char* cA = (const char*)g.A + (size_t)cur.pm * tstep; const char* cB = (const char*)g.Bt + (size_t)cur.pn * tstep;
    S.a_ready(cur);
    if constexpr (SP2) {
        PG8_STAGE(PG8_SB(0, 0), cB, voffB); PG8_STAGE(PG8_SB(0, 1), cB + hstep, voffB); PG8_STAGE(PG8_SA(0, 0), cA, voffA); PG8_STAGE(PG8_SA(0, 1), cA + hstep, voffA);
        if (wr == 1) PG8_BAR;
        PG8_WAIT_V(2); PG8_BAR;
        PG8_STAGE(PG8_SB(1, 0), cB + kstep, voffB); PG8_STAGE(PG8_SA(1, 0), cA + kstep, voffA); PG8_STAGE(PG8_SB(1, 1), cB + hstep + kstep, voffB);
        PG8_WAIT_V(6); PG8_BAR;
    } else {
        PG8_STAGE(PG8_SB(0, 0), cB, voffB); PG8_STAGE(PG8_SA(0, 0), cA, voffA); PG8_STAGE(PG8_SB(0, 1), cB + hstep, voffB); PG8_STAGE(PG8_SA(0, 1), cA + hstep, voffA);
        if (wr == 1) PG8_BAR;
        PG8_WAIT_V(4); PG8_BAR;
        PG8_STAGE(PG8_SB(1, 0), cB + kstep, voffB); PG8_STAGE(PG8_SA(1, 0), cA + kstep, voffA); PG8_STAGE(PG8_SB(1, 1), cB + hstep + kstep, voffB);
        PG8_WAIT_V(6); PG8_BAR;
    }
    for (;;) {
        const bool has_next = S.next(ui + 1, nxt);
        const char* nA = has_next ? (const char*)g.A + (size_t)nxt.pm * tstep : cA; const char* nB = has_next ? (const char*)g.Bt + (size_t)nxt.pn * tstep : cB;
        for (int t = 0; t < nt; t += 2) {
            const bool last = (t == nt - 2);
            const char* a1 = cA + (size_t)(t + 1) * kstep;
            const char* a2 = last ? nA : cA + (size_t)(t + 2) * kstep; const char* b2 = last ? nB : cB + (size_t)(t + 2) * kstep;
            const char* a3 = a2 + kstep; const char* b3 = b2 + kstep;
            if (last && has_next) S.a_ready(nxt);
            if constexpr (SP2) {
            PG8_LDB(B0, 0, 0); PG8_LDB(B1, 0, 1); PG8_SCHED; PG8_LDA(At, 0, 0); PG8_STAGE(PG8_SA(1, 1), a1 + hstep, voffA);
            PG8_WAIT_V(8); PG8_WAIT_L(0); PG8_BAR; PG8_MMA(0, 0, At, B0); PG8_MMA(0, 1, At, B1); PG8_BAR; PG8_SCHED;
            PG8_LDA(At, 0, 1); PG8_STAGE(PG8_SB(0, 0), b2, voffB); PG8_STAGE(PG8_SB(0, 1), b2 + hstep, voffB); PG8_STAGE(PG8_SA(0, 0), a2, voffA);
            PG8_WAIT_V(8); PG8_WAIT_L(0); PG8_BAR; PG8_MMA(1, 0, At, B0); PG8_MMA(1, 1, At, B1); PG8_BAR; PG8_SCHED;
            PG8_LDB(B0, 1, 0); PG8_LDB(B1, 1, 1); PG8_SCHED; PG8_LDA(At, 1, 0); PG8_STAGE(PG8_SA(0, 1), a2 + hstep, voffA);
            PG8_WAIT_V(8); PG8_WAIT_L(0); PG8_BAR; PG8_MMA(0, 0, At, B0); PG8_MMA(0, 1, At, B1); PG8_BAR; PG8_SCHED;
            PG8_LDA(At, 1, 1); PG8_STAGE(PG8_SB(1, 0), b3, voffB); PG8_STAGE(PG8_SB(1, 1), b3 + hstep, voffB); PG8_STAGE(PG8_SA(1, 0), a3, voffA);
            PG8_WAIT_V(8); PG8_WAIT_L(0); PG8_BAR; PG8_MMA(1, 0, At, B0); PG8_MMA(1, 1, At, B1); PG8_BAR; PG8_SCHED;
            } else {
            PG8_LDB(B0, 0, 0); PG8_SCHED; PG8_LDA(At, 0, 0); PG8_STAGE(PG8_SA(1, 1), a1 + hstep, voffA);
            PG8_WAIT_L(8); PG8_BAR; PG8_WAIT_L(0); PG8_MMA(0, 0, At, B0); PG8_BAR; PG8_SCHED;
            PG8_LDB(B1, 0, 1); PG8_STAGE(PG8_SB(0, 0), b2, voffB);
            PG8_BAR; PG8_WAIT_L(0); PG8_MMA(0, 1, At, B1); PG8_BAR;
            PG8_LDA(At, 0, 1); PG8_STAGE(PG8_SA(0, 0), a2, voffA);
            PG8_BAR; PG8_WAIT_L(0); PG8_MMA(1, 0, At, B0); PG8_BAR; PG8_SCHED;
            PG8_STAGE(PG8_SB(0, 1), b2 + hstep, voffB);
            PG8_WAIT_V(6); PG8_BAR; PG8_MMA(1, 1, At, B1); PG8_BAR;
            PG8_LDB(B0, 1, 0); PG8_SCHED; PG8_LDA(At, 1, 0); PG8_STAGE(PG8_SA(0, 1), a2 + hstep, voffA);
            PG8_WAIT_L(8); PG8_BAR; PG8_WAIT_L(0); PG8_MMA(0, 0, At, B0); PG8_BAR; PG8_SCHED;
            PG8_LDB(B1, 1, 1); PG8_STAGE(PG8_SB(1, 0), b3, voffB);
            PG8_BAR; PG8_WAIT_L(0); PG8_MMA(0, 1, At, B1); PG8_BAR;
            PG8_LDA(At, 1, 1); PG8_STAGE(PG8_SA(1, 0), a3, voffA);
            PG8_BAR; PG8_WAIT_L(0); PG8_MMA(1, 0, At, B0); PG8_BAR; PG8_SCHED;
            PG8_STAGE(PG8_SB(1, 1), b3 + hstep, voffB);
            PG8_WAIT_V(6); PG8_BAR; PG8_MMA(1, 1, At, B1); PG8_BAR;
            }
        }
        if constexpr (ALIGN_EPI) { if (wr == 0) PG8_BAR; }
        if constexpr (!Epi::AFTER_DRAIN) {
            if constexpr (FP8) { int l2 = lane; asm volatile("" : "+v"(l2)); E(acc, cur, wr, wc, l2 & 15, l2 >> 4); }
            else E(acc, cur, wr, wc, fr, fq);
            S.done(cur); }
        if (!has_next) break;
#pragma unroll
        for (int a = 0; a < 2; ++a)
#pragma unroll
            for (int b = 0; b < 2; ++b)
#pragma unroll
                for (int m = 0; m < 4; ++m)
#pragma unroll
                    for (int n = 0; n < 2; ++n) acc[a][b][m][n] = (f32x4){0.f, 0.f, 0.f, 0.f};
        cur = nxt; cA = nA; cB = nB; ++ui;
        if constexpr (ALIGN_EPI) { if (wr == 1) PG8_BAR; }
    }
    PG8_WAIT_V(0);
    if constexpr (!ALIGN_EPI) { if (wr == 0) PG8_BAR; }
    PG8_BAR;
    if constexpr (Epi::AFTER_DRAIN) { E.fused(acc, cur, wr, wc, fr, fq, lds, wid, lane); S.done(cur); }
#undef PG8_SA
#undef PG8_SB
#undef PG8_STAGE
#undef PG8_LDA
#undef PG8_LDB
#undef PG8_MMA
#undef PG8_WAIT_V
#undef PG8_WAIT_L
#undef PG8_BAR
#undef PG8_SCHED
}
}
#define GAS __attribute__((address_space(1)))
#define LAS __attribute__((address_space(3)))
typedef unsigned short bf16;
typedef unsigned v4u __attribute__((ext_vector_type(4)));
typedef float f32x4 __attribute__((ext_vector_type(4)));
typedef short bf16x8 __attribute__((ext_vector_type(8)));
typedef GAS unsigned gu32;
typedef GAS unsigned long long gu64;
#define RLX_AGENT __ATOMIC_RELAXED, __HIP_MEMORY_SCOPE_AGENT
#define LDS_WAIT() asm volatile("s_waitcnt lgkmcnt(0)" ::: "memory")
#define VM_WAIT() asm volatile("s_waitcnt vmcnt(0)" ::: "memory")
__device__ __forceinline__ unsigned long long rt() { return __builtin_amdgcn_s_memrealtime(); }
__device__ __forceinline__ unsigned f2bf(float f) { unsigned u = __builtin_bit_cast(unsigned, f); return (u + 0x7fffu + ((u >> 16) & 1u)) >> 16; }
__device__ __forceinline__ unsigned pk2(float lo, float hi) { return f2bf(lo) | (f2bf(hi) << 16); }

#define XB_TMO      128
#define XB_XCNT(j)  (256  + 64 * (j))
#define XB_XSUB(j)  (1280 + 64 * (j))
#define XB_XGEN(j)  (2304 + 64 * (j))
#define XB_TOP      3328
#define XB_TOPGEN   3392
#define XCD_BAR_WORDS 3456
#define XB_SPIN_CAP (1u << 18)

__device__ __forceinline__ unsigned xb_ld(unsigned* p)              { return __hip_atomic_load(p, __ATOMIC_RELAXED, __HIP_MEMORY_SCOPE_AGENT); }
__device__ __forceinline__ unsigned xb_add(unsigned* p, unsigned v) { return __hip_atomic_fetch_add(p, v, __ATOMIC_RELAXED, __HIP_MEMORY_SCOPE_AGENT); }
__device__ __forceinline__ unsigned xb_xcc_id() { return (unsigned)__builtin_amdgcn_s_getreg((3 << 11) | 20) & 0xFu; }
#define XB_SPIN(cond, bar) do { unsigned _sp = 0; while (cond) { __builtin_amdgcn_s_sleep(1); \
    if ((++_sp & 255u) == 0u) { if (xb_ld(&(bar)[XB_TMO])) break; if (_sp > XB_SPIN_CAP) { atomicAdd(&(bar)[XB_TMO], 1u); break; } } } } while (0)

struct XcdBarrier {
    unsigned* bar; unsigned x;
    volatile LAS unsigned* st;
};

__device__ __forceinline__ XcdBarrier xcd_barrier_post(unsigned* bar, volatile LAS unsigned* st, const bool xb_t0  ) {
    XcdBarrier b; b.bar = bar; b.x = xb_xcc_id(); b.st = st;
    if (xb_t0) (void)xb_add(&bar[XB_XCNT(b.x)], 1u);
    return b;
}
__device__ __forceinline__ void xcd_barrier_complete(unsigned* bar, unsigned x, unsigned& nloc, unsigned& nx) {
    const unsigned G = gridDim.x * gridDim.y * gridDim.z;
    unsigned sum, cnt, mine, sp = 0u;
    for (;;) {
        sum = 0u; cnt = 0u; mine = 0u;
#pragma unroll
        for (unsigned j = 0; j < 16; ++j) { const unsigned c = xb_ld(&bar[XB_XCNT(j)]); sum += c; cnt += (c > 0u) ? 1u : 0u; mine = (j == x) ? c : mine; }
        if (sum == G) break;
        __builtin_amdgcn_s_sleep(1);
        if ((++sp & 255u) == 0u) { if (xb_ld(&bar[XB_TMO])) break; if (sp > XB_SPIN_CAP) { atomicAdd(&bar[XB_TMO], 1u); break; } }
    }
    nloc = mine > 0u ? mine : 1u; nx = cnt > 0u ? cnt : 1u;
}

__device__ __forceinline__ void xcd_barrier(const XcdBarrier& b, const bool xb_t0) {
    asm volatile("s_waitcnt vmcnt(0)" ::: "memory");
    __syncthreads();
    if (xb_t0) {
        unsigned* bar = b.bar;
        __builtin_amdgcn_s_waitcnt(0);
        unsigned nloc = b.st[0], nx = b.st[1];
        if (nloc == 0u) { xcd_barrier_complete(bar, b.x, nloc, nx); b.st[0] = nloc; b.st[1] = nx; }
        const unsigned old = xb_add(&bar[XB_XSUB(b.x)], 1u);
        const unsigned gen = old / nloc;
        if (old + 1u == (gen + 1u) * nloc) {
            __builtin_amdgcn_fence(__ATOMIC_RELEASE, "agent");
            asm volatile("s_waitcnt vmcnt(0)" ::: "memory");
            const unsigned og = xb_add(&bar[XB_TOP], 1u);
            const unsigned tg = og / nx;
            if (og + 1u == (tg + 1u) * nx) xb_add(&bar[XB_TOPGEN], 1u);
            else XB_SPIN(xb_ld(&bar[XB_TOPGEN]) == tg, bar);
            __builtin_amdgcn_fence(__ATOMIC_ACQUIRE, "agent");
            xb_add(&bar[XB_XGEN(b.x)], 1u);
            asm volatile("s_waitcnt vmcnt(0)" ::: "memory");
        } else {
            XB_SPIN(xb_ld(&bar[XB_XGEN(b.x)]) == gen, bar);
            __builtin_amdgcn_fence(__ATOMIC_ACQUIRE, "agent");
            asm volatile("s_waitcnt vmcnt(0)" ::: "memory");
        }
    }
    __syncthreads();
}
namespace fox {
constexpr int D = 128;
constexpr float SCALE = 0.08838834764831845f, LOG2E = 1.4426950408889634f;
constexpr float THR = 8.f;
constexpr int NW = 8, QBLK = 32, KVBLK = 64, QB = NW * QBLK;
constexpr int SHM_V = KVBLK * D * 2, SHM_K = KVBLK * D * 2;
constexpr int CB_OFF = 2 * SHM_V + 2 * SHM_K, WS_OFF = CB_OFF + 512;
constexpr int LDS_BYTES = WS_OFF + NW * 64 * 4;
constexpr unsigned WINF = 0x7fffffffu;
constexpr int LDO = 2048;

typedef unsigned short bf16;
typedef short bf16x8 __attribute__((ext_vector_type(8)));
typedef short s16x4 __attribute__((ext_vector_type(4)));
typedef float f32x16 __attribute__((ext_vector_type(16)));
typedef float f32x4 __attribute__((ext_vector_type(4)));
typedef unsigned u32x4 __attribute__((ext_vector_type(4)));
typedef unsigned u32x2 __attribute__((ext_vector_type(2)));

#define KSWZ(row, colB) ((row) * 256 + ((colB) ^ (((row) & 7) << 4)))
#define SBAR() __builtin_amdgcn_sched_barrier(0)
__device__ __forceinline__ int v_st(int k, int c) { const int kk = (k & ~0xC) | ((k & 4) << 1) | ((k & 8) >> 1); return ((kk >> 3) * 4 + (c >> 5)) * 512 + ((kk & 7) * 32 + (c & 31)) * 2; }
__device__ __forceinline__ int v_rd_base(int lane) { return ((lane & 3) << 3) | (((lane >> 2) & 3) << 6) | (((lane >> 4) & 1) << 5) | (((lane >> 5) & 1) << 8); }
constexpr int v_rd_off(int d0, int ks, int half) { return d0 * 512 + ks * 4096 + half * 2048; }
__device__ __forceinline__ int crow(int r, int hi) { return (r & 3) + 8 * (r >> 2) + 4 * hi; }
__device__ __forceinline__ unsigned cvtpk(float lo, float hi) { unsigned r; asm volatile("v_cvt_pk_bf16_f32 %0, %1, %2" : "=v"(r) : "v"(lo), "v"(hi)); return r; }
__device__ __forceinline__ bf16x8 load8(const bf16* p) { return *reinterpret_cast<const bf16x8*>(p); }
__device__ __forceinline__ void mask_tile(f32x16& p0, f32x16& p1, int dq, unsigned W) {
    const float NEG = -__builtin_inff();
#pragma unroll
    for (int r = 0; r < 16; ++r) {
        const int c = (r & 3) + 8 * (r >> 2);
        if ((unsigned)(dq - c) >= W) p0[r] = NEG;
        if ((unsigned)(dq - c - 32) >= W) p1[r] = NEG;
    }
}
__device__ __forceinline__ void partialSM(f32x16& p0, f32x16& p1, float& m_reg, float& mn, float& alpha) {
    float pmax = p0[0]; for (int r = 1; r < 16; ++r) pmax = fmaxf(pmax, p0[r]); for (int r = 0; r < 16; ++r) pmax = fmaxf(pmax, p1[r]);
    { auto rr = __builtin_amdgcn_permlane32_swap(__float_as_uint(pmax), __float_as_uint(pmax), false, false);
      pmax = fmaxf(__uint_as_float(rr[0]), __uint_as_float(rr[1])); }
    constexpr float C2 = LOG2E * SCALE;
    if (__builtin_expect(__all((pmax - m_reg) * SCALE <= THR), 1)) { mn = m_reg; alpha = 1.f; }
    else { mn = fmaxf(m_reg, pmax); alpha = __builtin_amdgcn_exp2f((m_reg - mn) * C2); m_reg = mn; }
    const float mnL = -mn * C2;
    for (int r = 0; r < 16; ++r) p0[r] = fmaf(p0[r], C2, mnL); for (int r = 0; r < 16; ++r) p1[r] = fmaf(p1[r], C2, mnL);
    for (int r = 0; r < 16; ++r) p0[r] = __builtin_amdgcn_exp2f(p0[r]);
}
__device__ __forceinline__ void finishSM(f32x16& p0, f32x16& p1, float alpha, float& l_reg, bf16x8& pa0, bf16x8& pa1, bf16x8& pa2, bf16x8& pa3) {
    for (int r = 0; r < 16; ++r) p1[r] = __builtin_amdgcn_exp2f(p1[r]);
    float ps = 0; for (int r = 0; r < 16; ++r) ps += p0[r]; for (int r = 0; r < 16; ++r) ps += p1[r];
    { auto rr = __builtin_amdgcn_permlane32_swap(__float_as_uint(ps), __float_as_uint(ps), false, false);
      ps = __uint_as_float(rr[0]) + __uint_as_float(rr[1]); }
    l_reg = l_reg * alpha + ps;
#define PK4(P, B_, OUT) do { unsigned a0 = cvtpk(P[B_+0], P[B_+1]), a1 = cvtpk(P[B_+2], P[B_+3]);                          \
        unsigned b0 = cvtpk(P[B_+4], P[B_+5]), b1 = cvtpk(P[B_+6], P[B_+7]);                                             \
        auto r0 = __builtin_amdgcn_permlane32_swap(a0, b0, false, false); auto r1 = __builtin_amdgcn_permlane32_swap(a1, b1, false, false); \
        u32x4 w = {r0[0], r1[0], r0[1], r1[1]}; OUT = *reinterpret_cast<bf16x8*>(&w); } while (0)
    PK4(p0, 0, pa0); PK4(p0, 8, pa1); PK4(p1, 0, pa2); PK4(p1, 8, pa3);
#undef PK4
}
template <int KB>
__device__ __forceinline__ void qkt(f32x16& p0, f32x16& p1, const char* K_lds, const float* cb, int r32, int hi, const bf16x8* qr) {
#pragma unroll
    for (int g = 0; g < 4; ++g) { const f32x4 b0 = *(const f32x4*)(cb + 8 * g + 4 * hi), b1 = *(const f32x4*)(cb + 32 + 8 * g + 4 * hi);
#pragma unroll
        for (int j = 0; j < 4; ++j) { p0[4 * g + j] = b0[j]; p1[4 * g + j] = b1[j]; } }
    const char* kb[4];
#pragma unroll
    for (int dd = 0; dd < 4; ++dd) kb[dd] = K_lds + KB * SHM_K + KSWZ(r32, (dd * 16 + hi * 8) * 2);
#pragma unroll
    for (int d0 = 0; d0 < 8; ++d0) { const char* a = kb[d0 & 3] + (d0 >> 2) * 128;
        bf16x8 b0 = *reinterpret_cast<const bf16x8*>(a);
        bf16x8 b1 = *reinterpret_cast<const bf16x8*>(a + 32 * 256);
        p0 = __builtin_amdgcn_mfma_f32_32x32x16_bf16(b0, qr[d0], p0, 0, 0, 0);
        p1 = __builtin_amdgcn_mfma_f32_32x32x16_bf16(b1, qr[d0], p1, 0, 0, 0); }
}
template <int VB>
__device__ __forceinline__ void pv_tile(f32x16* o, int vb0, bf16x8 pa0, bf16x8 pa1, bf16x8 pa2, bf16x8 pa3) {
#define TRRD(dst, off) asm volatile("ds_read_b64_tr_b16 %0, %1 offset:%2" : "=&v"(dst) : "v"(vb0), "i"(off) : "memory")
#define PV_D0(d0) do { s16x4 l0, l1, l2, l3, h0, h1, h2, h3; constexpr int b_ = VB * SHM_V + v_rd_off(d0, 0, 0);     \
        TRRD(l0, b_); TRRD(h0, b_ + 2048); TRRD(l1, b_ + 4096); TRRD(h1, b_ + 6144); TRRD(l2, b_ + 8192); TRRD(h2, b_ + 10240); TRRD(l3, b_ + 12288); TRRD(h3, b_ + 14336); \
        asm volatile("s_waitcnt lgkmcnt(0)" ::: "memory"); SBAR();             \
        o[d0] = __builtin_amdgcn_mfma_f32_32x32x16_bf16((bf16x8){l0[0], l0[1], l0[2], l0[3], h0[0], h0[1], h0[2], h0[3]}, pa0, o[d0], 0, 0, 0);   \
        o[d0] = __builtin_amdgcn_mfma_f32_32x32x16_bf16((bf16x8){l1[0], l1[1], l1[2], l1[3], h1[0], h1[1], h1[2], h1[3]}, pa1, o[d0], 0, 0, 0);   \
        o[d0] = __builtin_amdgcn_mfma_f32_32x32x16_bf16((bf16x8){l2[0], l2[1], l2[2], l2[3], h2[0], h2[1], h2[2], h2[3]}, pa2, o[d0], 0, 0, 0);   \
        o[d0] = __builtin_amdgcn_mfma_f32_32x32x16_bf16((bf16x8){l3[0], l3[1], l3[2], l3[3], h3[0], h3[1], h3[2], h3[3]}, pa3, o[d0], 0, 0, 0); } while (0)
    PV_D0(0); PV_D0(1); PV_D0(2); PV_D0(3);
#undef PV_D0
#undef TRRD
}

struct BlockRef { const bf16* Q; const bf16* K; const bf16* V; bf16* O; const float* C; float cref; int P0, jlo, ldo; };
struct Seam { bf16x8 qr[8]; bf16x8 st_v0, st_v1, st_k0, st_k1; float st_c; };
#define ROW(p, k0, rr) ((const bf16*)((const char*)(p) + (unsigned)((((k0) + (rr)) * D + sc) * 2)))
#define VMW() asm volatile("s_waitcnt vmcnt(0)" ::: "memory")
#define VMWN(n) asm volatile("s_waitcnt vmcnt(%0)" :: "i"(n) : "memory")
#define SLOAD_H(Kp, Vp, Cp, k0) do { S.st_v0 = load8(ROW(Vp, k0, sr)); S.st_v1 = load8(ROW(Vp, k0, 32 + sr));              \
                         S.st_k0 = load8(ROW(Kp, k0, sr)); S.st_k1 = load8(ROW(Kp, k0, 32 + sr));                          \
                         if (tid < 64) S.st_c = *(const float*)((const char*)(Cp) + (unsigned)(((k0) + tid) * 4)); } while (0)
#define SWRITE_HK(bf, cref_) do { *(bf16x8*)(K_lds + (bf) * SHM_K + kws) = S.st_k0; *(bf16x8*)(K_lds + (bf) * SHM_K + kws + 32 * 256) = S.st_k1; \
                         if (tid < 64) *(float*)(C_lds + (bf) * 256 + tid * 4) = ((cref_) - S.st_c) * (1.0f / SCALE); } while (0)
#define SWRITE_HV(bf) do { *(bf16x8*)(V_lds + (bf) * SHM_V + vst0) = S.st_v0; *(bf16x8*)(V_lds + (bf) * SHM_V + vst1) = S.st_v1; } while (0)
#define SWRITE_H(bf, cref_) do { SWRITE_HV(bf); SWRITE_HK(bf, cref_); } while (0)
__device__ __forceinline__ void fox_prime(const BlockRef& cur, char* lds, Seam& S, const int tid) {
    const int wid = __builtin_amdgcn_readfirstlane(tid >> 6), lane = tid & 63, r32 = lane & 31, hi = lane >> 5;
    const int sr = tid >> 4, sc = (tid & 15) * 8, kws = KSWZ(sr, sc * 2); char* K_lds = lds + 2 * SHM_V; char* C_lds = lds + CB_OFF;
    const int kb0 = cur.jlo * KVBLK;
    for (int d0 = 0; d0 < 8; ++d0) S.qr[d0] = load8((const bf16*)((const char*)cur.Q + (unsigned)(((wid * QBLK + r32) * D + d0 * 16 + hi * 8) * 2)));
    SLOAD_H(cur.K, cur.V, cur.C, kb0); VMW(); SWRITE_HK(0, cur.cref);
    __syncthreads();
}
__device__ __forceinline__ void fox_block(const BlockRef& cur, const BlockRef& nxt, int skv, char* lds, Seam& S, const int tid) {
    const int wid = __builtin_amdgcn_readfirstlane(tid >> 6), lane = tid & 63, r32 = lane & 31, hi = lane >> 5;
    const int j_lo = cur.jlo;
    int j_hi = (cur.P0 + QB - 1) / KVBLK + 1; if (j_hi > skv / KVBLK) j_hi = skv / KVBLK;
    const int NT = j_hi - j_lo;
    const int kbn = nxt.jlo * KVBLK;
    const int qlo = cur.P0 + wid * QBLK, qm = qlo + r32 - 4 * hi;
    char* V_lds = lds; char* K_lds = lds + 2 * SHM_V; char* C_lds = lds + CB_OFF;
    float m_reg = -1e30f, l_reg = 0; f32x16 o[4] = {};
    const int sr = tid >> 4, sc = (tid & 15) * 8, vst0 = v_st(sr, sc), vst1 = v_st(32 + sr, sc), kws = KSWZ(sr, sc * 2);
    const int vb0 = (int)(uintptr_t)V_lds + v_rd_base(lane);
    const bf16* Kh = cur.K; const bf16* Vh = cur.V; const float* Ch = cur.C; const float cref = cur.cref;
#define CBT(bf) ((const float*)(C_lds + (bf) * 256))
#define RESC(a) do { if (__any((a) < 1.f)) { for (int d_ = 0; d_ < 4; ++d_) for (int r = 0; r < 16; ++r) o[d_][r] *= (a); } } while (0)
#define KBASE(t) ((j_lo + (t)) * KVBLK)
#define MASKT(P0_, P1_, t) do { const int kb_ = KBASE(t); if (kb_ + KVBLK - 1 > qlo) mask_tile(P0_, P1_, qm - kb_, WINF); } while (0)
    constexpr int NQL = 8;
#define SEAM_K0() do { VMWN(NQL); SWRITE_HK(0, nxt.cref); SBAR(); } while (0)
    f32x16 pA0, pA1, pB0, pB1; float mnA, mnB, alA, alB; bf16x8 pa0, pa1, pa2, pa3;
    SWRITE_HV(0); SBAR();
    if (NT > 1) { SLOAD_H(Kh, Vh, Ch, KBASE(1)); }
    SBAR(); qkt<0>(pA0, pA1, K_lds, CBT(0), r32, hi, S.qr);
    MASKT(pA0, pA1, 0); partialSM(pA0, pA1, m_reg, mnA, alA);
    if (NT > 1) { VMW(); SWRITE_H(1, cref); }
    __syncthreads();
#define HALF_STEP(PX0, PX1, mnX, alX, PY0, PY1, alY, t, KB, VB, SB) do {                                                      \
        SBAR(); qkt<KB>(PX0, PX1, K_lds, CBT(KB), r32, hi, S.qr);                                                                     \
        finishSM(PY0, PY1, alY, l_reg, pa0, pa1, pa2, pa3); SBAR();                                                           \
        if ((t) + 1 < NT) { SLOAD_H(Kh, Vh, Ch, KBASE((t) + 1)); SBAR(); }                                                    \
        pv_tile<VB>(o, vb0, pa0, pa1, pa2, pa3); MASKT(PX0, PX1, (t)); partialSM(PX0, PX1, m_reg, mnX, alX);    \
        __syncthreads();                                                                                                      \
        if ((t) + 1 < NT) { VMW(); SWRITE_H(SB, cref); }                                                                      \
        RESC(alX); __syncthreads(); } while (0)
    for (int t = 1; t + 1 < NT; t += 2) {
        HALF_STEP(pB0, pB1, mnB, alB, pA0, pA1, alA, t, 1, 0, 0);
        HALF_STEP(pA0, pA1, mnA, alA, pB0, pB1, alB, t + 1, 0, 1, 1);
    }
    const bool even = (NT & 1) == 0;
    if (even) { SBAR(); qkt<1>(pB0, pB1, K_lds, CBT(1), r32, hi, S.qr); SBAR(); }
    SLOAD_H(nxt.K, nxt.V, nxt.C, kbn); SBAR();
#pragma unroll
    for (int d0 = 0; d0 < 8; ++d0) S.qr[d0] = load8((const bf16*)((const char*)nxt.Q + (unsigned)(((wid * QBLK + r32) * D + d0 * 16 + hi * 8) * 2)));
    SBAR();
    finishSM(pA0, pA1, alA, l_reg, pa0, pa1, pa2, pa3); SBAR();
    pv_tile<0>(o, vb0, pa0, pa1, pa2, pa3);
    if (even) { MASKT(pB0, pB1, NT - 1); partialSM(pB0, pB1, m_reg, mnB, alB); __syncthreads(); RESC(alB);
        finishSM(pB0, pB1, alB, l_reg, pa0, pa1, pa2, pa3); SBAR(); pv_tile<1>(o, vb0, pa0, pa1, pa2, pa3); }
    SBAR(); SEAM_K0();
    const float rl = __builtin_amdgcn_rcpf(l_reg) * pg8::MIX_SCALE;
    unsigned ob = (unsigned)((wid * QBLK + r32) * LDO + 4 * hi);
    asm volatile("" : "+v"(ob));
#pragma unroll
    for (int d0 = 0; d0 < 4; ++d0)
#pragma unroll
        for (int g4 = 0; g4 < 4; ++g4) { int w8 = __builtin_amdgcn_cvt_pk_fp8_f32(o[d0][4 * g4] * rl, o[d0][4 * g4 + 1] * rl, 0, false); w8 = __builtin_amdgcn_cvt_pk_fp8_f32(o[d0][4 * g4 + 2] * rl, o[d0][4 * g4 + 3] * rl, w8, true);
            *(unsigned*)((char*)cur.O + (ob + (unsigned)(d0 * 32 + 8 * g4))) = (unsigned)w8; }
    __syncthreads();
#undef CBT
#undef RESC
#undef KBASE
#undef MASKT
#undef SEAM_K0
#undef HALF_STEP
}
#undef ROW
#undef VMW
#undef VMWN
#undef SLOAD_H
#undef SWRITE_HK
#undef SWRITE_HV
#undef SWRITE_H
#undef KSWZ
#undef SBAR
}
namespace dsa {
constexpr int L = 16384, NQ = 32, CAP = 640, KSEL = 256, EPL = CAP / 64  ;
#ifndef PROBE2X
#define PROBE2X 0
#endif
constexpr int ATT_REPS = ((PROBE2X >> 10) & 1) + 1, IDX_REPS = ((PROBE2X >> 11) & 1) + 1, CMP_REPS = ((PROBE2X >> 12) & 1) + 1, DMA_REPS = ((PROBE2X >> 15) & 1) + 1, CPT_REPS = ((PROBE2X >> 13) & 1) + 1;
constexpr float LOG2E = 1.4426950408889634f, SCALE = 0.08838834764831845f;
constexpr int CE_OFF = 0;
constexpr int KS_OFF = CE_OFF + NQ * CAP * 4, KS_BUF = 128 * 128, KS_NBUF = 3;
static_assert(KS_OFF + KS_NBUF * KS_BUF <= 131072, "indexer scratch inside the 128 KiB overlay");
constexpr int SEL_OFF = 131072;
constexpr int NV_OFF = SEL_OFF + 16384;
constexpr int TB_OFF = NV_OFF + 128;
constexpr int LUT_OFF = TB_OFF + 1024;
constexpr int HI_OFF = LUT_OFF + 128;
constexpr int FLG_OFF = HI_OFF + 8192;
constexpr int END_OFF = FLG_OFF + 16;
static_assert(SEL_OFF >= 131072 && END_OFF <= 161024, "DSA LDS map");

typedef short bf16x8 __attribute__((ext_vector_type(8)));
typedef short s16x4 __attribute__((ext_vector_type(4)));
typedef float f32x16 __attribute__((ext_vector_type(16)));
typedef float f32x4 __attribute__((ext_vector_type(4)));
typedef unsigned u32x4 __attribute__((ext_vector_type(4)));
typedef unsigned u32x2 __attribute__((ext_vector_type(2)));

typedef __bf16 bf2_t __attribute__((ext_vector_type(2)));
typedef float f2_t __attribute__((ext_vector_type(2)));
typedef short s2_t __attribute__((ext_vector_type(2)));
__device__ __forceinline__ unsigned pkrelu(float a, float b) { const f2_t v = {a, b}; const s2_t z = {0, 0}; return __builtin_bit_cast(unsigned, __builtin_elementwise_max(__builtin_bit_cast(s2_t, __builtin_convertvector(v, bf2_t)), z)); }
__device__ __forceinline__ unsigned pkbf(float a, float b) { const f2_t v = {a, b}; return __builtin_bit_cast(unsigned, __builtin_convertvector(v, bf2_t)); }
__device__ __forceinline__ unsigned bf_rne(float f) { const unsigned u = __float_as_uint(f); return (u + 0x7fffu + ((u >> 16) & 1u)) >> 16; }
__device__ __forceinline__ unsigned clamp_bf2(unsigned w) { const float lo = fminf(fmaxf(__uint_as_float(w << 16), -448.0f), 448.0f), hh = fminf(fmaxf(__uint_as_float(w & 0xffff0000u), -448.0f), 448.0f); return (__float_as_uint(lo) >> 16) | (__float_as_uint(hh) & 0xffff0000u); }
__device__ __forceinline__ unsigned pk4f8(f32x4 v) { int w = __builtin_amdgcn_cvt_pk_fp8_f32(__builtin_amdgcn_fmed3f(v[0], -448.0f, 448.0f), __builtin_amdgcn_fmed3f(v[1], -448.0f, 448.0f), 0, false);
    return (unsigned)__builtin_amdgcn_cvt_pk_fp8_f32(__builtin_amdgcn_fmed3f(v[2], -448.0f, 448.0f), __builtin_amdgcn_fmed3f(v[3], -448.0f, 448.0f), w, true); }
struct Tensors { const bf16* aiq; const float* small; const bf16* kidx; const unsigned char* ckv8; const unsigned char* qlat8; bf16* olat; };

__device__ __forceinline__ unsigned ord_key(float f) { const unsigned u = __float_as_uint(f); return (u & 0x80000000u) ? ~u : (u | 0x80000000u); }
__device__ __forceinline__ float unord_key(unsigned k) { return __uint_as_float((k & 0x80000000u) ? (k & 0x7fffffffu) : ~k); }
__device__ __forceinline__ unsigned lanemask_lt_pop(unsigned long long m, int lane) { return (unsigned)__popcll(m & ((1ull << lane) - 1ull)); }

template <int CTRL, int RM> __device__ __forceinline__ unsigned dppu(unsigned v, unsigned idn) { return (unsigned)__builtin_amdgcn_update_dpp((int)idn, (int)v, CTRL, RM, 0xf, false); }
__device__ __forceinline__ unsigned wave_incl_scan_add(unsigned v) {
    v += dppu<0x111, 0xf>(v, 0u); v += dppu<0x112, 0xf>(v, 0u); v += dppu<0x114, 0xf>(v, 0u); v += dppu<0x118, 0xf>(v, 0u);
    v += dppu<0x142, 0xa>(v, 0u); v += dppu<0x143, 0xc>(v, 0u); return v; }
__device__ __forceinline__ unsigned wave_min_u32(unsigned v) {
    v = min(v, dppu<0x111, 0xf>(v, 0xffffffffu)); v = min(v, dppu<0x112, 0xf>(v, 0xffffffffu)); v = min(v, dppu<0x114, 0xf>(v, 0xffffffffu)); v = min(v, dppu<0x118, 0xf>(v, 0xffffffffu));
    v = min(v, dppu<0x142, 0xa>(v, 0xffffffffu)); v = min(v, dppu<0x143, 0xc>(v, 0xffffffffu)); return (unsigned)__builtin_amdgcn_readlane((int)v, 63); }
__device__ __forceinline__ unsigned wave_max_u32(unsigned v) {
    v = max(v, dppu<0x111, 0xf>(v, 0u)); v = max(v, dppu<0x112, 0xf>(v, 0u)); v = max(v, dppu<0x114, 0xf>(v, 0u)); v = max(v, dppu<0x118, 0xf>(v, 0u));
    v = max(v, dppu<0x142, 0xa>(v, 0u)); v = max(v, dppu<0x143, 0xc>(v, 0u)); return (unsigned)__builtin_amdgcn_readlane((int)v, 63); }
__device__ __forceinline__ void hist_add(unsigned hist_addr, unsigned bin) { asm volatile("ds_add_u32 %0, %1" :: "v"(hist_addr + bin * 4u), "v"(1u) : "memory"); }
__device__ __forceinline__ unsigned hist_find(LAS unsigned* hist, unsigned need, int lane, unsigned& nib) {
    asm volatile("s_waitcnt lgkmcnt(0)" ::: "memory");
    const u32x4 c = *(LAS u32x4*)(hist + 4 * (63 - lane));
    const unsigned s = c.x + c.y + c.z + c.w, incl = wave_incl_scan_add(s), excl = incl - s;
    const bool found = (excl < need) && (need <= incl);
    const unsigned long long fm = __ballot(found);
    const int fl = (int)__builtin_ctzll(fm | 0x8000000000000000ull);
    unsigned a = excl; int bin; unsigned nn;
    if (a + c.w >= need) { bin = 3; nn = need - a; } else { a += c.w;
        if (a + c.z >= need) { bin = 2; nn = need - a; } else { a += c.z;
            if (a + c.y >= need) { bin = 1; nn = need - a; } else { a += c.y; bin = 0; nn = need - a; } } }
    bin += 4 * (63 - lane);
    nib = (unsigned)__builtin_amdgcn_readlane((int)nn, fl);
    return (unsigned)__builtin_amdgcn_readlane(bin, fl);
}
#define DSA_LOAD_LIST() unsigned key[EPL];                                                                                      \
    _Pragma("unroll") for (int i = 0; i < EPL; ++i) { const int e = lane + 64 * i; key[i] = 0u; if (e < n) key[i] = ce[e]; }
__device__ __forceinline__ float compact_exact(LAS unsigned* ce, LAS unsigned* hist, int n, int lane) {
    DSA_LOAD_LIST();
    const unsigned haddr = (unsigned)(size_t)hist;
    unsigned prefix = 0u, pmask = 0u; unsigned need = KSEL;
#pragma unroll 1
    for (int pass = 0; pass < 4; ++pass) {
        const int sh = 24 - 8 * pass;
        *(LAS u32x4*)(hist + 4 * lane) = (u32x4){0u, 0u, 0u, 0u};
        asm volatile("s_waitcnt lgkmcnt(0)" ::: "memory");
#pragma unroll
        for (int i = 0; i < EPL; ++i) if (key[i] != 0u && (key[i] & pmask) == prefix) hist_add(haddr, (key[i] >> sh) & 255u);
        unsigned nib; const unsigned binu = hist_find(hist, need, lane, nib); need = nib;
        prefix |= binu << sh; pmask |= 0xffu << sh;
    }
    int base = 0; unsigned eqseen = 0u;
#pragma unroll
    for (int i = 0; i < EPL; ++i) {
        const bool gt = key[i] > prefix, eq = key[i] == prefix;
        const unsigned long long meq = __ballot(eq);
        const bool keep = gt || (eq && (eqseen + lanemask_lt_pop(meq, lane)) < need);
        eqseen += (unsigned)__popcll(meq);
        const unsigned long long mk = __ballot(keep);
        const int pos = base + (int)lanemask_lt_pop(mk, lane);
        if (keep) ce[pos] = key[i];
        base += (int)__popcll(mk);
    }
    asm volatile("s_waitcnt lgkmcnt(0)" ::: "memory");
    return unord_key((prefix & 0xffffc000u) - 1u);
}
__device__ __forceinline__ float compact_approx(LAS unsigned* ce, LAS unsigned* hist, int n, int lane, int& n_out) {
    DSA_LOAD_LIST();
    const unsigned haddr = (unsigned)(size_t)hist;
    unsigned kmn = 0xffffffffu, kmx = 0u;
#pragma unroll
    for (int i = 0; i < EPL; ++i) if (key[i] != 0u) { kmn = min(kmn, key[i]); kmx = max(kmx, key[i]); }
    kmn = wave_min_u32(kmn); kmx = wave_max_u32(kmx);
    const int lz = __builtin_clz((kmx - kmn) | 1u), sh = lz < 24 ? 24 - lz : 0;
    *(LAS u32x4*)(hist + 4 * lane) = (u32x4){0u, 0u, 0u, 0u};
    asm volatile("s_waitcnt lgkmcnt(0)" ::: "memory");
#pragma unroll
    for (int i = 0; i < EPL; ++i) if (key[i] != 0u) hist_add(haddr, (key[i] - kmn) >> sh);
    unsigned nib; const unsigned b = hist_find(hist, KSEL, lane, nib);
    const unsigned tkey = kmn + (b << sh);
    int base = 0;
#pragma unroll
    for (int i = 0; i < EPL; ++i) {
        const bool keep = key[i] != 0u && key[i] >= tkey;
        const unsigned long long mk = __ballot(keep);
        const int pos = base + (int)lanemask_lt_pop(mk, lane);
        if (keep) ce[pos] = key[i];
        base += (int)__popcll(mk);
    }
    asm volatile("s_waitcnt lgkmcnt(0)" ::: "memory");
    n_out = base;
    return unord_key((tkey & 0xffffc000u) - 1u);
}
#undef DSA_LOAD_LIST

__device__ __forceinline__ void init_tables(LAS unsigned char* lds, const float* t5, const int tid) {
    if (tid < 256) ((LAS float*)(lds + TB_OFF))[tid] = t5[tid] * LOG2E;
    if (tid < 128) { int bk = tid; if (tid >= 16) { bk = 16 + (int)floorf(__log2f((float)tid * (1.0f / 16.0f)) * (16.0f / 3.0f)); bk = bk > 31 ? 31 : bk; } ((LAS unsigned char*)(lds + LUT_OFF))[tid] = (unsigned char)bk; }
}

__device__ __forceinline__ void unit(LAS unsigned char* lds, const Tensors& T, int b, int t0, const int tid) {
    const int wid = __builtin_amdgcn_readfirstlane(tid >> 6), lane = tid & 63, r32 = lane & 31, hi = lane >> 5;
    const size_t tokb = (size_t)b * L;
    {
        int tqv[2]; bf16x8 qa[2][4]; bf16x8 wf[2][2];
#pragma unroll
        for (int B = 0; B < 2; ++B) {
            tqv[B] = t0 + 4 * wid + 2 * B + hi;
            const int aq = t0 + 4 * wid + 2 * B + ((r32 >> 2) & 1), ah = (r32 & 3) + 4 * (r32 >> 3);
#pragma unroll
            for (int s = 0; s < 4; ++s) qa[B][s] = *(const bf16x8*)(T.aiq + (tokb + aq) * 1024 + ah * 64 + 16 * s + 8 * hi);
            float w[16];
#pragma unroll
            for (int q4 = 0; q4 < 4; ++q4) { const f32x4 v = *(const f32x4*)(T.small + (tokb + tqv[B]) * 128 + 64 + 4 * q4);
#pragma unroll
                for (int j = 0; j < 4; ++j) w[4 * q4 + j] = v[j] * (0.25f * 0.125f); }
            const bool rh = r32 == 4 * hi, rl = r32 == 4 * hi + 1;
#pragma unroll
            for (int s = 0; s < 2; ++s) { u32x4 pw;
#pragma unroll
                for (int jj = 0; jj < 4; ++jj) { const float a = w[8 * s + 2 * jj], b2 = w[8 * s + 2 * jj + 1]; const unsigned ah2 = bf_rne(a), bh2 = bf_rne(b2);
                    const unsigned al = bf_rne(a - __uint_as_float(ah2 << 16)), bl = bf_rne(b2 - __uint_as_float(bh2 << 16));
                    pw[jj] = rh ? (ah2 | (bh2 << 16)) : (rl ? (al | (bl << 16)) : 0u); }
                wf[B][s] = __builtin_bit_cast(bf16x8, pw); }
        }
        LAS unsigned* ceW = (LAS unsigned*)(lds + CE_OFF) + (4 * wid) * CAP;
        LAS unsigned* ceM0 = ceW + hi * CAP; LAS unsigned* ceM1 = ceW + (2 + hi) * CAP;
        LAS unsigned* hist = (LAS unsigned*)(lds + HI_OFF) + wid * 256;
        int cnt0 = 0, cnt1 = 0, cnt2 = 0, cnt3 = 0; float tau0 = -__builtin_inff(), tau1 = tau0, tau2 = tau0, tau3 = tau0, tauv0 = tau0, tauv1 = tau0;
        const int tmax = t0 + NQ - 1, nch = tmax / 128 + 1;
        const int dk = lane >> 3, dpc = lane & 7, k0l = 16 * wid + dk, k1l = k0l + 8;
        const bf16* src0 = T.kidx + (tokb + k0l) * 64 + ((dpc ^ ((k0l >> 1) & 7)) * 8);
        const bf16* src1 = T.kidx + (tokb + k1l) * 64 + ((dpc ^ ((k1l >> 1) & 7)) * 8);
        LAS unsigned char* ring = lds + KS_OFF;
        LAS unsigned* flg = (LAS unsigned*)(lds + FLG_OFF);
#define DMA_CHUNK(c, slot) do { const int cc_ = (c) < nch ? (c) : nch - 1; LAS unsigned char* d_ = ring + (slot) * KS_BUF + wid * 2048;                  \
            __builtin_amdgcn_global_load_lds((const unsigned*)(src0 + (size_t)cc_ * 8192), (LAS unsigned*)d_, 16, 0, 0);                               \
            __builtin_amdgcn_global_load_lds((const unsigned*)(src1 + (size_t)cc_ * 8192), (LAS unsigned*)(d_ + 1024), 16, 0, 0); } while (0)
        int boff[4];
#pragma unroll
        for (int s = 0; s < 4; ++s) boff[s] = r32 * 128 + (((2 * s + hi) ^ ((r32 >> 1) & 7)) << 4);
#pragma unroll 1
        for (int irep = 0; irep < IDX_REPS; ++irep) {
        if (irep) { __syncthreads(); cnt0 = cnt1 = cnt2 = cnt3 = 0; tau0 = tau1 = tau2 = tau3 = tauv0 = tauv1 = -__builtin_inff(); }
        if (tid < 3) flg[tid] = 0u;
        DMA_CHUNK(0, 0); DMA_CHUNK(1, 1);
#define LOADK(kf, tile) do { _Pragma("unroll") for (int s = 0; s < 4; ++s) kf[s] = *(const LAS bf16x8*)(kbuf + (tile) * 4096 + boff[s]); } while (0)
#define MFMA4(acc, B, kf) do { acc = f32x16{}; _Pragma("unroll") for (int s = 0; s < 4; ++s) acc = __builtin_amdgcn_mfma_f32_32x32x16_bf16(qa[B][s], kf[s], acc, 0, 0, 0); } while (0)
#define MFMA8(accP, accQ, kf) do { MFMA4(accP, 0, kf); MFMA4(accQ, 1, kf); } while (0)
#define SB() __builtin_amdgcn_sched_barrier(0)
#define SCORE1(acc, tile, B, tauv_, ceM_, cA_, cB_) do { u32x4 x0_, x1_;                                                                                    \
            x0_.x = pkrelu(acc[0], acc[1]); x0_.y = pkrelu(acc[2], acc[3]); x0_.z = pkrelu(acc[4], acc[5]); x0_.w = pkrelu(acc[6], acc[7]);               \
            x1_.x = pkrelu(acc[8], acc[9]); x1_.y = pkrelu(acc[10], acc[11]); x1_.z = pkrelu(acc[12], acc[13]); x1_.w = pkrelu(acc[14], acc[15]);         \
            f32x16 y_ = __builtin_amdgcn_mfma_f32_32x32x16_bf16(wf[B][0], __builtin_bit_cast(bf16x8, x0_), f32x16{}, 0, 0, 0);                            \
            y_ = __builtin_amdgcn_mfma_f32_32x32x16_bf16(wf[B][1], __builtin_bit_cast(bf16x8, x1_), y_, 0, 0, 0);                                         \
            const float sc = y_[0] + y_[1]; const int key = kbase + (tile) * 32 + r32;                                                                  \
            const bool pass = (key <= tqv[B]) && (sc > tauv_);                                                                                      \
            const unsigned long long pm = __ballot(pass); const unsigned mlo = (unsigned)pm, mhi = (unsigned)(pm >> 32);                            \
            const int nlo_ = (int)__popc(mlo);                                                                                                      \
            const unsigned pos = __builtin_amdgcn_mbcnt_hi(mhi, __builtin_amdgcn_mbcnt_lo(mlo, (unsigned)(hi ? cB_ - nlo_ : cA_)));                  \
            if (pass) ceM_[pos] = (ord_key(sc) & 0xffffc000u) | (unsigned)key;                                                                       \
            cA_ += nlo_; cB_ += (int)__popc(mhi); } while (0)
#define SCORE2(accP, accQ, tile) do { SCORE1(accP, tile, 0, tauv0, ceM0, cnt0, cnt1); SCORE1(accQ, tile, 1, tauv1, ceM1, cnt2, cnt3); } while (0)
#define COMPACT_ROUND() do { asm volatile("s_waitcnt lgkmcnt(0)" ::: "memory");                                                                      \
            _Pragma("nounroll") for (int q_ = 0; q_ < 4; ++q_) { const int cq_ = q_ == 0 ? cnt0 : (q_ == 1 ? cnt1 : (q_ == 2 ? cnt2 : cnt3)); if (cq_ > KSEL) {   \
                LAS unsigned* ce_ = ceW + q_ * CAP; int nn_; float t_ = compact_approx(ce_, hist, cq_, lane, nn_);   \
                if (nn_ > CAP - 256) { t_ = compact_exact(ce_, hist, nn_, lane); nn_ = KSEL; }       \
                if (q_ == 0) { tau0 = t_; cnt0 = nn_; } else if (q_ == 1) { tau1 = t_; cnt1 = nn_; } else if (q_ == 2) { tau2 = t_; cnt2 = nn_; } else { tau3 = t_; cnt3 = nn_; } } }   \
            tauv0 = hi ? tau1 : tau0; tauv1 = hi ? tau3 : tau2; } while (0)
#define COMPACT_FINAL() do { asm volatile("s_waitcnt lgkmcnt(0)" ::: "memory");                                                                      \
            _Pragma("nounroll") for (int q_ = 0; q_ < 4; ++q_) { const int cq_ = q_ == 0 ? cnt0 : (q_ == 1 ? cnt1 : (q_ == 2 ? cnt2 : cnt3)); if (cq_ > KSEL) {   \
                compact_exact(ceW + q_ * CAP, hist, cq_, lane);                                                    \
                if (q_ == 0) cnt0 = KSEL; else if (q_ == 1) cnt1 = KSEL; else if (q_ == 2) cnt2 = KSEL; else cnt3 = KSEL; } } } while (0)
        constexpr int FLAG_LIM = CAP - 160;
        asm volatile("s_waitcnt vmcnt(2) lgkmcnt(0)" ::: "memory"); __builtin_amdgcn_s_barrier(); asm volatile("" ::: "memory");
        DMA_CHUNK(2, 2);
        f32x16 accA0, accA1, accB0, accB1; bf16x8 k0[4], k1[4];
        { const LAS unsigned char* kbuf = ring; LOADK(k0, 0); LOADK(k1, 1); SB(); MFMA8(accA0, accA1, k0); SB(); LOADK(k0, 2); SB(); MFMA8(accB0, accB1, k1); SB(); LOADK(k1, 3); SB(); }
        int slot = 0;
#pragma unroll 1
        for (int ch = 0; ch < nch; ++ch) {
            const int kbase = ch * 128; const int nslot = slot == KS_NBUF - 1 ? 0 : slot + 1;
            const LAS unsigned char* kbuf = ring + nslot * KS_BUF;
            SCORE2(accA0, accA1, 0); MFMA8(accA0, accA1, k0);
            asm volatile("s_waitcnt vmcnt(2) lgkmcnt(0)" ::: "memory");
            __builtin_amdgcn_s_barrier(); asm volatile("" ::: "memory");
            DMA_CHUNK(ch + 3, slot);
            const unsigned fraw = ch == 0 ? 0u : flg[(ch + 2) % 3];
            if (tid == 0) flg[(ch + 1) % 3] = 0u;
            LOADK(k0, 0); SB();
            if (__builtin_amdgcn_readfirstlane((int)fraw)) COMPACT_ROUND();
            SCORE2(accB0, accB1, 1); MFMA8(accB0, accB1, k1); LOADK(k1, 1);
            SCORE2(accA0, accA1, 2); MFMA8(accA0, accA1, k0); LOADK(k0, 2);
            SCORE2(accB0, accB1, 3); MFMA8(accB0, accB1, k1); LOADK(k1, 3);
            if (cnt0 > FLAG_LIM || cnt1 > FLAG_LIM || cnt2 > FLAG_LIM || cnt3 > FLAG_LIM) { if (lane == 0) flg[ch % 3] = 1u; }
            slot = nslot;
        }
        asm volatile("s_waitcnt vmcnt(0) lgkmcnt(0)" ::: "memory");
        COMPACT_FINAL();
        }
#undef DMA_CHUNK
#undef MFMA4
#undef MFMA8
#undef LOADK
#undef SB
#undef SCORE1
#undef SCORE2
#undef COMPACT_ROUND
#undef COMPACT_FINAL
#pragma unroll
        for (int j = 0; j < 4; ++j) { const int cj = j == 0 ? cnt0 : (j == 1 ? cnt1 : (j == 2 ? cnt2 : cnt3));
            LAS unsigned short* selJ = (LAS unsigned short*)(lds + SEL_OFF) + (4 * wid + j) * KSEL; const LAS unsigned* ceJ = ceW + j * CAP;
#pragma unroll
            for (int i = 0; i < 4; ++i) { const int e = lane + 64 * i; selJ[e] = e < cj ? (unsigned short)(ceJ[e] & 0x3fffu) : (unsigned short)0; }
            if (lane == 0) ((LAS int*)(lds + NV_OFF))[4 * wid + j] = cj; }
    }
    __syncthreads();
    {
        int lane_o = lane; asm volatile("" : "+v"(lane_o));
        LAS unsigned char* cbuf = lds + wid * 16384;
        const unsigned cbase = (unsigned)(size_t)cbuf;
        const int head = lane_o & 15, g = lane_o >> 4;
        const LAS float* tb = (const LAS float*)(lds + TB_OFF); const LAS unsigned char* lut = (const LAS unsigned char*)(lds + LUT_OFF);
        constexpr float C2 = SCALE * LOG2E;
#define GATHER(chunk, bufsel) do { _Pragma("unroll") for (int i = 0; i < 8; ++i) { const int kap = 4 * i + g; const int key = (int)sel[(chunk) * 32 + kap]; const int c = head ^ (kap & 15);   \
            __builtin_amdgcn_global_load_lds((const unsigned*)(T.ckv8 + (tokb + key) * 256 + c * 16), (LAS unsigned*)(cbuf + (bufsel) * 8192 + i * 1024), 16, 0, 0); } } while (0)
#pragma unroll 1
        for (int qq = 0; qq < 4 * ATT_REPS; ++qq) { const int qi = qq & 3;
            const int qs = 4 * wid + qi, t = t0 + qs;
            const int nvalid = ((const LAS int*)(lds + NV_OFF))[qs];
            const LAS unsigned short* sel = (const LAS unsigned short*)(lds + SEL_OFF) + qs * KSEL;
            if (qi == 0) GATHER(0, 0);
            long qf[8];
#pragma unroll
            for (int s = 0; s < 8; ++s) { qf[s] = 0; if (head < 8) qf[s] = *(const long*)(T.qlat8 + ((size_t)head * (2 * L) + tokb + t) * 256 + 32 * s + 8 * g); }
            f32x4 o[16];
#pragma unroll
            for (int nb = 0; nb < 16; ++nb) o[nb] = (f32x4){0.f, 0.f, 0.f, 0.f};
            float m_run = -1e30f, l_run = 0.f;
#pragma unroll 1
            for (int ch = 0; ch < 8; ++ch) {
                const int bs = ch & 1;
                if (ch + 1 < 8) { GATHER(ch + 1, bs ^ 1); asm volatile("s_waitcnt vmcnt(8)" ::: "memory"); }
                else if (qi < 3) { const LAS unsigned short* selc = sel; sel = selc + KSEL; GATHER(0, 0); sel = selc; asm volatile("s_waitcnt vmcnt(8)" ::: "memory"); }
                else asm volatile("s_waitcnt vmcnt(0)" ::: "memory");
                const LAS unsigned char* cb = cbuf + bs * 8192;
                f32x4 sa[2];
#pragma unroll
                for (int e = 0; e < 2; ++e) { sa[e] = (f32x4){0.f, 0.f, 0.f, 0.f};
                    const int kap = 8 * ((lane_o & 15) >> 2) + 4 * e + (lane_o & 3); const int x = kap & 15;
                    const LAS unsigned char* rp = cb + kap * 256 + (g & 1) * 8;
#pragma unroll
                    for (int s = 0; s < 8; ++s) { const long a = *(const LAS long*)(rp + (((2 * s + (g >> 1)) ^ x) << 4)); sa[e] = __builtin_amdgcn_mfma_f32_16x16x32_fp8_fp8(a, qf[s], sa[e], 0, 0, 0); } }
                float v[8]; float cmax = -__builtin_inff();
#pragma unroll
                for (int e = 0; e < 2; ++e)
#pragma unroll
                    for (int r = 0; r < 4; ++r) { const int slot = ch * 32 + 8 * g + 4 * e + r; const int key = (int)sel[slot]; const int dist = t - key;
                        const int bk = dist < 128 ? (int)lut[dist < 0 ? 0 : dist] : 31; const float bias = tb[bk * 8 + (head & 7)];
                        const float x = slot < nvalid ? fmaf(sa[e][r], C2, bias) : -__builtin_inff(); v[4 * e + r] = x; cmax = fmaxf(cmax, x); }
                cmax = fmaxf(cmax, __shfl_xor(cmax, 16)); cmax = fmaxf(cmax, __shfl_xor(cmax, 32));
                const float mn = fmaxf(m_run, cmax), alpha = __builtin_amdgcn_exp2f(m_run - mn); m_run = mn;
                float ps = 0.f;
#pragma unroll
                for (int j = 0; j < 8; ++j) { v[j] = __builtin_amdgcn_exp2f(v[j] - mn); ps += v[j]; }
                ps += __shfl_xor(ps, 16); ps += __shfl_xor(ps, 32);
                l_run = l_run * alpha + ps;
#pragma unroll
                for (int nb = 0; nb < 16; ++nb) o[nb] = o[nb] * alpha;
                int plo = __builtin_amdgcn_cvt_pk_fp8_f32(v[0] * 256.0f, v[1] * 256.0f, 0, false); plo = __builtin_amdgcn_cvt_pk_fp8_f32(v[2] * 256.0f, v[3] * 256.0f, plo, true);
                int phi = __builtin_amdgcn_cvt_pk_fp8_f32(v[4] * 256.0f, v[5] * 256.0f, 0, false); phi = __builtin_amdgcn_cvt_pk_fp8_f32(v[6] * 256.0f, v[7] * 256.0f, phi, true);
                const long pf = (long)(((unsigned long long)(unsigned)phi << 32) | (unsigned)plo);
                const int kapv = 8 * g + ((lane_o & 15) >> 1);
                const unsigned av = cbase + bs * 8192 + kapv * 256 + (lane_o & 1) * 8; const unsigned xv = (unsigned)((kapv & 15) << 4);
#pragma unroll
                for (int nh = 0; nh < 2; ++nh) {
                    unsigned long long ar[8];
#pragma unroll
                    for (int i = 0; i < 8; ++i) { const unsigned ad = av + ((unsigned)((8 * nh + i) << 4) ^ xv); asm volatile("ds_read_b64_tr_b8 %0, %1" : "=&v"(ar[i]) : "v"(ad) : "memory"); }
                    asm volatile("s_waitcnt lgkmcnt(0)" ::: "memory"); __builtin_amdgcn_sched_barrier(0);
#pragma unroll
                    for (int i = 0; i < 8; ++i) o[8 * nh + i] = __builtin_amdgcn_mfma_f32_16x16x32_fp8_fp8((long)ar[i], pf, o[8 * nh + i], 0, 0, 0);
                }
            }
            const float rl = 1.0f / (256.0f * l_run);
            if (head < 8) { bf16* op = T.olat + ((size_t)head * (2 * L) + tokb + t) * 256 + 4 * g;
#pragma unroll
                for (int nb = 0; nb < 16; ++nb) { u32x2 w; w.x = pg8::cvt_pk_bf16(o[nb][0] * rl, o[nb][1] * rl); w.y = pg8::cvt_pk_bf16(o[nb][2] * rl, o[nb][3] * rl); *(u32x2*)(op + 16 * nb) = w; } }
        }
#undef GATHER
    }
    __syncthreads();
}
template <int KD, int NBW, bool OUT8 = false>
__device__ __forceinline__ void absorb(const bf16* Wt, const bf16* X, int ldx, bf16* out, int ldo, int tg0, int tg_step, int ntg, int lane, int reps = 1  , float oscale = 1.0f  ) {
    constexpr int KS = KD / 32; const int r16 = lane & 15, g = lane >> 4;
    bf16x8 a[NBW][KS];
#pragma unroll
    for (int nb = 0; nb < NBW; ++nb)
#pragma unroll
        for (int s = 0; s < KS; ++s) a[nb][s] = *(const bf16x8*)(Wt + (size_t)(16 * nb + r16) * KD + 32 * s + 8 * g);
#pragma unroll 1
    for (int tgg = tg0; tgg < ntg * reps; tgg += tg_step) { const int tg = tgg % ntg;
        const size_t tok = (size_t)tg * 16 + r16;
        bf16x8 b[KS];
#pragma unroll
        for (int s = 0; s < KS; ++s) b[s] = *(const bf16x8*)(X + tok * ldx + 32 * s + 8 * g);
#pragma unroll
        for (int nb = 0; nb < NBW; ++nb) { f32x4 acc = (f32x4){0.f, 0.f, 0.f, 0.f};
#pragma unroll
            for (int s = 0; s < KS; ++s) acc = __builtin_amdgcn_mfma_f32_16x16x32_bf16(a[nb][s], b[s], acc, 0, 0, 0);
            if constexpr (OUT8) *(unsigned*)((unsigned char*)out + tok * ldo + 16 * nb + 4 * g) = pk4f8(acc * oscale);
            else { u32x2 w; w.x = pkbf(acc[0], acc[1]); w.y = pkbf(acc[2], acc[3]); *(u32x2*)(out + tok * ldo + 16 * nb + 4 * g) = w; } }
    }
}
template <int KD, int NB, bool OUT8 = false>
__device__ __forceinline__ void absorb_wg(LAS unsigned char* lds, const bf16* Wt, const bf16* X, int ldx, bf16* out, int ldo, int tg_begin, int tg_per_wave, int tid, int reps = 1  , float oscale = 1.0f  ) {
    constexpr int KS = KD / 32, CPR = KD / 8  , ROWB = KD * 2;
    const int wid = __builtin_amdgcn_readfirstlane(tid >> 6), lane = tid & 63, r16 = lane & 15, g = lane >> 4;
#pragma unroll
    for (int i = 0; i < (16 * NB * CPR) / 512; ++i) { const int q = tid + 512 * i, n = q / CPR, c = q % CPR;
        *(LAS u32x4*)(lds + n * ROWB + ((c ^ (n & 15)) << 4)) = *(const u32x4*)(Wt + (size_t)n * KD + c * 8); }
    __syncthreads();
    const unsigned arow0 = (unsigned)(size_t)lds + r16 * ROWB;
    bf16x8 b[KS];
    { const size_t tok = (size_t)(tg_begin + wid * tg_per_wave) * 16 + r16;
#pragma unroll
      for (int s = 0; s < KS; ++s) b[s] = *(const bf16x8*)(X + tok * ldx + 32 * s + 8 * g); }
#pragma unroll 1
    for (int ii = 0; ii < tg_per_wave * reps; ++ii) { const int i = ii % tg_per_wave;
        const size_t tok = (size_t)(tg_begin + wid * tg_per_wave + i) * 16 + r16;
        unsigned arow_u = arow0; asm volatile("" : "+v"(arow_u));
        const LAS unsigned char* arow = (const LAS unsigned char*)(size_t)arow_u;
        bf16x8 bn[KS];
        { const size_t tokn = (size_t)(tg_begin + wid * tg_per_wave + (ii + 1 < tg_per_wave * reps ? (ii + 1) % tg_per_wave : i)) * 16 + r16;
#pragma unroll
          for (int s = 0; s < KS; ++s) bn[s] = *(const bf16x8*)(X + tokn * ldx + 32 * s + 8 * g); }
#pragma unroll
        for (int nb = 0; nb < NB; ++nb) { f32x4 acc = (f32x4){0.f, 0.f, 0.f, 0.f};
#pragma unroll
            for (int s = 0; s < KS; ++s) { const bf16x8 a = *(const LAS bf16x8*)(arow + nb * 16 * ROWB + (((4 * s + g) ^ r16) << 4)); acc = __builtin_amdgcn_mfma_f32_16x16x32_bf16(a, b[s], acc, 0, 0, 0); }
            if constexpr (OUT8) *(unsigned*)((unsigned char*)out + tok * ldo + 16 * nb + 4 * g) = pk4f8(acc * oscale);
            else { u32x2 w; w.x = pkbf(acc[0], acc[1]); w.y = pkbf(acc[2], acc[3]); *(u32x2*)(out + tok * ldo + 16 * nb + 4 * g) = w; } }
#pragma unroll
        for (int s = 0; s < KS; ++s) b[s] = bn[s];
    }
    __syncthreads();
}
}
constexpr int NWAVES = 8;
#ifndef MK_N_LAUNCHES
#define MK_N_LAUNCHES 1
#endif
constexpr int N_PHASES = 10;
constexpr int N_LAUNCHES = MK_N_LAUNCHES;
static_assert(N_LAUNCHES == 1 || N_LAUNCHES == N_PHASES, "MK_N_LAUNCHES is 1 or 10");

constexpr int BATCH = 2, SEQ = 16384, DM = 2048, M = BATCH * SEQ;
constexpr int N_INB = 1536, N_IN8 = 4096;
constexpr int N_IN = 5632;
constexpr int D_IN_SRC = 5464;
constexpr int K_O = 2048;
constexpr int FF = 5632, FF2 = 11264;
constexpr int NHALO = 1024;
constexpr size_t MiB = 1u << 20;
constexpr size_t WS_CTL = 0, CTL_ZERO_BYTES = 1 * MiB;
constexpr size_t WS_WIN = 2 * MiB, WS_WIN8 = 10 * MiB, WS_WO = 28 * MiB, WS_WUP = 40 * MiB, WS_WDN = 84 * MiB;
constexpr size_t WS_SMALL = 106 * MiB, WS_KIDX = 122 * MiB, WS_CKV = 126 * MiB, WS_CUM = 142 * MiB, WS_AHALO = 143 * MiB, WS_UHALO = 147 * MiB;
constexpr size_t WS_WUKT = 36 * MiB, WS_WUVT = 36 * MiB + 512 * 1024;
constexpr size_t WS_H = 192 * MiB;
constexpr size_t WS_OLAT = WS_H;
constexpr size_t WS_H8 = 320 * MiB;
constexpr size_t WS_MIX = 320 * MiB;
constexpr size_t WS_X2B = 320 * MiB;
constexpr size_t WS_AQ = 448 * MiB;
constexpr size_t WS_QLAT = 512 * MiB, WS_AKV = 640 * MiB, WS_AIQ = 656 * MiB, WS_BQ = 720 * MiB, WS_BK = 784 * MiB, WS_BV = 848 * MiB;
constexpr size_t WS_ACT = 512 * MiB;
constexpr size_t WS_END = 912 * MiB;
static_assert(WS_WIN + (size_t)N_INB * DM * 2 <= WS_WIN8 && WS_WIN8 + (size_t)N_IN8 * DM <= WS_WO && WS_WO + (size_t)DM * K_O * 2 <= WS_WUP && WS_WUP + (size_t)FF2 * DM * 2 <= WS_WDN && WS_WDN + (size_t)DM * FF * 2 <= WS_SMALL, "weights map");
static_assert(WS_BK - WS_BQ == WS_BV - WS_BK, "q/k/v spacing");
static_assert(WS_UHALO + (size_t)NHALO * FF2 * 4 <= WS_H && WS_ACT + (size_t)M * FF * 2 <= WS_END, "ws map");
constexpr int CW_TMO = 0, CW_CODE = 1, CW_QUEUE = 64  , CW_NORMQ = 320, CW_NORMK = 384, CW_QBLK = 512  , CW_DMIN = 1536  , CW_BAR = 4096;
constexpr size_t CTL_SS1 = 65536, CTL_SS2 = 65536 + 131072;
constexpr int RING_OFF = 0, RING_BYTES = 131072;
constexpr int LDSCTL_OFF = 161024, MISC_OFF = LDSCTL_OFF + 320;
constexpr int LDS_BYTES = 163840;
static_assert(dsa::END_OFF <= LDSCTL_OFF && MISC_OFF + 128 <= LDS_BYTES && fox::LDS_BYTES <= RING_BYTES, "LDS map");

__device__ __forceinline__ int fresh_lane() { int l; asm volatile("v_mbcnt_lo_u32_b32 %0, -1, 0\n\tv_mbcnt_hi_u32_b32 %0, -1, %0" : "=v"(l)); return l; }
struct Frame {
    LAS unsigned char* lds; volatile LAS unsigned* MISC; gu32* ctl;
    int tid, lane, wave, vcu, G;
    __device__ __forceinline__ void refresh() { lane = fresh_lane(); tid = wave * 64 + lane; }
};
__device__ __forceinline__ float wave_sum(float v) {
#pragma unroll
    for (int o = 1; o < 64; o <<= 1) v += __shfl_xor(v, o);
    return v;
}
__device__ __forceinline__ void p0_transpose_item(const float* W, int ldw, int c0, bf16* WT, int ldt, int r0, int k0, const float* gk, LAS float* scr, int lane) {
#pragma unroll
    for (int i = 0; i < 32; ++i) { const int kk = 2 * i + (lane >> 5); float v = W[(size_t)(k0 + kk) * ldw + c0 + (lane & 31)]; if (gk) v *= gk[k0 + kk]; scr[kk * 33 + (lane & 31)] = v; }
    LDS_WAIT(); asm volatile("" ::: "memory");
    const int c = lane & 7;
#pragma unroll
    for (int j = 0; j < 4; ++j) { const int n = (lane >> 3) + 8 * j; const LAS float* s = scr + (8 * c) * 33 + n;
        v4u o; o.x = pk2(s[0 * 33], s[1 * 33]); o.y = pk2(s[2 * 33], s[3 * 33]); o.z = pk2(s[4 * 33], s[5 * 33]); o.w = pk2(s[6 * 33], s[7 * 33]);
        *(GAS v4u*)(WT + (size_t)(r0 + n) * ldt + k0 + 8 * c) = o; }
    LDS_WAIT(); asm volatile("" ::: "memory");
}
__device__ __forceinline__ float clamp8(float v) { return __builtin_amdgcn_fmed3f(v, -448.0f, 448.0f); }
__device__ __forceinline__ void p0_transpose_item8(const float* W, int ldw, int c0, unsigned char* WT8, int ldt, int r0, int k0, float scale, LAS float* scr, int lane) {
#pragma unroll
    for (int i = 0; i < 32; ++i) { const int kk = 2 * i + (lane >> 5); scr[kk * 33 + (lane & 31)] = W[(size_t)(k0 + kk) * ldw + c0 + (lane & 31)] * scale; }
    LDS_WAIT(); asm volatile("" ::: "memory");
    const int c = lane & 7;
#pragma unroll
    for (int j = 0; j < 4; ++j) { const int n = (lane >> 3) + 8 * j; const LAS float* s = scr + (8 * c) * 33 + n;
        int lo = __builtin_amdgcn_cvt_pk_fp8_f32(s[0 * 33], s[1 * 33], 0, false); lo = __builtin_amdgcn_cvt_pk_fp8_f32(s[2 * 33], s[3 * 33], lo, true);
        int hi = __builtin_amdgcn_cvt_pk_fp8_f32(s[4 * 33], s[5 * 33], 0, false); hi = __builtin_amdgcn_cvt_pk_fp8_f32(s[6 * 33], s[7 * 33], hi, true);
        *(GAS unsigned long long*)(WT8 + (size_t)(r0 + n) * ldt + k0 + 8 * c) = (unsigned long long)(unsigned)lo | ((unsigned long long)(unsigned)hi << 32); }
    LDS_WAIT(); asm volatile("" ::: "memory");
}
__device__ __forceinline__ void fold_item(Frame& F, const float* A, int lda, const float* B, int ldb, bf16* out, int ldo, int row0, int col0) {
    LAS float* As = (LAS float*)(F.lds); LAS float* Bs = (LAS float*)(F.lds + 64 * 129 * 4);
    { const int r = F.tid >> 3, c = (F.tid & 7) * 16;
#pragma unroll
      for (int q = 0; q < 4; ++q) { const f32x4 v = *(const f32x4*)(A + (size_t)r * lda + c + 4 * q); As[r * 129 + c + 4 * q + 0] = v[0]; As[r * 129 + c + 4 * q + 1] = v[1]; As[r * 129 + c + 4 * q + 2] = v[2]; As[r * 129 + c + 4 * q + 3] = v[3]; } }
    { const int r = F.tid >> 2, c = (F.tid & 3) * 16;
#pragma unroll
      for (int q = 0; q < 4; ++q) *(LAS f32x4*)(Bs + r * 64 + c + 4 * q) = *(const f32x4*)(B + (size_t)r * ldb + c + 4 * q); }
    __syncthreads();
    const int j = F.tid & 63, ig = F.tid >> 6; float acc[8];
#pragma unroll
    for (int ii = 0; ii < 8; ++ii) acc[ii] = 0.f;
#pragma unroll 4
    for (int d = 0; d < 128; ++d) { const float bv = Bs[d * 64 + j];
#pragma unroll
        for (int ii = 0; ii < 8; ++ii) acc[ii] = fmaf(As[(8 * ig + ii) * 129 + d], bv, acc[ii]); }
    v4u o; o.x = pk2(acc[0], acc[1]); o.y = pk2(acc[2], acc[3]); o.z = pk2(acc[4], acc[5]); o.w = pk2(acc[6], acc[7]);
    *(GAS v4u*)(out + (size_t)(row0 + j) * ldo + col0 + 8 * ig) = o;
    __syncthreads();
}
struct Inputs { const float *x, *w_in, *kv_g, *w_uk, *w_uv, *t5, *fgb, *w_o, *g1, *g2, *w_up, *conv_w, *conv_b, *w_down, *gf; };

__device__ __forceinline__ void p0_prologue(Frame& F, const Inputs& I, unsigned char* ws) {
    F.refresh();
    bf16* WIN = (bf16*)(ws + WS_WIN); bf16* H = (bf16*)(ws + WS_H);
    bf16* WUKT = (bf16*)(ws + WS_WUKT); bf16* WUVT = (bf16*)(ws + WS_WUVT);
    LAS float* scr = (LAS float*)(F.lds + RING_OFF + F.wave * 16384);
    const int gw = F.vcu * NWAVES + F.wave, NGW = F.G * NWAVES;
    constexpr int I_IN = 170 * 32, I_UK = 8 * 2 * 8, I_UV = 8 * 4 * 4, NIT = I_IN + I_UK + I_UV;
    constexpr int P0R = ((PROBE2X >> 16) & 1) + 1;
    for (int it = gw; it < NIT * P0R; it += NGW) {
        int r = it % NIT;
        if (r < I_IN) { const int kb = r / 170, cb = r % 170;
            if (cb < 32 || (cb >= 72 && cb < 168)) {
                const int dst = cb < 32 ? cb * 32 : 1024 + (cb - 72) * 32, src = cb < 32 ? cb * 32 : 2384 + (cb - 72) * 32;
                p0_transpose_item8(I.w_in, D_IN_SRC, src, ws + WS_WIN8, DM, dst, kb * 64, pg8::WIN8_SCALE, scr, F.lane); continue; }
            const int dst = cb < 72 ? (cb - 32) * 32 : 1280 + (cb - 168) * 32, src = cb < 72 ? cb * 32 : 2304 + (cb - 168) * 32;
            p0_transpose_item(I.w_in, D_IN_SRC, src, WIN, DM, dst, kb * 64, nullptr, scr, F.lane); continue; }
        r -= I_IN;
        if (r < I_UK) { const int h = r >> 4, kb = (r >> 3) & 1, nb = r & 7;
            p0_transpose_item(I.w_uk + (size_t)h * 128 * 256, 256, nb * 32, WUKT + (size_t)h * 256 * 128, 128, nb * 32, kb * 64, nullptr, scr, F.lane); continue; }
        r -= I_UK;
        { const int h = r >> 4, kb = (r >> 2) & 3, nb = r & 3;
            p0_transpose_item(I.w_uv + (size_t)h * 256 * 128, 128, nb * 32, WUVT + (size_t)h * 128 * 256, 256, nb * 32, kb * 64, nullptr, scr, F.lane); }
    }
    for (int e = (F.vcu * NWAVES + F.wave) * 64 + F.lane; e < 192 * DM; e += NGW * 64) { const int c = 64 + e / DM, k = e % DM;
        float v = 0.f; if (c < 80) v = I.w_in[(size_t)k * D_IN_SRC + 2368 + (c - 64)]; else if (c < 88) v = I.w_in[(size_t)k * D_IN_SRC + 5456 + (c - 80)];
        WIN[(size_t)(1280 + c) * DM + k] = (bf16)f2bf(v); }
    for (int mm = gw; mm < M * P0R; mm += NGW) { const int m = mm % M;
        const GAS f32x4* xr = (const GAS f32x4*)(I.x + (size_t)m * DM) + F.lane; const GAS f32x4* gr = (const GAS f32x4*)I.g1 + F.lane;
        f32x4 v[8]; float s = 0.f;
#pragma unroll
        for (int j = 0; j < 8; ++j) { v[j] = xr[64 * j]; s += (v[j].x * v[j].x + v[j].y * v[j].y) + (v[j].z * v[j].z + v[j].w * v[j].w); }
        const float rstd = __builtin_amdgcn_rsqf(wave_sum(s) * (1.0f / DM) + 1e-6f);
        GAS unsigned long long* o8 = (GAS unsigned long long*)(H + (size_t)m * DM) + F.lane;
#pragma unroll
        for (int j = 0; j < 8; ++j) { const f32x4 g = gr[64 * j]; const float h0 = v[j].x * rstd * g.x, h1 = v[j].y * rstd * g.y, h2 = v[j].z * rstd * g.z, h3 = v[j].w * rstd * g.w;
            o8[64 * j] = (unsigned long long)pk2(h0, h1) | ((unsigned long long)pk2(h2, h3) << 32);
            int w8 = __builtin_amdgcn_cvt_pk_fp8_f32(clamp8(h0 * pg8::H8_SCALE), clamp8(h1 * pg8::H8_SCALE), 0, false); w8 = __builtin_amdgcn_cvt_pk_fp8_f32(clamp8(h2 * pg8::H8_SCALE), clamp8(h3 * pg8::H8_SCALE), w8, true);
            ((GAS int*)(ws + WS_H8 + (size_t)m * DM))[F.lane + 64 * j] = w8; }
    }
}
__device__ __forceinline__ void late_weights(Frame& F, const Inputs& I, unsigned char* ws, int gw, int NGW, bool with_down_only) {
    bf16* WO = (bf16*)(ws + WS_WO); bf16* WUP = (bf16*)(ws + WS_WUP); bf16* WDN = (bf16*)(ws + WS_WDN);
    LAS float* scr = (LAS float*)(F.lds + RING_OFF + F.wave * 16384);
    constexpr int I_O = 32 * 64, I_UP = 352 * 32, I_DN = 88 * 64;
    const int it0 = with_down_only ? I_O + I_UP : 0, it1 = with_down_only ? I_O + I_UP + I_DN : I_O + I_UP;
    for (int it = it0 + gw; it < it1; it += NGW) {
        int r = it;
        if (r < I_O) { const int kb = r >> 6, nb = r & 63; p0_transpose_item8(I.w_o, DM, nb * 32, (unsigned char*)WO, K_O, nb * 32, kb * 64, pg8::WO_SCALE, scr, F.lane); continue; }
        r -= I_O;
        if (r < I_UP) { const int kb = r / 352, cb = r % 352;        const int n0 = cb * 32, j = n0 >> 8, c = n0 & 255; const int src = c < 128 ? 128 * j + c : FF + 128 * j + (c - 128);
            p0_transpose_item(I.w_up, FF2, src, WUP, DM, n0, kb * 64, I.g2, scr, F.lane); continue; }
        r -= I_UP;
        { const int kb = r >> 6, nb = r & 63; p0_transpose_item8(I.w_down, DM, nb * 32, (unsigned char*)WDN, FF, nb * 32, kb * 64, pg8::WDN_SCALE, scr, F.lane); }
    }
}
__device__ __forceinline__ float log_sigmoid(float x) { return x >= 0.f ? -log1pf(expf(-x)) : x - log1pf(expf(x)); }
constexpr int NCUMWG = 16;
__device__ __forceinline__ void p2_misc(Frame& F, const Inputs& I, unsigned char* ws) {
    F.refresh();
    { const int h = F.vcu >> 5, part = F.vcu & 31;
      if (F.G == 256) dsa::absorb_wg<128, 16, true>(F.lds, (const bf16*)(ws + WS_WUKT) + (size_t)h * 256 * 128, (const bf16*)(ws + WS_AQ) + (size_t)h * M * 128, 128, (bf16*)(ws + WS_QLAT + (size_t)h * M * 256), 256, part * 64, 8, F.tid);
      else { const int gw0 = F.vcu * NWAVES + F.wave, combo = gw0 & 31, hh = combo >> 2, qd = combo & 3;
        dsa::absorb<128, 4, true>((const bf16*)(ws + WS_WUKT) + ((size_t)hh * 256 + qd * 64) * 128, (const bf16*)(ws + WS_AQ) + (size_t)hh * M * 128, 128, (bf16*)(ws + WS_QLAT + (size_t)hh * M * 256 + qd * 64), 256, gw0 >> 5, (F.G * NWAVES) >> 5, M / 16, F.lane); } }
    const float* SMALL = (const float*)(ws + WS_SMALL); float* CUM = (float*)(ws + WS_CUM);
    if (F.vcu >= F.G - NCUMWG) {
        const int bh = F.vcu - (F.G - NCUMWG), b = bh >> 3, h = bh & 7; LAS float* tot = (LAS float*)(F.lds);
        const float fb = I.fgb[h];
        const float* sp = SMALL + ((size_t)b * SEQ + (size_t)F.tid * 32) * 128 + 80 + h;
        float lf[32]; float s = 0.f;
#pragma unroll
        for (int k = 0; k < 32; ++k) { lf[k] = log_sigmoid(sp[(size_t)k * 128] + fb); s += lf[k]; }
        tot[F.tid] = s;
        __syncthreads();
        if (F.wave == 0) { float loc[8]; float run = 0.f;
#pragma unroll
            for (int k = 0; k < 8; ++k) { loc[k] = run; run += tot[8 * F.lane + k]; }
            float incl = run;
#pragma unroll
            for (int o = 1; o < 64; o <<= 1) { const float v = __shfl_up(incl, o); if (F.lane >= o) incl += v; }
            const float excl = incl - run;
#pragma unroll
            for (int k = 0; k < 8; ++k) tot[8 * F.lane + k] = excl + loc[k]; }
        __syncthreads();
        float run = tot[F.tid];
        float* cp = CUM + (size_t)bh * SEQ + (size_t)F.tid * 32;
#pragma unroll
        for (int k = 0; k < 32; k += 4) { f32x4 o; run += lf[k]; o[0] = run; run += lf[k + 1]; o[1] = run; run += lf[k + 2]; o[2] = run; run += lf[k + 3]; o[3] = run; *(f32x4*)(cp + k) = o; }
        __syncthreads();
        return;
    }
    const int nwg = F.G - NCUMWG, gw = F.vcu * NWAVES + F.wave, NGW = nwg * NWAVES;
    const bf16* AKV = (const bf16*)(ws + WS_AKV); unsigned char* CKV8 = (unsigned char*)(ws + WS_CKV); bf16* KIDX = (bf16*)(ws + WS_KIDX);
    const f32x4 g4 = *(const f32x4*)(I.kv_g + 4 * F.lane);
    constexpr int P2R = ((PROBE2X >> 17) & 1) + 1;
    for (int mm = gw; mm < M * P2R; mm += 4 * NGW) {
        unsigned long long raw[4]; f32x4 kv[4];
#pragma unroll
        for (int u = 0; u < 4; ++u) { const int m = (mm + u * NGW) % M; raw[u] = *(const GAS unsigned long long*)(AKV + (size_t)m * 256 + 4 * F.lane);
            kv[u] = (f32x4){0.f, 0.f, 0.f, 0.f}; if (F.lane < 16) kv[u] = *(const f32x4*)(SMALL + (size_t)m * 128 + 4 * F.lane); }
#pragma unroll
        for (int u = 0; u < 4; ++u) { if (mm + u * NGW >= M * P2R) break; const int m = (mm + u * NGW) % M;
            const float a0 = __uint_as_float((unsigned)(raw[u] & 0xffffu) << 16), a1 = __uint_as_float((unsigned)((raw[u] >> 16) & 0xffffu) << 16), a2 = __uint_as_float((unsigned)((raw[u] >> 32) & 0xffffu) << 16), a3 = __uint_as_float((unsigned)((raw[u] >> 48) & 0xffffu) << 16);
            const float rstd = __builtin_amdgcn_rsqf(wave_sum((a0 * a0 + a1 * a1) + (a2 * a2 + a3 * a3)) * (1.0f / 256.0f) + 1e-6f);
            { int w8 = __builtin_amdgcn_cvt_pk_fp8_f32(a0 * rstd * g4[0], a1 * rstd * g4[1], 0, false); w8 = __builtin_amdgcn_cvt_pk_fp8_f32(a2 * rstd * g4[2], a3 * rstd * g4[3], w8, true);
              *(GAS unsigned*)(CKV8 + (size_t)m * 256 + 4 * F.lane) = (unsigned)w8; }
            if (F.lane < 16) *(GAS unsigned long long*)(KIDX + (size_t)m * 64 + 4 * F.lane) = (unsigned long long)pk2(kv[u][0], kv[u][1]) | ((unsigned long long)pk2(kv[u][2], kv[u][3]) << 32); }
    }
    for (int itt = gw; itt < 16 * 64 * P2R; itt += NGW) { const int it = itt % 1024; const int bh = it >> 6, ck = it & 63;
        const bf16* qb_ = (const bf16*)(ws + WS_BQ) + ((size_t)bh * SEQ + (size_t)ck * 256) * 128; const bf16* kb_ = (const bf16*)(ws + WS_BK) + ((size_t)bh * SEQ + (size_t)ck * 256) * 128;
        float mq = 0.f, mk = 0.f, dmn = 3.0e38f;
#pragma unroll 4
        for (int i = 0; i < 64; ++i) { const size_t ro = (size_t)(4 * i + (F.lane >> 4)) * 128 + (F.lane & 15) * 8;
            const v4u vq = *(const GAS v4u*)(qb_ + ro), vk = *(const GAS v4u*)(kb_ + ro);
            float sq = 0.f, sk = 0.f, sd = 0.f; const unsigned wq[4] = {vq.x, vq.y, vq.z, vq.w}, wk[4] = {vk.x, vk.y, vk.z, vk.w};
#pragma unroll
            for (int q = 0; q < 4; ++q) { const float ql = __uint_as_float(wq[q] << 16), qh = __uint_as_float(wq[q] & 0xffff0000u), kl = __uint_as_float(wk[q] << 16), kh = __uint_as_float(wk[q] & 0xffff0000u);
                sq += ql * ql + qh * qh; sk += kl * kl + kh * kh; sd += ql * kl + qh * kh; }
#pragma unroll
            for (int o = 1; o < 16; o <<= 1) { sq += __shfl_xor(sq, o); sk += __shfl_xor(sk, o); sd += __shfl_xor(sd, o); }
            mq = fmaxf(mq, sq); mk = fmaxf(mk, sk); dmn = fminf(dmn, sd); }
        mq = fmaxf(mq, __shfl_xor(mq, 16)); mq = fmaxf(mq, __shfl_xor(mq, 32)); mk = fmaxf(mk, __shfl_xor(mk, 16)); mk = fmaxf(mk, __shfl_xor(mk, 32)); dmn = fminf(dmn, __shfl_xor(dmn, 16)); dmn = fminf(dmn, __shfl_xor(dmn, 32));
        if (F.lane == 0) { atomicMax((unsigned*)(F.ctl + CW_NORMK + bh), __float_as_uint(mk)); __hip_atomic_store(F.ctl + CW_QBLK + it, __float_as_uint(mq), RLX_AGENT); __hip_atomic_store(F.ctl + CW_DMIN + it, __float_as_uint(dmn), RLX_AGENT); } }
    late_weights(F, I, ws, gw, NGW, false);
}
constexpr int NFOX = 16 * 64, NDSA = 2 * 512;
constexpr int NFOX_Q = NFOX * (((PROBE2X >> 3) & 1) + 1), NDSA_Q = NDSA * (((PROBE2X >> 9) & 1) + 1);
__device__ __forceinline__ int queue_fetch(Frame& F, int q) {
    if (F.tid == 0) F.MISC[16] = __hip_atomic_fetch_add(F.ctl + CW_QUEUE + 64 * q, 1u, RLX_AGENT);
    __syncthreads(); const int v = __builtin_amdgcn_readfirstlane((int)F.MISC[16]); __syncthreads(); return v;
}
__device__ __forceinline__ fox::BlockRef fox_ref(Frame& F, unsigned char* ws, int id) {
    const int idm = id % NFOX, qb = 63 - (idm >> 4), bh = idm & 15, b = bh >> 3, h = bh & 7;
    fox::BlockRef r;
    r.Q = (const bf16*)(ws + WS_BQ) + ((size_t)bh * SEQ + (size_t)qb * 256) * 128; r.K = (const bf16*)(ws + WS_BK) + (size_t)bh * SEQ * 128; r.V = (const bf16*)(ws + WS_BV) + (size_t)bh * SEQ * 128;
    r.O = (bf16*)(ws + WS_MIX + ((size_t)b * SEQ + (size_t)qb * 256) * K_O + 1024 + h * 128); r.ldo = K_O;
    r.C = (const float*)(ws + WS_CUM) + (size_t)bh * SEQ; r.P0 = qb * 256; r.cref = __uint_as_float(__builtin_amdgcn_readfirstlane(__float_as_uint(r.C[r.P0])));
    const float qn = sqrtf(__uint_as_float(__hip_atomic_load(F.ctl + CW_QBLK + bh * 64 + qb, RLX_AGENT))), kn = sqrtf(__uint_as_float(__hip_atomic_load(F.ctl + CW_NORMK + bh, RLX_AGENT)));
    const float dmn = __uint_as_float(__hip_atomic_load(F.ctl + CW_DMIN + bh * 64 + qb, RLX_AGENT));
    const float lim = __uint_as_float(__builtin_amdgcn_readfirstlane(__float_as_uint(r.cref + 28.5f + (qn * kn - dmn) * fox::SCALE)));
    const int jd = r.P0 / 64; int nf = 0;
    int l4 = F.lane * 4; asm volatile("" : "+v"(l4));
    float cv[4];
#pragma unroll
    for (int i = 0; i < 4; ++i) { const int j = l4 + i; cv[i] = *(const float*)((const char*)r.C + (unsigned)((64 * (j < jd ? j : 0) + 63) * 4)); }
#pragma unroll
    for (int i = 0; i < 4; ++i) { const bool f = (l4 + i < jd) && (cv[i] > lim); nf += (int)__popcll(__ballot(f)); }
    r.jlo = ((PROBE2X >> 20) & 1) ? (nf > 16 ? nf - 16 : 0) : nf;
    return r;
}
__device__ __forceinline__ void p3_fox(Frame& F, unsigned char* ws, int q) {
    F.refresh();
    int id = (int)blockIdx.x; const int G_ = (int)gridDim.x; (void)q;
    if (id < NFOX_Q) {
        fox::Seam S; fox::BlockRef cur = fox_ref(F, ws, id);
        fox::fox_prime(cur, (char*)F.lds, S, F.tid);
        for (;;) {
            id += G_; const int idn = id; const bool more = idn < NFOX_Q;
            const fox::BlockRef nxt = more ? fox_ref(F, ws, idn) : cur;
            fox::fox_block(cur, nxt, SEQ, (char*)F.lds, S, F.tid);
            if (!more) break;
            cur = nxt;
        }
    }
    asm volatile("s_waitcnt vmcnt(0)" ::: "memory"); __syncthreads();
}
__device__ __forceinline__ void p3_dsa(Frame& F, const Inputs& I, unsigned char* ws) {
    F.refresh();
    dsa::init_tables(F.lds, I.t5, F.tid);
    __syncthreads();
    dsa::Tensors T{(const bf16*)(ws + WS_AIQ), (const float*)(ws + WS_SMALL), (const bf16*)(ws + WS_KIDX), (const unsigned char*)(ws + WS_CKV), (const unsigned char*)(ws + WS_QLAT), (bf16*)(ws + WS_OLAT)};
    const int bpref = ((int)blockIdx.x >> 2) & 1;
    _Pragma("nounroll") for (int pass = 0; pass < 2; ++pass) { const int b = bpref ^ pass;
        for (int uq = queue_fetch(F, 2 + b); uq < NDSA_Q / 2; uq = queue_fetch(F, 2 + b)) { const int u = uq % (NDSA / 2); dsa::unit(F.lds, T, b, (511 - u) * 32, F.tid); } }
}
__device__ __forceinline__ void p4_oa(Frame& F, unsigned char* ws) {
    F.refresh();
    const int h = F.vcu >> 5, part = F.vcu & 31;
    if (F.G == 256) { dsa::absorb_wg<256, 8, true>(F.lds, (const bf16*)(ws + WS_WUVT) + (size_t)h * 128 * 256, (const bf16*)(ws + WS_OLAT) + (size_t)h * M * 256, 256, (bf16*)(ws + WS_MIX + h * 128), K_O, part * 64, 8, F.tid, ((PROBE2X >> 18) & 1) + 1, pg8::MIX_SCALE); return; }
    const int gw0 = F.vcu * NWAVES + F.wave, combo = gw0 & 31, hh = combo >> 2, pr = combo & 3;
    dsa::absorb<256, 2, true>((const bf16*)(ws + WS_WUVT) + ((size_t)hh * 128 + pr * 32) * 256, (const bf16*)(ws + WS_OLAT) + (size_t)hh * M * 256, 256, (bf16*)(ws + WS_MIX + hh * 128 + pr * 32), K_O, gw0 >> 5, (F.G * NWAVES) >> 5, M / 16, F.lane, 1, pg8::MIX_SCALE);
}
__device__ __forceinline__ void p8_final(Frame& F, const Inputs& I, float* out, const bf16* x2b) {
    F.refresh();
    const int gw = F.vcu * NWAVES + F.wave, NGW = F.G * NWAVES; const float* ss2 = (const float*)((const unsigned char*)F.ctl + CTL_SS2);
    f32x4 gv[4][2];
    { const GAS f32x4* gr = (const GAS f32x4*)I.gf + 2 * F.lane;
#pragma unroll
      for (int j = 0; j < 4; ++j) { gv[j][0] = gr[128 * j]; gv[j][1] = gr[128 * j + 1]; } }
    v4u vn[4]; float sn = 0.f;
    if (gw < M) { const GAS v4u* xr = (const GAS v4u*)(x2b + (size_t)gw * DM) + F.lane;
#pragma unroll
        for (int j = 0; j < 4; ++j) vn[j] = xr[64 * j];
        sn = ss2[gw]; }
    for (int m = gw; m < M; m += NGW) {
        GAS f32x4* orow = (GAS f32x4*)(out + (size_t)m * DM) + 2 * F.lane;
        v4u vc[4]; const float sc = sn;
#pragma unroll
        for (int j = 0; j < 4; ++j) vc[j] = vn[j];
        if (m + NGW < M) { const GAS v4u* xr = (const GAS v4u*)(x2b + (size_t)(m + NGW) * DM) + F.lane;
#pragma unroll
            for (int j = 0; j < 4; ++j) vn[j] = xr[64 * j];
            sn = ss2[m + NGW]; }
        const float rstd = __builtin_amdgcn_rsqf(sc * (1.0f / DM) + 1e-6f);
#pragma unroll
        for (int j = 0; j < 4; ++j) { const v4u v = vc[j]; const f32x4 g0 = gv[j][0], g1 = gv[j][1];
            const f32x4 a = {__uint_as_float(v.x << 16), __uint_as_float(v.x & 0xffff0000u), __uint_as_float(v.y << 16), __uint_as_float(v.y & 0xffff0000u)};
            const f32x4 b = {__uint_as_float(v.z << 16), __uint_as_float(v.z & 0xffff0000u), __uint_as_float(v.w << 16), __uint_as_float(v.w & 0xffff0000u)};
            orow[128 * j] = a * g0 * rstd; orow[128 * j + 1] = b * g1 * rstd; }
    }
}

struct Args { const float* in[15]; float* out; unsigned char* ws; int ph_lo, ph_hi; };
__global__ void __launch_bounds__(NWAVES * 64, 2) layer_fwd(Args args) {
    extern __shared__ __attribute__((aligned(16))) unsigned char lds[];
    Frame F;
    F.lds = (LAS unsigned char*)lds; F.MISC = (volatile LAS unsigned*)(F.lds + MISC_OFF);
    F.wave = __builtin_amdgcn_readfirstlane((int)threadIdx.x >> 6); F.refresh();
    F.G = gridDim.x; { const int bx = blockIdx.x; F.vcu = (F.G % 8 == 0) ? (bx % 8) * (F.G / 8) + bx / 8 : bx; }
    unsigned char* ws = args.ws; F.ctl = (gu32*)(ws + WS_CTL);
    Inputs I{args.in[0], args.in[1], args.in[2], args.in[3], args.in[4], args.in[5], args.in[6], args.in[7], args.in[8], args.in[9], args.in[10], args.in[11], args.in[12], args.in[13], args.in[14]};
    for (int u = F.tid; u < (LDS_BYTES - LDSCTL_OFF) / 4; u += NWAVES * 64) ((LAS unsigned*)(F.lds + LDSCTL_OFF))[u] = 0u;
    __syncthreads();
    XcdBarrier bar; bar.bar = (unsigned*)(F.ctl + CW_BAR); bar.x = 0; bar.st = nullptr;
    if (N_LAUNCHES == 1) bar = xcd_barrier_post((unsigned*)(F.ctl + CW_BAR), F.MISC + 8, F.tid == 0);
    const int lo = args.ph_lo, hi = args.ph_hi;
#ifndef PH_MASK
#define PH_MASK 0x3ff
#endif
#define IN(k) (((PH_MASK >> (k)) & 1) && lo <= (k) && (k) < hi)
#define SEAM(k) do { if (IN(k) && IN((k) + 1)) xcd_barrier(bar, F.wave * 64 + fresh_lane() == 0); } while (0)
    float* SS1 = (float*)((unsigned char*)F.ctl + CTL_SS1); float* SS2 = (float*)((unsigned char*)F.ctl + CTL_SS2);
    if (IN(0)) { p0_prologue(F, I, ws); SEAM(0); }
    if (IN(1)) {
        { pg8::Gemm g{(const pg8::bf16_t*)(ws + WS_H), (const pg8::bf16_t*)(ws + WS_WIN), M, N_INB, DM}; pg8::StaticOrder S; S.init(M, N_INB, F.G, (int)blockIdx.x, ((PROBE2X >> 1) & 1) + 1);
          pg8::EpiInProj E{(pg8::bf16_t*)(ws + WS_AQ), (pg8::bf16_t*)(ws + WS_AKV), (pg8::bf16_t*)(ws + WS_AIQ), (pg8::bf16_t*)(ws + WS_BQ), (size_t)(WS_BK - WS_BQ) / 2, (float*)(ws + WS_SMALL)};
          pg8::gemm_phase<pg8::EpiInProj, pg8::StaticOrder, true, true>(F.lds + RING_OFF, g, S, E, F.wave * 64 + fresh_lane()); }
        { pg8::Gemm g{(const pg8::bf16_t*)(ws + WS_H8), (const pg8::bf16_t*)(ws + WS_WIN8), M, N_IN8, DM / 2}; pg8::StaticOrder S; S.init(M, N_IN8, F.G, (int)blockIdx.x, ((PROBE2X >> 1) & 1) + 1);
          pg8::EpiInProj8 E{(pg8::bf16_t*)(ws + WS_AQ), (pg8::bf16_t*)(ws + WS_AKV), (pg8::bf16_t*)(ws + WS_AIQ), (pg8::bf16_t*)(ws + WS_BQ), (size_t)(WS_BK - WS_BQ) / 2, (float*)(ws + WS_SMALL)};
          pg8::gemm_phase<pg8::EpiInProj8, pg8::StaticOrder, true, true, true>(F.lds + RING_OFF, g, S, E, F.wave * 64 + fresh_lane()); }
        SEAM(1);
    }
    if (IN(2)) { p2_misc(F, I, ws); SEAM(2); }
    if (IN(3)) {
        _Pragma("nounroll") for (int rep = 0; rep < 1; ++rep) p3_fox(F, ws, rep);
        p3_dsa(F, I, ws);
        SEAM(3);
    }
    if (IN(4)) { _Pragma("nounroll") for (int rep = 0; rep < ((PROBE2X >> 18) & 1) + 1; ++rep) { if (rep) xcd_barrier(bar, F.wave * 64 + fresh_lane() == 0); p4_oa(F, ws); } SEAM(4); }
    if (IN(5)) {
        pg8::Gemm g{(const pg8::bf16_t*)(ws + WS_MIX), (const pg8::bf16_t*)(ws + WS_WO), M, DM, K_O / 2}; pg8::StaticOrder S; S.init(M, DM, F.G, (int)blockIdx.x);
        pg8::EpiOutProj E{I.x, (pg8::bf16_t*)(ws + WS_H), (pg8::bf16_t*)(ws + WS_AHALO), SS1};
        pg8::gemm_phase<pg8::EpiOutProj, pg8::StaticOrder, true, true, true>(F.lds + RING_OFF, g, S, E, F.wave * 64 + fresh_lane());
        SEAM(5);
    }
    if (IN(6)) {
        pg8::Gemm g{(const pg8::bf16_t*)(ws + WS_AHALO), (const pg8::bf16_t*)(ws + WS_WUP), NHALO, FF2, DM}; pg8::StaticOrder S; S.init(NHALO, FF2, F.G, (int)blockIdx.x);
        pg8::EpiHalo E{SS1, (float*)(ws + WS_UHALO)};
        pg8::gemm_phase<pg8::EpiHalo, pg8::StaticOrder, true, true>(F.lds + RING_OFF, g, S, E, F.wave * 64 + fresh_lane());
        constexpr int NHU = (NHALO / 256) * (FF2 / 256);
        if ((int)blockIdx.x >= NHU) { F.refresh(); late_weights(F, I, ws, ((int)blockIdx.x - NHU) * NWAVES + F.wave, ((int)gridDim.x - NHU) * NWAVES, true); }
        SEAM(6);
    }
    if (IN(7)) {
        pg8::Gemm g{(const pg8::bf16_t*)(ws + WS_H), (const pg8::bf16_t*)(ws + WS_WUP), M, FF2, DM}; pg8::StaticOrder S; S.init(M, FF2, F.G, (int)blockIdx.x, ((PROBE2X >> 6) & 1) + 1);
        pg8::EpiUp E{SS1, (const float*)(ws + WS_UHALO), I.conv_w, I.conv_b, ws + WS_ACT};
        pg8::gemm_phase<pg8::EpiUp, pg8::StaticOrder, true, true>(F.lds + RING_OFF, g, S, E, F.wave * 64 + fresh_lane());
        SEAM(7);
    }
    if (IN(8)) {
        pg8::Gemm g{(const pg8::bf16_t*)(ws + WS_ACT), (const pg8::bf16_t*)(ws + WS_WDN), M, DM, FF / 2}; pg8::StaticOrder S; S.init(M, DM, F.G, (int)blockIdx.x);
        pg8::EpiDown E{(const pg8::bf16_t*)(ws + WS_H), (pg8::bf16_t*)(ws + WS_X2B), SS2};
        pg8::gemm_phase<pg8::EpiDown, pg8::StaticOrder, true, true, true>(F.lds + RING_OFF, g, S, E, F.wave * 64 + fresh_lane());
        SEAM(8);
    }
    if (IN(9)) p8_final(F, I, args.out, (const bf16*)(ws + WS_X2B));
#undef IN
#undef SEAM
}

extern "C" void kernel_launch(void* const* d_in, const int* in_sizes, int n_in, void* d_out, int out_size, void* d_ws, size_t ws_size, hipStream_t stream) {
    static int grid = 0;
    if (grid == 0) {
        if (n_in != 15 || in_sizes[0] != M * DM || out_size != M * DM || ws_size < WS_END) { fprintf(stderr, "kernel_launch: unexpected shapes (n_in %d, in0 %d, out %d, ws %zu)\n", n_in, n_in > 0 ? in_sizes[0] : -1, out_size, ws_size); grid = -1; return; }
        int dev = 0, cus = 0, per_cu = 0;
        if (hipGetDevice(&dev) != hipSuccess || hipDeviceGetAttribute(&cus, hipDeviceAttributeMultiprocessorCount, dev) != hipSuccess) { grid = -1; return; }
        if (hipFuncSetAttribute((const void*)layer_fwd, hipFuncAttributeMaxDynamicSharedMemorySize, LDS_BYTES) != hipSuccess) { fprintf(stderr, "kernel_launch: hipFuncSetAttribute failed\n"); grid = -1; return; }
        if (hipOccupancyMaxActiveBlocksPerMultiprocessor(&per_cu, (const void*)layer_fwd, NWAVES * 64, LDS_BYTES) != hipSuccess || per_cu < 1) fprintf(stderr, "kernel_launch: occupancy query reports %d\n", per_cu);
        (void)hipGetLastError();
        grid = cus;
    }
    if (grid < 0) return;
    if (hipMemsetAsync((char*)d_ws + WS_CTL, 0, CTL_ZERO_BYTES, stream) != hipSuccess) return;
    Args a{};
    for (int i = 0; i < 15; ++i) a.in[i] = (const float*)d_in[i];
    a.out = (float*)d_out; a.ws = (unsigned char*)d_ws;
    for (int li = 0; li < N_LAUNCHES; ++li) {
        a.ph_lo = (N_LAUNCHES == 1) ? 0 : li; a.ph_hi = (N_LAUNCHES == 1) ? N_PHASES : li + 1;
        hipLaunchKernelGGL(layer_fwd, dim3(grid), dim3(NWAVES * 64), LDS_BYTES, stream, a);
        if (hipPeekAtLastError() != hipSuccess) { fprintf(stderr, "kernel_launch: launch %d failed\n", li); break; }
    }
}
```

```cpp
#include <hip/hip_runtime.h>
#include <cstdio>
#include <cstdint>
#ifndef PROBE2X
#define PROBE2X 0
#endif
namespace pg8 {
#define PG8_LAS __attribute__((address_space(3)))
typedef unsigned short bf16_t;
typedef short bf16x8 __attribute__((ext_vector_type(8)));
typedef float f32x4 __attribute__((ext_vector_type(4)));
typedef unsigned u32x4 __attribute__((ext_vector_type(4)));
typedef int i32x4 __attribute__((ext_vector_type(4)));
typedef int i32x8 __attribute__((ext_vector_type(8)));
constexpr float MIX_SCALE = 32.0f, WO_SCALE = 1024.0f;
__device__ __forceinline__ i32x8 cat8(bf16x8 a, bf16x8 b) { const i32x4 x = (i32x4)a, y = (i32x4)b; return __builtin_shufflevector(x, y, 0, 1, 2, 3, 4, 5, 6, 7); }
constexpr int BM = 256, BK = 64, HALF = 128, HTB = HALF * BK * 2  , STAGE_BYTES = 8 * HTB, NXCD = 8, WGM = 8;

__host__ __device__ __forceinline__ int lds_byte(int r, int c) { const int st = (r >> 4) * 2 + (c >> 5), rr = r & 15, cc = c & 31, ob = rr * 64 + cc * 2; return st * 1024 + (ob ^ (((ob >> 9) & 1) << 5)); }
__host__ __device__ __forceinline__ void stage_rc(int b, int& R, int& C) { const int st = b / 1024, sb = b % 1024, swz = sb ^ (((sb >> 9) & 1) << 5); R = (st >> 1) * 16 + swz / 64; C = (st & 1) * 32 + (swz % 64) / 2; }
__host__ __device__ __forceinline__ int perm32(int rho) { const int n = rho >> 4, i = rho & 15; return 8 * (i >> 2) + 4 * n + (i & 3); }

struct Unit { int pm, pn; };
struct Gemm { const bf16_t* A; const bf16_t* Bt; int M, N, K; };

struct StaticOrder {
    int nM, nN, nwg, G, c, reps;
    __host__ __device__ void init(int M, int N, int G_, int c_, int reps_ = 1) { nM = M / BM; nN = N / BM; nwg = nM * nN; G = G_; c = c_; reps = reps_; }
    __host__ __device__ bool next(int i, Unit& u) const {
        const long L = (long)i * G + c; if (L >= (long)nwg * reps) return false;
        int wgid = (int)(L % nwg); { const int q = nwg / NXCD, r = nwg % NXCD, xcd = wgid % NXCD, off = wgid / NXCD; wgid = (xcd < r ? xcd * (q + 1) : r * (q + 1) + (xcd - r) * q) + off; }
        const int nig = WGM * nN, gid = wgid / nig, fm = gid * WGM, gsz = (nM - fm) < WGM ? (nM - fm) : WGM;
        u.pm = fm + ((wgid % nig) % gsz); u.pn = (wgid % nig) / gsz; return true;
    }
    __device__ __forceinline__ void a_ready(const Unit&) const {}
    __device__ __forceinline__ void done(const Unit&) const {}
};

__device__ __forceinline__ unsigned cvt_pk_bf16(float lo, float hi) { unsigned r; asm volatile("v_cvt_pk_bf16_f32 %0, %1, %2" : "=v"(r) : "v"(lo), "v"(hi)); return r; }
__device__ __forceinline__ u32x4 pack8bf(const f32x4 v0, const f32x4 v1) { u32x4 w; w.x = cvt_pk_bf16(v0[0], v0[1]); w.y = cvt_pk_bf16(v0[2], v0[3]); w.z = cvt_pk_bf16(v1[0], v1[1]); w.w = cvt_pk_bf16(v1[2], v1[3]); return w; }
__device__ __forceinline__ float dot4(const f32x4 a) { return (a[0] * a[0] + a[1] * a[1]) + (a[2] * a[2] + a[3] * a[3]); }
__device__ __forceinline__ float sum_g4(float v) {
    v += __int_as_float(__builtin_amdgcn_ds_swizzle(__float_as_int(v), 0x401F));
    typedef unsigned u2_ __attribute__((ext_vector_type(2)));
    const u2_ r = __builtin_amdgcn_permlane32_swap(__float_as_uint(v), __float_as_uint(v), false, false);
    return __uint_as_float(r[0]) + __uint_as_float(r[1]);
}
template <int CTRL> __device__ __forceinline__ float dppf(float v) { return __builtin_bit_cast(float, __builtin_amdgcn_update_dpp(0, __builtin_bit_cast(int, v), CTRL, 0xf, 0xf, false)); }

constexpr float H8_SCALE = 16.0f, WIN8_SCALE = 1024.0f;
template <bool F8>
struct EpiInProjT {
    static constexpr bool PERM = true, AFTER_DRAIN = false;
    bf16_t *aq, *akv, *aiq, *bq; size_t qkv_stride; float* small;
    __device__ __forceinline__ void operator()(const f32x4 (&acc0)[2][2][4][2], const Unit& u, int wr, int wc, int fr, int fq) const {
        const int pn = F8 ? (u.pn < 4 ? u.pn : u.pn + 5) : (u.pn == 5 ? 21 : u.pn + 4), row0 = u.pm * BM + wr * 64 + fr, cl = wc * 32 + 8 * fq;
        f32x4 acc[2][2][4][2];
#pragma unroll
        for (int a = 0; a < 2; ++a)
#pragma unroll
            for (int b = 0; b < 2; ++b)
#pragma unroll
                for (int m = 0; m < 4; ++m)
#pragma unroll
                    for (int n = 0; n < 2; ++n) acc[a][b][m][n] = F8 ? acc0[a][b][m][n] * (1.0f / (H8_SCALE * WIN8_SCALE)) : acc0[a][b][m][n];
        if (pn < 4) {
#pragma unroll
            for (int ai = 0; ai < 2; ++ai)
#pragma unroll
                for (int m = 0; m < 4; ++m) { const int row = row0 + ai * HALF + m * 16;
#pragma unroll
                    for (int bj = 0; bj < 2; ++bj) *(u32x4*)(aq + ((size_t)(2 * pn + bj) * 32768 + row) * 128 + cl) = pack8bf(acc[ai][bj][m][0], acc[ai][bj][m][1]); }
        } else if (pn < 9) {
            bf16_t* dst; int ld, cb;
            if (pn == 4) { dst = akv; ld = 256; cb = 0; } else { dst = aiq; ld = 1024; cb = (pn - 5) * 256; }
#pragma unroll
            for (int ai = 0; ai < 2; ++ai)
#pragma unroll
                for (int m = 0; m < 4; ++m) { bf16_t* rowp = dst + (size_t)(row0 + ai * HALF + m * 16) * ld + cb + cl;
#pragma unroll
                    for (int bj = 0; bj < 2; ++bj) *(u32x4*)(rowp + bj * HALF) = pack8bf(acc[ai][bj][m][0], acc[ai][bj][m][1]); }
        } else if (pn < 21) {
            const int w = (pn - 9) >> 2, hp = (pn - 9) & 3; bf16_t* dst = bq + (size_t)w * qkv_stride;
#pragma unroll
            for (int ai = 0; ai < 2; ++ai)
#pragma unroll
                for (int m = 0; m < 4; ++m) { const int row = row0 + ai * HALF + m * 16, b = row >> 14, t = row & 16383;
#pragma unroll
                    for (int bj = 0; bj < 2; ++bj) *(u32x4*)(dst + ((size_t)(b * 8 + 2 * hp + bj) * 16384 + t) * 128 + cl) = pack8bf(acc[ai][bj][m][0], acc[ai][bj][m][1]); }
        } else {
#pragma unroll
            for (int ai = 0; ai < 2; ++ai)
#pragma unroll
                for (int m = 0; m < 4; ++m) { float* rp = small + (size_t)(row0 + ai * HALF + m * 16) * 128 + cl; *(f32x4*)rp = acc[ai][0][m][0]; *(f32x4*)(rp + 4) = acc[ai][0][m][1]; }
        }
    }
};
typedef EpiInProjT<false> EpiInProj; typedef EpiInProjT<true> EpiInProj8;
struct EpiOutProj {
    static constexpr bool PERM = true, AFTER_DRAIN = false;
    const float* x; bf16_t* x1b; bf16_t* ahalo; float* ss;
    __device__ __forceinline__ void operator()(const f32x4 (&acc)[2][2][4][2], const Unit& u, int wr, int wc, int fr, int fq) const {
        const int row0 = u.pm * BM + wr * 64 + fr, col0 = u.pn * BM + wc * 32 + 8 * fq;
#pragma unroll
        for (int ai = 0; ai < 2; ++ai) {
            f32x4 xv[4][2][2];
#pragma unroll
            for (int m = 0; m < 4; ++m)
#pragma unroll
                for (int bj = 0; bj < 2; ++bj) { const size_t o = (size_t)(row0 + ai * HALF + m * 16) * 2048 + col0 + bj * HALF; xv[m][bj][0] = __builtin_nontemporal_load((const f32x4*)(x + o)); xv[m][bj][1] = __builtin_nontemporal_load((const f32x4*)(x + o + 4)); }
#pragma unroll
            for (int m = 0; m < 4; ++m) { const int row = row0 + ai * HALF + m * 16; float s = 0.f;
#pragma unroll
                for (int bj = 0; bj < 2; ++bj) { const size_t o = (size_t)row * 2048 + col0 + bj * HALF;
                    const f32x4 v0 = xv[m][bj][0] + acc[ai][bj][m][0] * (1.0f / (MIX_SCALE * WO_SCALE)), v1 = xv[m][bj][1] + acc[ai][bj][m][1] * (1.0f / (MIX_SCALE * WO_SCALE));
                    const u32x4 w = pack8bf(v0, v1); *(u32x4*)(x1b + o) = w;
                    if ((row & 63) >= 62) *(u32x4*)(ahalo + (size_t)(2 * (row >> 6) + (row & 1)) * 2048 + col0 + bj * HALF) = w;
                    s += dot4(v0) + dot4(v1); }
                s = sum_g4(s);
                if (fq == 0) unsafeAtomicAdd(ss + row, s); } }
    }
};
struct EpiHalo {
    static constexpr bool PERM = true, AFTER_DRAIN = false;
    const float* ss; float* uh;
    __device__ __forceinline__ void operator()(const f32x4 (&acc)[2][2][4][2], const Unit& u, int wr, int wc, int fr, int fq) const {
        const int row0 = u.pm * BM + wr * 64 + fr, col0 = u.pn * BM + wc * 32 + 8 * fq;
        float rsv[2][4];
#pragma unroll
        for (int ai = 0; ai < 2; ++ai)
#pragma unroll
            for (int m = 0; m < 4; ++m) { const int hr = row0 + ai * HALF + m * 16, src = 64 * (hr >> 1) + 62 + (hr & 1); rsv[ai][m] = ss[src]; }
#pragma unroll
        for (int ai = 0; ai < 2; ++ai)
#pragma unroll
            for (int m = 0; m < 4; ++m) { const int hr = row0 + ai * HALF + m * 16;
                const float rs = __builtin_amdgcn_rsqf(rsv[ai][m] * (1.0f / 2048.0f) + 1e-6f);
#pragma unroll
                for (int bj = 0; bj < 2; ++bj) { float* p = uh + (size_t)hr * 11264 + col0 + bj * HALF; *(f32x4*)p = acc[ai][bj][m][0] * rs; *(f32x4*)(p + 4) = acc[ai][bj][m][1] * rs; } }
    }
};
constexpr float ACT_SCALE = 16.0f, WDN_SCALE = 1024.0f;
struct EpiUp {
    static constexpr bool PERM = true, AFTER_DRAIN = false;
    const float* ss; const float* uh; const float* cw; const float* cbias; unsigned char* act;
    __device__ __forceinline__ void operator()(const f32x4 (&acc)[2][2][4][2], const Unit& u, int wr, int wc, int fr, int fq) const {
        const int pn = u.pn, cl = wc * 32 + 8 * fq, rowb0 = u.pm * BM + wr * 64;
        unsigned pk[2][4];
        const unsigned long long m15 = __ballot(fr == 15), m14 = __ballot(fr >= 14);
        float rsv[2][4];
#pragma unroll
        for (int ai = 0; ai < 2; ++ai)
#pragma unroll
            for (int m = 0; m < 4; ++m) rsv[ai][m] = ss[rowb0 + ai * HALF + m * 16 + fr];
#pragma unroll
        for (int ai = 0; ai < 2; ++ai)
#pragma unroll
            for (int m = 0; m < 4; ++m) rsv[ai][m] = __builtin_amdgcn_rsqf(rsv[ai][m] * (1.0f / 2048.0f) + 1e-6f);
#pragma unroll
        for (int n = 0; n < 2; ++n) {
            f32x4 w0[2], w1[2], w2[2], bb[2];
#pragma unroll
            for (int bj = 0; bj < 2; ++bj) { const int oc = bj * 5632 + pn * 128 + cl + 4 * n;
                w0[bj] = *(const f32x4*)(cw + oc); w1[bj] = *(const f32x4*)(cw + 11264 + oc); w2[bj] = *(const f32x4*)(cw + 22528 + oc); bb[bj] = *(const f32x4*)(cbias + oc); }
            f32x4 prevh[2][2];
#pragma unroll
            for (int ai = 0; ai < 2; ++ai) { const int rb = rowb0 + ai * HALF;
                prevh[ai][0] = prevh[ai][1] = (f32x4){0.f, 0.f, 0.f, 0.f};
                if ((rb & 16383) != 0 && fr >= 14) { const int hr = 2 * ((rb >> 6) - 1) + (fr - 14);
#pragma unroll
                    for (int bj = 0; bj < 2; ++bj) prevh[ai][bj] = *(const f32x4*)(uh + (size_t)hr * 11264 + pn * 256 + bj * HALF + cl + 4 * n); } }
#pragma unroll
            for (int ai = 0; ai < 2; ++ai) {
                const int rb = rowb0 + ai * HALF;
                f32x4 prev[2] = {prevh[ai][0], prevh[ai][1]};
#pragma unroll
                for (int m = 0; m < 4; ++m) {
                    const int row = rb + m * 16 + fr; const float rs = rsv[ai][m];
                    f32x4 y[2];
#pragma unroll
                    for (int bj = 0; bj < 2; ++bj) { const f32x4 uc = acc[ai][bj][m][n] * rs;
#pragma unroll
                        for (int j = 0; j < 4; j += 2) {
                            float ya = fmaf(w2[bj][j], uc[j], bb[bj][j]), yb = fmaf(w2[bj][j + 1], uc[j + 1], bb[bj][j + 1]); float t0, t1, r0, r1;
                            asm("v_cndmask_b32_e64 %2, %6, %8, %10\n\tv_cndmask_b32_e64 %3, %7, %9, %10\n\tv_cndmask_b32_e64 %4, %6, %8, %11\n\tv_cndmask_b32_e64 %5, %7, %9, %11\n\t"
                                "v_fmac_f32_dpp %0, %2, %12 row_ror:1 row_mask:0xf bank_mask:0xf\n\tv_fmac_f32_dpp %1, %3, %13 row_ror:1 row_mask:0xf bank_mask:0xf\n\t"
                                "v_fmac_f32_dpp %0, %4, %14 row_ror:2 row_mask:0xf bank_mask:0xf\n\tv_fmac_f32_dpp %1, %5, %15 row_ror:2 row_mask:0xf bank_mask:0xf"
                                : "+v"(ya), "+v"(yb), "=&v"(t0), "=&v"(t1), "=&v"(r0), "=&v"(r1)
                                : "v"(uc[j]), "v"(uc[j + 1]), "v"(prev[bj][j]), "v"(prev[bj][j + 1]), "s"(m15), "s"(m14), "v"(w1[bj][j]), "v"(w1[bj][j + 1]), "v"(w0[bj][j]), "v"(w0[bj][j + 1]));
                            y[bj][j] = ya; y[bj][j + 1] = yb; }
                        prev[bj] = uc; }
                    float a[4];
#pragma unroll
                    for (int j = 0; j < 4; ++j) { const float g = y[0][j]; a[j] = g * __builtin_amdgcn_rcpf(1.0f + __builtin_amdgcn_exp2f(-1.4426950408889634f * g)) * y[1][j]; }
#pragma unroll
                    for (int j = 0; j < 4; ++j) a[j] = __builtin_amdgcn_fmed3f(a[j] * ACT_SCALE, -448.0f, 448.0f);
                    int w8 = __builtin_amdgcn_cvt_pk_fp8_f32(a[0], a[1], 0, false); w8 = __builtin_amdgcn_cvt_pk_fp8_f32(a[2], a[3], w8, true); asm volatile("" : "+v"(w8));
                    if (n == 0) pk[ai][m] = (unsigned)w8;
                    else *(unsigned long long*)(act + (size_t)row * 5632 + pn * 128 + cl) = (unsigned long long)pk[ai][m] | ((unsigned long long)(unsigned)w8 << 32);
                }
            }
        }
    }
};
struct EpiDown {
    static constexpr bool PERM = true, AFTER_DRAIN = false;
    const bf16_t* xin; bf16_t* xout; float* ss;
    __device__ __forceinline__ void operator()(const f32x4 (&acc)[2][2][4][2], const Unit& u, int wr, int wc, int fr, int fq) const {
        const int row0 = u.pm * BM + wr * 64 + fr, col0 = u.pn * BM + wc * 32 + 8 * fq;
#pragma unroll
        for (int ai = 0; ai < 2; ++ai) {
            u32x4 xbv[4][2];
#pragma unroll
            for (int m = 0; m < 4; ++m)
#pragma unroll
                for (int bj = 0; bj < 2; ++bj) xbv[m][bj] = *(const u32x4*)(xin + (size_t)(row0 + ai * HALF + m * 16) * 2048 + col0 + bj * HALF);
#pragma unroll
            for (int m = 0; m < 4; ++m) { const int row = row0 + ai * HALF + m * 16; float s = 0.f;
#pragma unroll
                for (int bj = 0; bj < 2; ++bj) { const size_t o = (size_t)row * 2048 + col0 + bj * HALF;
                    const u32x4 xb = xbv[m][bj];
                    const f32x4 x0 = {__uint_as_float(xb.x << 16), __uint_as_float(xb.x & 0xffff0000u), __uint_as_float(xb.y << 16), __uint_as_float(xb.y & 0xffff0000u)}, x1 = {__uint_as_float(xb.z << 16), __uint_as_float(xb.z & 0xffff0000u), __uint_as_float(xb.w << 16), __uint_as_float(xb.w & 0xffff0000u)};
                    const f32x4 v0 = x0 + acc[ai][bj][m][0] * (1.0f / (ACT_SCALE * WDN_SCALE)), v1 = x1 + acc[ai][bj][m][1] * (1.0f / (ACT_SCALE * WDN_SCALE));
                    *(u32x4*)(xout + o) = pack8bf(v0, v1); s += dot4(v0) + dot4(v1); }
                s = sum_g4(s);
                if (fq == 0) unsafeAtomicAdd(ss + row, s); } }
    }
};
template <class Epi, class Sched, bool ALIGN_EPI = false, bool SP2 = false, bool FP8 = false>
__device__ __forceinline__ void gemm_phase(PG8_LAS unsigned char* lds, const Gemm g, const Sched& S, const Epi& E, const int tid  ) {
    const int wid = __builtin_amdgcn_readfirstlane(tid >> 6), lane = tid & 63, wr = wid >> 2, wc = wid & 3, fr = lane & 15, fq = lane >> 4;
    const int K = g.K, nt = K / BK;
    unsigned voffA[2], voffB[2];
#pragma unroll
    for (int i = 0; i < 2; ++i) { int R, C; stage_rc(tid * 16 + i * 8192, R, C); const int Rb = Epi::PERM ? ((R & ~31) + perm32(R & 31)) : R;
        voffA[i] = (unsigned)(R * K + C) * 2u; voffB[i] = (unsigned)(Rb * K + C) * 2u; }
    const size_t kstep = (size_t)(BK * 2);
    const size_t hstep = (size_t)HALF * K * 2;
    const size_t tstep = 2 * hstep;
    const unsigned ldsw = (unsigned)wid * 1024u;
    const int aoff = lds_byte(wr * 64 + fr, fq * 8), boff = lds_byte(wc * 32 + fr, fq * 8);
#define PG8_SA(b, h) (((b) * 2 + (h)) * HTB)
#define PG8_SB(b, h) ((4 + (b) * 2 + (h)) * HTB)
#define PG8_STAGE(bufoff, gbase, voff) do { const char* _gb = (const char*)(gbase); if constexpr (FP8) asm volatile("" : "+s"(_gb));     \
        _Pragma("unroll") for (int _i = 0; _i < 2; ++_i) \
        __builtin_amdgcn_global_load_lds((const unsigned*)(_gb + (voff)[_i]), (PG8_LAS unsigned*)(lds + (bufoff) + ldsw + _i * 8192), 16, 0, 0); } while (0)
#define PG8_LDA(dst, b, h) do { _Pragma("unroll") for (int m = 0; m < 4; ++m) _Pragma("unroll") for (int k = 0; k < 2; ++k) dst[m][k] = *(const PG8_LAS bf16x8*)(lds + PG8_SA(b, h) + aoff + m * 2048 + k * 1024); } while (0)
#define PG8_LDB(dst, b, h) do { _Pragma("unroll") for (int n = 0; n < 2; ++n) _Pragma("unroll") for (int k = 0; k < 2; ++k) dst[n][k] = *(const PG8_LAS bf16x8*)(lds + PG8_SB(b, h) + boff + n * 2048 + k * 1024); } while (0)
#define PG8_MMA(ai, bj, At, Bt) do { __builtin_amdgcn_s_setprio(1); \
        if constexpr (FP8) { _Pragma("unroll") for (int m = 0; m < 4; ++m) _Pragma("unroll") for (int n = 0; n < 2; ++n) \
            acc[ai][bj][m][n] = __builtin_amdgcn_mfma_scale_f32_16x16x128_f8f6f4(cat8(Bt[n][0], Bt[n][1]), cat8(At[m][0], At[m][1]), acc[ai][bj][m][n], 0, 0, 0, 0, 0, 0); } \
        else { _Pragma("unroll") for (int m = 0; m < 4; ++m) _Pragma("unroll") for (int n = 0; n < 2; ++n) _Pragma("unroll") for (int k = 0; k < 2; ++k) \
            acc[ai][bj][m][n] = __builtin_amdgcn_mfma_f32_16x16x32_bf16(Bt[n][k], At[m][k], acc[ai][bj][m][n], 0, 0, 0); } \
        __builtin_amdgcn_s_setprio(0); } while (0)
#define PG8_WAIT_V(n) asm volatile("s_waitcnt vmcnt(" #n ")" ::: "memory")
#define PG8_WAIT_L(n) asm volatile("s_waitcnt lgkmcnt(" #n ")" ::: "memory")
#define PG8_BAR __builtin_amdgcn_s_barrier()
#define PG8_SCHED __builtin_amdgcn_sched_barrier(0)
    Unit cur, nxt; int ui = 0;
    if (!S.next(0, cur)) return;
    f32x4 acc[2][2][4][2];
#pragma unroll
    for (int a = 0; a < 2; ++a)
#pragma unroll
        for (int b = 0; b < 2; ++b)
#pragma unroll
            for (int m = 0; m < 4; ++m)
#pragma unroll
                for (int n = 0; n < 2; ++n) acc[a][b][m][n] = (f32x4){0.f, 0.f, 0.f, 0.f};
    bf16x8 At[4][2], B0[2][2], B1[2][2];
    const char* cA = (const char*)g.A + (size_t)cur.pm * tstep; const char* cB = (const char*)g.Bt + (size_t)cur.pn * tstep;
    S.a_ready(cur);
    if constexpr (SP2) {
        PG8_STAGE(PG8_SB(0, 0), cB, voffB); PG8_STAGE(PG8_SB(0, 1), cB + hstep, voffB); PG8_STAGE(PG8_SA(0, 0), cA, voffA); PG8_STAGE(PG8_SA(0, 1), cA + hstep, voffA);
        if (wr == 1) PG8_BAR;
        PG8_WAIT_V(2); PG8_BAR;
        PG8_STAGE(PG8_SB(1, 0), cB + kstep, voffB); PG8_STAGE(PG8_SA(1, 0), cA + kstep, voffA); PG8_STAGE(PG8_SB(1, 1), cB + hstep + kstep, voffB);
        PG8_WAIT_V(6); PG8_BAR;
    } else {
        PG8_STAGE(PG8_SB(0, 0), cB, voffB); PG8_STAGE(PG8_SA(0, 0), cA, voffA); PG8_STAGE(PG8_SB(0, 1), cB + hstep, voffB); PG8_STAGE(PG8_SA(0, 1), cA + hstep, voffA);
        if (wr == 1) PG8_BAR;
        PG8_WAIT_V(4); PG8_BAR;
        PG8_STAGE(PG8_SB(1, 0), cB + kstep, voffB); PG8_STAGE(PG8_SA(1, 0), cA + kstep, voffA); PG8_STAGE(PG8_SB(1, 1), cB + hstep + kstep, voffB);
        PG8_WAIT_V(6); PG8_BAR;
    }
    for (;;) {
        const bool has_next = S.next(ui + 1, nxt);
        const char* nA = has_next ? (const char*)g.A + (size_t)nxt.pm * tstep : cA; const char* nB = has_next ? (const char*)g.Bt + (size_t)nxt.pn * tstep : cB;
        for (int t = 0; t < nt; t += 2) {
            const bool last = (t == nt - 2);
            const char* a1 = cA + (size_t)(t + 1) * kstep;
            const char* a2 = last ? nA : cA + (size_t)(t + 2) * kstep; const char* b2 = last ? nB : cB + (size_t)(t + 2) * kstep;
            const char* a3 = a2 + kstep; const char* b3 = b2 + kstep;
            if (last && has_next) S.a_ready(nxt);
            if constexpr (SP2) {
            PG8_LDB(B0, 0, 0); PG8_LDB(B1, 0, 1); PG8_SCHED; PG8_LDA(At, 0, 0); PG8_STAGE(PG8_SA(1, 1), a1 + hstep, voffA);
            PG8_WAIT_V(8); PG8_WAIT_L(0); PG8_BAR; PG8_MMA(0, 0, At, B0); PG8_MMA(0, 1, At, B1); PG8_BAR; PG8_SCHED;
            PG8_LDA(At, 0, 1); PG8_STAGE(PG8_SB(0, 0), b2, voffB); PG8_STAGE(PG8_SB(0, 1), b2 + hstep, voffB); PG8_STAGE(PG8_SA(0, 0), a2, voffA);
            PG8_WAIT_V(8); PG8_WAIT_L(0); PG8_BAR; PG8_MMA(1, 0, At, B0); PG8_MMA(1, 1, At, B1); PG8_BAR; PG8_SCHED;
            PG8_LDB(B0, 1, 0); PG8_LDB(B1, 1, 1); PG8_SCHED; PG8_LDA(At, 1, 0); PG8_STAGE(PG8_SA(0, 1), a2 + hstep, voffA);
            PG8_WAIT_V(8); PG8_WAIT_L(0); PG8_BAR; PG8_MMA(0, 0, At, B0); PG8_MMA(0, 1, At, B1); PG8_BAR; PG8_SCHED;
            PG8_LDA(At, 1, 1); PG8_STAGE(PG8_SB(1, 0), b3, voffB); PG8_STAGE(PG8_SB(1, 1), b3 + hstep, voffB); PG8_STAGE(PG8_SA(1, 0), a3, voffA);
            PG8_WAIT_V(8); PG8_WAIT_L(0); PG8_BAR; PG8_MMA(1, 0, At, B0); PG8_MMA(1, 1, At, B1); PG8_BAR; PG8_SCHED;
            } else {
            PG8_LDB(B0, 0, 0); PG8_SCHED; PG8_LDA(At, 0, 0); PG8_STAGE(PG8_SA(1, 1), a1 + hstep, voffA);
            PG8_WAIT_L(8); PG8_BAR; PG8_WAIT_L(0); PG8_MMA(0, 0, At, B0); PG8_BAR; PG8_SCHED;
            PG8_LDB(B1, 0, 1); PG8_STAGE(PG8_SB(0, 0), b2, voffB);
            PG8_BAR; PG8_WAIT_L(0); PG8_MMA(0, 1, At, B1); PG8_BAR;
            PG8_LDA(At, 0, 1); PG8_STAGE(PG8_SA(0, 0), a2, voffA);
            PG8_BAR; PG8_WAIT_L(0); PG8_MMA(1, 0, At, B0); PG8_BAR; PG8_SCHED;
            PG8_STAGE(PG8_SB(0, 1), b2 + hstep, voffB);
            PG8_WAIT_V(6); PG8_BAR; PG8_MMA(1, 1, At, B1); PG8_BAR;
            PG8_LDB(B0, 1, 0); PG8_SCHED; PG8_LDA(At, 1, 0); PG8_STAGE(PG8_SA(0, 1), a2 + hstep, voffA);
            PG8_WAIT_L(8); PG8_BAR; PG8_WAIT_L(0); PG8_MMA(0, 0, At, B0); PG8_BAR; PG8_SCHED;
            PG8_LDB(B1, 1, 1); PG8_STAGE(PG8_SB(1, 0), b3, voffB);
            PG8_BAR; PG8_WAIT_L(0); PG8_MMA(0, 1, At, B1); PG8_BAR;
            PG8_LDA(At, 1, 1); PG8_STAGE(PG8_SA(1, 0), a3, voffA);
            PG8_BAR; PG8_WAIT_L(0); PG8_MMA(1, 0, At, B0); PG8_BAR; PG8_SCHED;
            PG8_STAGE(PG8_SB(1, 1), b3 + hstep, voffB);
            PG8_WAIT_V(6); PG8_BAR; PG8_MMA(1, 1, At, B1); PG8_BAR;
            }
        }
        if constexpr (ALIGN_EPI) { if (wr == 0) PG8_BAR; }
        if constexpr (!Epi::AFTER_DRAIN) {
            if constexpr (FP8) { int l2 = lane; asm volatile("" : "+v"(l2)); E(acc, cur, wr, wc, l2 & 15, l2 >> 4); }
            else E(acc, cur, wr, wc, fr, fq);
            S.done(cur); }
        if (!has_next) break;
#pragma unroll
        for (int a = 0; a < 2; ++a)
#pragma unroll
            for (int b = 0; b < 2; ++b)
#pragma unroll
                for (int m = 0; m < 4; ++m)
#pragma unroll
                    for (int n = 0; n < 2; ++n) acc[a][b][m][n] = (f32x4){0.f, 0.f, 0.f, 0.f};
        cur = nxt; cA = nA; cB = nB; ++ui;
        if constexpr (ALIGN_EPI) { if (wr == 1) PG8_BAR; }
    }
    PG8_WAIT_V(0);
    if constexpr (!ALIGN_EPI) { if (wr == 0) PG8_BAR; }
    PG8_BAR;
    if constexpr (Epi::AFTER_DRAIN) { E.fused(acc, cur, wr, wc, fr, fq, lds, wid, lane); S.done(cur); }
#undef PG8_SA
#undef PG8_SB
#undef PG8_STAGE
#undef PG8_LDA
#undef PG8_LDB
#undef PG8_MMA
#undef PG8_WAIT_V
#undef PG8_WAIT_L
#undef PG8_BAR
#undef PG8_SCHED
}
}
#define GAS __attribute__((address_space(1)))
#define LAS __attribute__((address_space(3)))
typedef unsigned short bf16;
typedef unsigned v4u __attribute__((ext_vector_type(4)));
typedef float f32x4 __attribute__((ext_vector_type(4)));
typedef short bf16x8 __attribute__((ext_vector_type(8)));
typedef GAS unsigned gu32;
typedef GAS unsigned long long gu64;
#define RLX_AGENT __ATOMIC_RELAXED, __HIP_MEMORY_SCOPE_AGENT
#define LDS_WAIT() asm volatile("s_waitcnt lgkmcnt(0)" ::: "memory")
#define VM_WAIT() asm volatile("s_waitcnt vmcnt(0)" ::: "memory")
__device__ __forceinline__ unsigned long long rt() { return __builtin_amdgcn_s_memrealtime(); }
__device__ __forceinline__ unsigned f2bf(float f) { unsigned u = __builtin_bit_cast(unsigned, f); return (u + 0x7fffu + ((u >> 16) & 1u)) >> 16; }
__device__ __forceinline__ unsigned pk2(float lo, float hi) { return f2bf(lo) | (f2bf(hi) << 16); }

#define XB_TMO      128
#define XB_XCNT(j)  (256  + 64 * (j))
#define XB_XSUB(j)  (1280 + 64 * (j))
#define XB_XGEN(j)  (2304 + 64 * (j))
#define XB_TOP      3328
#define XB_TOPGEN   3392
#define XCD_BAR_WORDS 3456
#define XB_SPIN_CAP (1u << 18)

__device__ __forceinline__ unsigned xb_ld(unsigned* p)              { return __hip_atomic_load(p, __ATOMIC_RELAXED, __HIP_MEMORY_SCOPE_AGENT); }
__device__ __forceinline__ unsigned xb_add(unsigned* p, unsigned v) { return __hip_atomic_fetch_add(p, v, __ATOMIC_RELAXED, __HIP_MEMORY_SCOPE_AGENT); }
__device__ __forceinline__ unsigned xb_xcc_id() { return (unsigned)__builtin_amdgcn_s_getreg((3 << 11) | 20) & 0xFu; }
#define XB_SPIN(cond, bar) do { unsigned _sp = 0; while (cond) { __builtin_amdgcn_s_sleep(1); \
    if ((++_sp & 255u) == 0u) { if (xb_ld(&(bar)[XB_TMO])) break; if (_sp > XB_SPIN_CAP) { atomicAdd(&(bar)[XB_TMO], 1u); break; } } } } while (0)

struct XcdBarrier {
    unsigned* bar; unsigned x;
    volatile LAS unsigned* st;
};

__device__ __forceinline__ XcdBarrier xcd_barrier_post(unsigned* bar, volatile LAS unsigned* st, const bool xb_t0  ) {
    XcdBarrier b; b.bar = bar; b.x = xb_xcc_id(); b.st = st;
    if (xb_t0) (void)xb_add(&bar[XB_XCNT(b.x)], 1u);
    return b;
}
__device__ __forceinline__ void xcd_barrier_complete(unsigned* bar, unsigned x, unsigned& nloc, unsigned& nx) {
    const unsigned G = gridDim.x * gridDim.y * gridDim.z;
    unsigned sum, cnt, mine, sp = 0u;
    for (;;) {
        sum = 0u; cnt = 0u; mine = 0u;
#pragma unroll
        for (unsigned j = 0; j < 16; ++j) { const unsigned c = xb_ld(&bar[XB_XCNT(j)]); sum += c; cnt += (c > 0u) ? 1u : 0u; mine = (j == x) ? c : mine; }
        if (sum == G) break;
        __builtin_amdgcn_s_sleep(1);
        if ((++sp & 255u) == 0u) { if (xb_ld(&bar[XB_TMO])) break; if (sp > XB_SPIN_CAP) { atomicAdd(&bar[XB_TMO], 1u); break; } }
    }
    nloc = mine > 0u ? mine : 1u; nx = cnt > 0u ? cnt : 1u;
}

__device__ __forceinline__ void xcd_barrier(const XcdBarrier& b, const bool xb_t0) {
    asm volatile("s_waitcnt vmcnt(0)" ::: "memory");
    __syncthreads();
    if (xb_t0) {
        unsigned* bar = b.bar;
        __builtin_amdgcn_s_waitcnt(0);
        unsigned nloc = b.st[0], nx = b.st[1];
        if (nloc == 0u) { xcd_barrier_complete(bar, b.x, nloc, nx); b.st[0] = nloc; b.st[1] = nx; }
        const unsigned old = xb_add(&bar[XB_XSUB(b.x)], 1u);
        const unsigned gen = old / nloc;
        if (old + 1u == (gen + 1u) * nloc) {
            __builtin_amdgcn_fence(__ATOMIC_RELEASE, "agent");
            asm volatile("s_waitcnt vmcnt(0)" ::: "memory");
            const unsigned og = xb_add(&bar[XB_TOP], 1u);
            const unsigned tg = og / nx;
            if (og + 1u == (tg + 1u) * nx) xb_add(&bar[XB_TOPGEN], 1u);
            else XB_SPIN(xb_ld(&bar[XB_TOPGEN]) == tg, bar);
            __builtin_amdgcn_fence(__ATOMIC_ACQUIRE, "agent");
            xb_add(&bar[XB_XGEN(b.x)], 1u);
            asm volatile("s_waitcnt vmcnt(0)" ::: "memory");
        } else {
            XB_SPIN(xb_ld(&bar[XB_XGEN(b.x)]) == gen, bar);
            __builtin_amdgcn_fence(__ATOMIC_ACQUIRE, "agent");
            asm volatile("s_waitcnt vmcnt(0)" ::: "memory");
        }
    }
    __syncthreads();
}
namespace fox {
constexpr int D = 128;
constexpr float SCALE = 0.08838834764831845f, LOG2E = 1.4426950408889634f;
constexpr float THR = 8.f;
constexpr int NW = 8, QBLK = 32, KVBLK = 64, QB = NW * QBLK;
constexpr int SHM_V = KVBLK * D * 2, SHM_K = KVBLK * D * 2;
constexpr int CB_OFF = 2 * SHM_V + 2 * SHM_K, WS_OFF = CB_OFF + 512;
constexpr int LDS_BYTES = WS_OFF + NW * 64 * 4;
constexpr unsigned WINF = 0x7fffffffu;
constexpr int LDO = 2048;

typedef unsigned short bf16;
typedef short bf16x8 __attribute__((ext_vector_type(8)));
typedef short s16x4 __attribute__((ext_vector_type(4)));
typedef float f32x16 __attribute__((ext_vector_type(16)));
typedef float f32x4 __attribute__((ext_vector_type(4)));
typedef unsigned u32x4 __attribute__((ext_vector_type(4)));
typedef unsigned u32x2 __attribute__((ext_vector_type(2)));

#define KSWZ(row, colB) ((row) * 256 + ((colB) ^ (((row) & 7) << 4)))
#define SBAR() __builtin_amdgcn_sched_barrier(0)
__device__ __forceinline__ int v_st(int k, int c) { const int kk = (k & ~0xC) | ((k & 4) << 1) | ((k & 8) >> 1); return ((kk >> 3) * 4 + (c >> 5)) * 512 + ((kk & 7) * 32 + (c & 31)) * 2; }
__device__ __forceinline__ int v_rd_base(int lane) { return ((lane & 3) << 3) | (((lane >> 2) & 3) << 6) | (((lane >> 4) & 1) << 5) | (((lane >> 5) & 1) << 8); }
constexpr int v_rd_off(int d0, int ks, int half) { return d0 * 512 + ks * 4096 + half * 2048; }
__device__ __forceinline__ int crow(int r, int hi) { return (r & 3) + 8 * (r >> 2) + 4 * hi; }
__device__ __forceinline__ unsigned cvtpk(float lo, float hi) { unsigned r; asm volatile("v_cvt_pk_bf16_f32 %0, %1, %2" : "=v"(r) : "v"(lo), "v"(hi)); return r; }
__device__ __forceinline__ bf16x8 load8(const bf16* p) { return *reinterpret_cast<const bf16x8*>(p); }
__device__ __forceinline__ void mask_tile(f32x16& p0, f32x16& p1, int dq, unsigned W) {
    const float NEG = -__builtin_inff();
#pragma unroll
    for (int r = 0; r < 16; ++r) {
        const int c = (r & 3) + 8 * (r >> 2);
        if ((unsigned)(dq - c) >= W) p0[r] = NEG;
        if ((unsigned)(dq - c - 32) >= W) p1[r] = NEG;
    }
}
__device__ __forceinline__ void partialSM(f32x16& p0, f32x16& p1, float& m_reg, float& mn, float& alpha) {
    float pmax = p0[0]; for (int r = 1; r < 16; ++r) pmax = fmaxf(pmax, p0[r]); for (int r = 0; r < 16; ++r) pmax = fmaxf(pmax, p1[r]);
    { auto rr = __builtin_amdgcn_permlane32_swap(__float_as_uint(pmax), __float_as_uint(pmax), false, false);
      pmax = fmaxf(__uint_as_float(rr[0]), __uint_as_float(rr[1])); }
    constexpr float C2 = LOG2E * SCALE;
    if (__builtin_expect(__all((pmax - m_reg) * SCALE <= THR), 1)) { mn = m_reg; alpha = 1.f; }
    else { mn = fmaxf(m_reg, pmax); alpha = __builtin_amdgcn_exp2f((m_reg - mn) * C2); m_reg = mn; }
    const float mnL = -mn * C2;
    for (int r = 0; r < 16; ++r) p0[r] = fmaf(p0[r], C2, mnL); for (int r = 0; r < 16; ++r) p1[r] = fmaf(p1[r], C2, mnL);
    for (int r = 0; r < 16; ++r) p0[r] = __builtin_amdgcn_exp2f(p0[r]);
}
__device__ __forceinline__ void finishSM(f32x16& p0, f32x16& p1, float alpha, float& l_reg, bf16x8& pa0, bf16x8& pa1, bf16x8& pa2, bf16x8& pa3) {
    for (int r = 0; r < 16; ++r) p1[r] = __builtin_amdgcn_exp2f(p1[r]);
    float ps = 0; for (int r = 0; r < 16; ++r) ps += p0[r]; for (int r = 0; r < 16; ++r) ps += p1[r];
    { auto rr = __builtin_amdgcn_permlane32_swap(__float_as_uint(ps), __float_as_uint(ps), false, false);
      ps = __uint_as_float(rr[0]) + __uint_as_float(rr[1]); }
    l_reg = l_reg * alpha + ps;
#define PK4(P, B_, OUT) do { unsigned a0 = cvtpk(P[B_+0], P[B_+1]), a1 = cvtpk(P[B_+2], P[B_+3]);                          \
        unsigned b0 = cvtpk(P[B_+4], P[B_+5]), b1 = cvtpk(P[B_+6], P[B_+7]);                                             \
        auto r0 = __builtin_amdgcn_permlane32_swap(a0, b0, false, false); auto r1 = __builtin_amdgcn_permlane32_swap(a1, b1, false, false); \
        u32x4 w = {r0[0], r1[0], r0[1], r1[1]}; OUT = *reinterpret_cast<bf16x8*>(&w); } while (0)
    PK4(p0, 0, pa0); PK4(p0, 8, pa1); PK4(p1, 0, pa2); PK4(p1, 8, pa3);
#undef PK4
}
template <int KB>
__device__ __forceinline__ void qkt(f32x16& p0, f32x16& p1, const char* K_lds, const float* cb, int r32, int hi, const bf16x8* qr) {
#pragma unroll
    for (int g = 0; g < 4; ++g) { const f32x4 b0 = *(const f32x4*)(cb + 8 * g + 4 * hi), b1 = *(const f32x4*)(cb + 32 + 8 * g + 4 * hi);
#pragma unroll
        for (int j = 0; j < 4; ++j) { p0[4 * g + j] = b0[j]; p1[4 * g + j] = b1[j]; } }
    const char* kb[4];
#pragma unroll
    for (int dd = 0; dd < 4; ++dd) kb[dd] = K_lds + KB * SHM_K + KSWZ(r32, (dd * 16 + hi * 8) * 2);
#pragma unroll
    for (int d0 = 0; d0 < 8; ++d0) { const char* a = kb[d0 & 3] + (d0 >> 2) * 128;
        bf16x8 b0 = *reinterpret_cast<const bf16x8*>(a);
        bf16x8 b1 = *reinterpret_cast<const bf16x8*>(a + 32 * 256);
        p0 = __builtin_amdgcn_mfma_f32_32x32x16_bf16(b0, qr[d0], p0, 0, 0, 0);
        p1 = __builtin_amdgcn_mfma_f32_32x32x16_bf16(b1, qr[d0], p1, 0, 0, 0); }
}
template <int VB>
__device__ __forceinline__ void pv_tile(f32x16* o, int vb0, bf16x8 pa0, bf16x8 pa1, bf16x8 pa2, bf16x8 pa3) {
#define TRRD(dst, off) asm volatile("ds_read_b64_tr_b16 %0, %1 offset:%2" : "=&v"(dst) : "v"(vb0), "i"(off) : "memory")
#define PV_D0(d0) do { s16x4 l0, l1, l2, l3, h0, h1, h2, h3; constexpr int b_ = VB * SHM_V + v_rd_off(d0, 0, 0);     \
        TRRD(l0, b_); TRRD(h0, b_ + 2048); TRRD(l1, b_ + 4096); TRRD(h1, b_ + 6144); TRRD(l2, b_ + 8192); TRRD(h2, b_ + 10240); TRRD(l3, b_ + 12288); TRRD(h3, b_ + 14336); \
        asm volatile("s_waitcnt lgkmcnt(0)" ::: "memory"); SBAR();             \
        o[d0] = __builtin_amdgcn_mfma_f32_32x32x16_bf16((bf16x8){l0[0], l0[1], l0[2], l0[3], h0[0], h0[1], h0[2], h0[3]}, pa0, o[d0], 0, 0, 0);   \
        o[d0] = __builtin_amdgcn_mfma_f32_32x32x16_bf16((bf16x8){l1[0], l1[1], l1[2], l1[3], h1[0], h1[1], h1[2], h1[3]}, pa1, o[d0], 0, 0, 0);   \
        o[d0] = __builtin_amdgcn_mfma_f32_32x32x16_bf16((bf16x8){l2[0], l2[1], l2[2], l2[3], h2[0], h2[1], h2[2], h2[3]}, pa2, o[d0], 0, 0, 0);   \
        o[d0] = __builtin_amdgcn_mfma_f32_32x32x16_bf16((bf16x8){l3[0], l3[1], l3[2], l3[3], h3[0], h3[1], h3[2], h3[3]}, pa3, o[d0], 0, 0, 0); } while (0)
    PV_D0(0); PV_D0(1); PV_D0(2); PV_D0(3);
#undef PV_D0
#undef TRRD
}

struct BlockRef { const bf16* Q; const bf16* K; const bf16* V; bf16* O; const float* C; float cref; int P0, jlo, ldo; };
struct Seam { bf16x8 qr[8]; bf16x8 st_v0, st_v1, st_k0, st_k1; float st_c; };
#define ROW(p, k0, rr) ((const bf16*)((const char*)(p) + (unsigned)((((k0) + (rr)) * D + sc) * 2)))
#define VMW() asm volatile("s_waitcnt vmcnt(0)" ::: "memory")
#define VMWN(n) asm volatile("s_waitcnt vmcnt(%0)" :: "i"(n) : "memory")
#define SLOAD_H(Kp, Vp, Cp, k0) do { S.st_v0 = load8(ROW(Vp, k0, sr)); S.st_v1 = load8(ROW(Vp, k0, 32 + sr));              \
                         S.st_k0 = load8(ROW(Kp, k0, sr)); S.st_k1 = load8(ROW(Kp, k0, 32 + sr));                          \
                         if (tid < 64) S.st_c = *(const float*)((const char*)(Cp) + (unsigned)(((k0) + tid) * 4)); } while (0)
#define SWRITE_HK(bf, cref_) do { *(bf16x8*)(K_lds + (bf) * SHM_K + kws) = S.st_k0; *(bf16x8*)(K_lds + (bf) * SHM_K + kws + 32 * 256) = S.st_k1; \
                         if (tid < 64) *(float*)(C_lds + (bf) * 256 + tid * 4) = ((cref_) - S.st_c) * (1.0f / SCALE); } while (0)
#define SWRITE_HV(bf) do { *(bf16x8*)(V_lds + (bf) * SHM_V + vst0) = S.st_v0; *(bf16x8*)(V_lds + (bf) * SHM_V + vst1) = S.st_v1; } while (0)
#define SWRITE_H(bf, cref_) do { SWRITE_HV(bf); SWRITE_HK(bf, cref_); } while (0)
__device__ __forceinline__ void fox_prime(const BlockRef& cur, char* lds, Seam& S, const int tid) {
    const int wid = __builtin_amdgcn_readfirstlane(tid >> 6), lane = tid & 63, r32 = lane & 31, hi = lane >> 5;
    const int sr = tid >> 4, sc = (tid & 15) * 8, kws = KSWZ(sr, sc * 2); char* K_lds = lds + 2 * SHM_V; char* C_lds = lds + CB_OFF;
    const int kb0 = cur.jlo * KVBLK;
    for (int d0 = 0; d0 < 8; ++d0) S.qr[d0] = load8((const bf16*)((const char*)cur.Q + (unsigned)(((wid * QBLK + r32) * D + d0 * 16 + hi * 8) * 2)));
    SLOAD_H(cur.K, cur.V, cur.C, kb0); VMW(); SWRITE_HK(0, cur.cref);
    __syncthreads();
}
__device__ __forceinline__ void fox_block(const BlockRef& cur, const BlockRef& nxt, int skv, char* lds, Seam& S, const int tid) {
    const int wid = __builtin_amdgcn_readfirstlane(tid >> 6), lane = tid & 63, r32 = lane & 31, hi = lane >> 5;
    const int j_lo = cur.jlo;
    int j_hi = (cur.P0 + QB - 1) / KVBLK + 1; if (j_hi > skv / KVBLK) j_hi = skv / KVBLK;
    const int NT = j_hi - j_lo;
    const int kbn = nxt.jlo * KVBLK;
    const int qlo = cur.P0 + wid * QBLK, qm = qlo + r32 - 4 * hi;
    char* V_lds = lds; char* K_lds = lds + 2 * SHM_V; char* C_lds = lds + CB_OFF;
    float m_reg = -1e30f, l_reg = 0; f32x16 o[4] = {};
    const int sr = tid >> 4, sc = (tid & 15) * 8, vst0 = v_st(sr, sc), vst1 = v_st(32 + sr, sc), kws = KSWZ(sr, sc * 2);
    const int vb0 = (int)(uintptr_t)V_lds + v_rd_base(lane);
    const bf16* Kh = cur.K; const bf16* Vh = cur.V; const float* Ch = cur.C; const float cref = cur.cref;
#define CBT(bf) ((const float*)(C_lds + (bf) * 256))
#define RESC(a) do { if (__any((a) < 1.f)) { for (int d_ = 0; d_ < 4; ++d_) for (int r = 0; r < 16; ++r) o[d_][r] *= (a); } } while (0)
#define KBASE(t) ((j_lo + (t)) * KVBLK)
#define MASKT(P0_, P1_, t) do { const int kb_ = KBASE(t); if (kb_ + KVBLK - 1 > qlo) mask_tile(P0_, P1_, qm - kb_, WINF); } while (0)
    constexpr int NQL = 8;
#define SEAM_K0() do { VMWN(NQL); SWRITE_HK(0, nxt.cref); SBAR(); } while (0)
    f32x16 pA0, pA1, pB0, pB1; float mnA, mnB, alA, alB; bf16x8 pa0, pa1, pa2, pa3;
    SWRITE_HV(0); SBAR();
    if (NT > 1) { SLOAD_H(Kh, Vh, Ch, KBASE(1)); }
    SBAR(); qkt<0>(pA0, pA1, K_lds, CBT(0), r32, hi, S.qr);
    MASKT(pA0, pA1, 0); partialSM(pA0, pA1, m_reg, mnA, alA);
    if (NT > 1) { VMW(); SWRITE_H(1, cref); }
    __syncthreads();
#define HALF_STEP(PX0, PX1, mnX, alX, PY0, PY1, alY, t, KB, VB, SB) do {                                                      \
        SBAR(); qkt<KB>(PX0, PX1, K_lds, CBT(KB), r32, hi, S.qr);                                                                     \
        finishSM(PY0, PY1, alY, l_reg, pa0, pa1, pa2, pa3); SBAR();                                                           \
        if ((t) + 1 < NT) { SLOAD_H(Kh, Vh, Ch, KBASE((t) + 1)); SBAR(); }                                                    \
        pv_tile<VB>(o, vb0, pa0, pa1, pa2, pa3); MASKT(PX0, PX1, (t)); partialSM(PX0, PX1, m_reg, mnX, alX);    \
        __syncthreads();                                                                                                      \
        if ((t) + 1 < NT) { VMW(); SWRITE_H(SB, cref); }                                                                      \
        RESC(alX); __syncthreads(); } while (0)
    for (int t = 1; t + 1 < NT; t += 2) {
        HALF_STEP(pB0, pB1, mnB, alB, pA0, pA1, alA, t, 1, 0, 0);
        HALF_STEP(pA0, pA1, mnA, alA, pB0, pB1, alB, t + 1, 0, 1, 1);
    }
    const bool even = (NT & 1) == 0;
    if (even) { SBAR(); qkt<1>(pB0, pB1, K_lds, CBT(1), r32, hi, S.qr); SBAR(); }
    SLOAD_H(nxt.K, nxt.V, nxt.C, kbn); SBAR();
#pragma unroll
    for (int d0 = 0; d0 < 8; ++d0) S.qr[d0] = load8((const bf16*)((const char*)nxt.Q + (unsigned)(((wid * QBLK + r32) * D + d0 * 16 + hi * 8) * 2)));
    SBAR();
    finishSM(pA0, pA1, alA, l_reg, pa0, pa1, pa2, pa3); SBAR();
    pv_tile<0>(o, vb0, pa0, pa1, pa2, pa3);
    if (even) { MASKT(pB0, pB1, NT - 1); partialSM(pB0, pB1, m_reg, mnB, alB); __syncthreads(); RESC(alB);
        finishSM(pB0, pB1, alB, l_reg, pa0, pa1, pa2, pa3); SBAR(); pv_tile<1>(o, vb0, pa0, pa1, pa2, pa3); }
    SBAR(); SEAM_K0();
    const float rl = __builtin_amdgcn_rcpf(l_reg) * pg8::MIX_SCALE;
    unsigned ob = (unsigned)((wid * QBLK + r32) * LDO + 4 * hi);
    asm volatile("" : "+v"(ob));
#pragma unroll
    for (int d0 = 0; d0 < 4; ++d0)
#pragma unroll
        for (int g4 = 0; g4 < 4; ++g4) { int w8 = __builtin_amdgcn_cvt_pk_fp8_f32(o[d0][4 * g4] * rl, o[d0][4 * g4 + 1] * rl, 0, false); w8 = __builtin_amdgcn_cvt_pk_fp8_f32(o[d0][4 * g4 + 2] * rl, o[d0][4 * g4 + 3] * rl, w8, true);
            *(unsigned*)((char*)cur.O + (ob + (unsigned)(d0 * 32 + 8 * g4))) = (unsigned)w8; }
    __syncthreads();
#undef CBT
#undef RESC
#undef KBASE
#undef MASKT
#undef SEAM_K0
#undef HALF_STEP
}
#undef ROW
#undef VMW
#undef VMWN
#undef SLOAD_H
#undef SWRITE_HK
#undef SWRITE_HV
#undef SWRITE_H
#undef KSWZ
#undef SBAR
}
namespace dsa {
constexpr int L = 16384, NQ = 32, CAP = 640, KSEL = 256, EPL = CAP / 64  ;
#ifndef PROBE2X
#define PROBE2X 0
#endif
constexpr int ATT_REPS = ((PROBE2X >> 10) & 1) + 1, IDX_REPS = ((PROBE2X >> 11) & 1) + 1, CMP_REPS = ((PROBE2X >> 12) & 1) + 1, DMA_REPS = ((PROBE2X >> 15) & 1) + 1, CPT_REPS = ((PROBE2X >> 13) & 1) + 1;
constexpr float LOG2E = 1.4426950408889634f, SCALE = 0.08838834764831845f;
constexpr int CE_OFF = 0;
constexpr int KS_OFF = CE_OFF + NQ * CAP * 4, KS_BUF = 128 * 128, KS_NBUF = 3;
static_assert(KS_OFF + KS_NBUF * KS_BUF <= 131072, "indexer scratch inside the 128 KiB overlay");
constexpr int SEL_OFF = 131072;
constexpr int NV_OFF = SEL_OFF + 16384;
constexpr int TB_OFF = NV_OFF + 128;
constexpr int LUT_OFF = TB_OFF + 1024;
constexpr int HI_OFF = LUT_OFF + 128;
constexpr int FLG_OFF = HI_OFF + 8192;
constexpr int END_OFF = FLG_OFF + 16;
static_assert(SEL_OFF >= 131072 && END_OFF <= 161024, "DSA LDS map");

typedef short bf16x8 __attribute__((ext_vector_type(8)));
typedef short s16x4 __attribute__((ext_vector_type(4)));
typedef float f32x16 __attribute__((ext_vector_type(16)));
typedef float f32x4 __attribute__((ext_vector_type(4)));
typedef unsigned u32x4 __attribute__((ext_vector_type(4)));
typedef unsigned u32x2 __attribute__((ext_vector_type(2)));

typedef __bf16 bf2_t __attribute__((ext_vector_type(2)));
typedef float f2_t __attribute__((ext_vector_type(2)));
typedef short s2_t __attribute__((ext_vector_type(2)));
__device__ __forceinline__ unsigned pkrelu(float a, float b) { const f2_t v = {a, b}; const s2_t z = {0, 0}; return __builtin_bit_cast(unsigned, __builtin_elementwise_max(__builtin_bit_cast(s2_t, __builtin_convertvector(v, bf2_t)), z)); }
__device__ __forceinline__ unsigned pkbf(float a, float b) { const f2_t v = {a, b}; return __builtin_bit_cast(unsigned, __builtin_convertvector(v, bf2_t)); }
__device__ __forceinline__ unsigned bf_rne(float f) { const unsigned u = __float_as_uint(f); return (u + 0x7fffu + ((u >> 16) & 1u)) >> 16; }
__device__ __forceinline__ unsigned clamp_bf2(unsigned w) { const float lo = fminf(fmaxf(__uint_as_float(w << 16), -448.0f), 448.0f), hh = fminf(fmaxf(__uint_as_float(w & 0xffff0000u), -448.0f), 448.0f); return (__float_as_uint(lo) >> 16) | (__float_as_uint(hh) & 0xffff0000u); }
__device__ __forceinline__ unsigned pk4f8(f32x4 v) { int w = __builtin_amdgcn_cvt_pk_fp8_f32(__builtin_amdgcn_fmed3f(v[0], -448.0f, 448.0f), __builtin_amdgcn_fmed3f(v[1], -448.0f, 448.0f), 0, false);
    return (unsigned)__builtin_amdgcn_cvt_pk_fp8_f32(__builtin_amdgcn_fmed3f(v[2], -448.0f, 448.0f), __builtin_amdgcn_fmed3f(v[3], -448.0f, 448.0f), w, true); }
__device__ __forceinline__ float swz16(float v) { return __int_as_float(__builtin_amdgcn_ds_swizzle(__float_as_int(v), 0x401F)); }
struct Tensors { const bf16* aiq; const float* small; const bf16* kidx; const unsigned char* ckv8; const unsigned char* qlat8; bf16* olat; };

__device__ __forceinline__ unsigned ord_key(float f) { const unsigned u = __float_as_uint(f); return (u & 0x80000000u) ? ~u : (u | 0x80000000u); }
__device__ __forceinline__ float unord_key(unsigned k) { return __uint_as_float((k & 0x80000000u) ? (k & 0x7fffffffu) : ~k); }
__device__ __forceinline__ unsigned lanemask_lt_pop(unsigned long long m, int lane) { return (unsigned)__popcll(m & ((1ull << lane) - 1ull)); }

template <int CTRL, int RM> __device__ __forceinline__ unsigned dppu(unsigned v, unsigned idn) { return (unsigned)__builtin_amdgcn_update_dpp((int)idn, (int)v, CTRL, RM, 0xf, false); }
__device__ __forceinline__ unsigned wave_incl_scan_add(unsigned v) {
    v += dppu<0x111, 0xf>(v, 0u); v += dppu<0x112, 0xf>(v, 0u); v += dppu<0x114, 0xf>(v, 0u); v += dppu<0x118, 0xf>(v, 0u);
    v += dppu<0x142, 0xa>(v, 0u); v += dppu<0x143, 0xc>(v, 0u); return v; }
__device__ __forceinline__ unsigned wave_min_u32(unsigned v) {
    v = min(v, dppu<0x111, 0xf>(v, 0xffffffffu)); v = min(v, dppu<0x112, 0xf>(v, 0xffffffffu)); v = min(v, dppu<0x114, 0xf>(v, 0xffffffffu)); v = min(v, dppu<0x118, 0xf>(v, 0xffffffffu));
    v = min(v, dppu<0x142, 0xa>(v, 0xffffffffu)); v = min(v, dppu<0x143, 0xc>(v, 0xffffffffu)); return (unsigned)__builtin_amdgcn_readlane((int)v, 63); }
__device__ __forceinline__ unsigned wave_max_u32(unsigned v) {
    v = max(v, dppu<0x111, 0xf>(v, 0u)); v = max(v, dppu<0x112, 0xf>(v, 0u)); v = max(v, dppu<0x114, 0xf>(v, 0u)); v = max(v, dppu<0x118, 0xf>(v, 0u));
    v = max(v, dppu<0x142, 0xa>(v, 0u)); v = max(v, dppu<0x143, 0xc>(v, 0u)); return (unsigned)__builtin_amdgcn_readlane((int)v, 63); }
__device__ __forceinline__ void hist_add(unsigned hist_addr, unsigned bin) { asm volatile("ds_add_u32 %0, %1" :: "v"(hist_addr + bin * 4u), "v"(1u) : "memory"); }
__device__ __forceinline__ unsigned hist_find(LAS unsigned* hist, unsigned need, int lane, unsigned& nib) {
    asm volatile("s_waitcnt lgkmcnt(0)" ::: "memory");
    const u32x4 c = *(LAS u32x4*)(hist + 4 * (63 - lane));
    const unsigned s = c.x + c.y + c.z + c.w, incl = wave_incl_scan_add(s), excl = incl - s;
    const bool found = (excl < need) && (need <= incl);
    const unsigned long long fm = __ballot(found);
    const int fl = (int)__builtin_ctzll(fm | 0x8000000000000000ull);
    unsigned a = excl; int bin; unsigned nn;
    if (a + c.w >= need) { bin = 3; nn = need - a; } else { a += c.w;
        if (a + c.z >= need) { bin = 2; nn = need - a; } else { a += c.z;
            if (a + c.y >= need) { bin = 1; nn = need - a; } else { a += c.y; bin = 0; nn = need - a; } } }
    bin += 4 * (63 - lane);
    nib = (unsigned)__builtin_amdgcn_readlane((int)nn, fl);
    return (unsigned)__builtin_amdgcn_readlane(bin, fl);
}
#define DSA_LOAD_LIST() unsigned key[EPL];                                                                                      \
    _Pragma("unroll") for (int i = 0; i < EPL; ++i) { const int e = lane + 64 * i; key[i] = 0u; if (e < n) key[i] = ce[e]; }
__device__ __forceinline__ float compact_exact(LAS unsigned* ce, LAS unsigned* hist, int n, int lane) {
    DSA_LOAD_LIST();
    const unsigned haddr = (unsigned)(size_t)hist;
    unsigned prefix = 0u, pmask = 0u; unsigned need = KSEL;
#pragma unroll 1
    for (int pass = 0; pass < 4; ++pass) {
        const int sh = 24 - 8 * pass;
        *(LAS u32x4*)(hist + 4 * lane) = (u32x4){0u, 0u, 0u, 0u};
        asm volatile("s_waitcnt lgkmcnt(0)" ::: "memory");
#pragma unroll
        for (int i = 0; i < EPL; ++i) if (key[i] != 0u && (key[i] & pmask) == prefix) hist_add(haddr, (key[i] >> sh) & 255u);
        unsigned nib; const unsigned binu = hist_find(hist, need, lane, nib); need = nib;
        prefix |= binu << sh; pmask |= 0xffu << sh;
    }
    int base = 0; unsigned eqseen = 0u;
#pragma unroll
    for (int i = 0; i < EPL; ++i) {
        const bool gt = key[i] > prefix, eq = key[i] == prefix;
        const unsigned long long meq = __ballot(eq);
        const bool keep = gt || (eq && (eqseen + lanemask_lt_pop(meq, lane)) < need);
        eqseen += (unsigned)__popcll(meq);
        const unsigned long long mk = __ballot(keep);
        const int pos = base + (int)lanemask_lt_pop(mk, lane);
        if (keep) ce[pos] = key[i];
        base += (int)__popcll(mk);
    }
    asm volatile("s_waitcnt lgkmcnt(0)" ::: "memory");
    return unord_key((prefix & 0xffffc000u) - 1u);
}
__device__ __forceinline__ float compact_approx(LAS unsigned* ce, LAS unsigned* hist, int n, int lane, int& n_out) {
    DSA_LOAD_LIST();
    const unsigned haddr = (unsigned)(size_t)hist;
    unsigned kmn = 0xffffffffu, kmx = 0u;
#pragma unroll
    for (int i = 0; i < EPL; ++i) if (key[i] != 0u) { kmn = min(kmn, key[i]); kmx = max(kmx, key[i]); }
    kmn = wave_min_u32(kmn); kmx = wave_max_u32(kmx);
    const int lz = __builtin_clz((kmx - kmn) | 1u), sh = lz < 24 ? 24 - lz : 0;
    *(LAS u32x4*)(hist + 4 * lane) = (u32x4){0u, 0u, 0u, 0u};
    asm volatile("s_waitcnt lgkmcnt(0)" ::: "memory");
#pragma unroll
    for (int i = 0; i < EPL; ++i) if (key[i] != 0u) hist_add(haddr, (key[i] - kmn) >> sh);
    unsigned nib; const unsigned b = hist_find(hist, KSEL, lane, nib);
    const unsigned tkey = kmn + (b << sh);
    int base = 0;
#pragma unroll
    for (int i = 0; i < EPL; ++i) {
        const bool keep = key[i] != 0u && key[i] >= tkey;
        const unsigned long long mk = __ballot(keep);
        const int pos = base + (int)lanemask_lt_pop(mk, lane);
        if (keep) ce[pos] = key[i];
        base += (int)__popcll(mk);
    }
    asm volatile("s_waitcnt lgkmcnt(0)" ::: "memory");
    n_out = base;
    return unord_key((tkey & 0xffffc000u) - 1u);
}
#undef DSA_LOAD_LIST

__device__ __forceinline__ void init_tables(LAS unsigned char* lds, const float* t5, const int tid) {
    if (tid < 256) ((LAS float*)(lds + TB_OFF))[tid] = t5[tid] * LOG2E;
    if (tid < 128) { int bk = tid; if (tid >= 16) { bk = 16 + (int)floorf(__log2f((float)tid * (1.0f / 16.0f)) * (16.0f / 3.0f)); bk = bk > 31 ? 31 : bk; } ((LAS unsigned char*)(lds + LUT_OFF))[tid] = (unsigned char)bk; }
}

__device__ __forceinline__ void unit(LAS unsigned char* lds, const Tensors& T, int b, int t0, const int tid) {
    const int wid = __builtin_amdgcn_readfirstlane(tid >> 6), lane = tid & 63, r32 = lane & 31, hi = lane >> 5;
    const size_t tokb = (size_t)b * L;
    {
        int tqv[2]; bf16x8 qa[2][4]; bf16x8 wf[2][2];
#pragma unroll
        for (int B = 0; B < 2; ++B) {
            tqv[B] = t0 + 4 * wid + 2 * B + hi;
            const int aq = t0 + 4 * wid + 2 * B + ((r32 >> 2) & 1), ah = (r32 & 3) + 4 * (r32 >> 3);
#pragma unroll
            for (int s = 0; s < 4; ++s) qa[B][s] = *(const bf16x8*)(T.aiq + (tokb + aq) * 1024 + ah * 64 + 16 * s + 8 * hi);
            float w[16];
#pragma unroll
            for (int q4 = 0; q4 < 4; ++q4) { const f32x4 v = *(const f32x4*)(T.small + (tokb + tqv[B]) * 128 + 64 + 4 * q4);
#pragma unroll
                for (int j = 0; j < 4; ++j) w[4 * q4 + j] = v[j] * (0.25f * 0.125f); }
            const bool rh = r32 == 4 * hi, rl = r32 == 4 * hi + 1;
#pragma unroll
            for (int s = 0; s < 2; ++s) { u32x4 pw;
#pragma unroll
                for (int jj = 0; jj < 4; ++jj) { const float a = w[8 * s + 2 * jj], b2 = w[8 * s + 2 * jj + 1]; const unsigned ah2 = bf_rne(a), bh2 = bf_rne(b2);
                    const unsigned al = bf_rne(a - __uint_as_float(ah2 << 16)), bl = bf_rne(b2 - __uint_as_float(bh2 << 16));
                    pw[jj] = rh ? (ah2 | (bh2 << 16)) : (rl ? (al | (bl << 16)) : 0u); }
                wf[B][s] = __builtin_bit_cast(bf16x8, pw); }
        }
        LAS unsigned* ceW = (LAS unsigned*)(lds + CE_OFF) + (4 * wid) * CAP;
        LAS unsigned* ceM0 = ceW + hi * CAP; LAS unsigned* ceM1 = ceW + (2 + hi) * CAP;
        LAS unsigned* hist = (LAS unsigned*)(lds + HI_OFF) + wid * 256;
        int cnt0 = 0, cnt1 = 0, cnt2 = 0, cnt3 = 0; float tau0 = -__builtin_inff(), tau1 = tau0, tau2 = tau0, tau3 = tau0, tauv0 = tau0, tauv1 = tau0;
        const int tmax = t0 + NQ - 1, nch = tmax / 128 + 1;
        const int dk = lane >> 3, dpc = lane & 7, k0l = 16 * wid + dk, k1l = k0l + 8;
        const bf16* src0 = T.kidx + (tokb + k0l) * 64 + ((dpc ^ ((k0l >> 1) & 7)) * 8);
        const bf16* src1 = T.kidx + (tokb + k1l) * 64 + ((dpc ^ ((k1l >> 1) & 7)) * 8);
        LAS unsigned char* ring = lds + KS_OFF;
        LAS unsigned* flg = (LAS unsigned*)(lds + FLG_OFF);
#define DMA_CHUNK(c, slot) do { const int cc_ = (c) < nch ? (c) : nch - 1; LAS unsigned char* d_ = ring + (slot) * KS_BUF + wid * 2048;                  \
            __builtin_amdgcn_global_load_lds((const unsigned*)(src0 + (size_t)cc_ * 8192), (LAS unsigned*)d_, 16, 0, 0);                               \
            __builtin_amdgcn_global_load_lds((const unsigned*)(src1 + (size_t)cc_ * 8192), (LAS unsigned*)(d_ + 1024), 16, 0, 0); } while (0)
        int boff[4];
#pragma unroll
        for (int s = 0; s < 4; ++s) boff[s] = r32 * 128 + (((2 * s + hi) ^ ((r32 >> 1) & 7)) << 4);
#pragma unroll 1
        for (int irep = 0; irep < IDX_REPS; ++irep) {
        if (irep) { __syncthreads(); cnt0 = cnt1 = cnt2 = cnt3 = 0; tau0 = tau1 = tau2 = tau3 = tauv0 = tauv1 = -__builtin_inff(); }
        if (tid < 3) flg[tid] = 0u;
        DMA_CHUNK(0, 0); DMA_CHUNK(1, 1);
#define LOADK(kf, tile) do { _Pragma("unroll") for (int s = 0; s < 4; ++s) kf[s] = *(const LAS bf16x8*)(kbuf + (tile) * 4096 + boff[s]); } while (0)
#define MFMA4(acc, B, kf) do { acc = f32x16{}; _Pragma("unroll") for (int s = 0; s < 4; ++s) acc = __builtin_amdgcn_mfma_f32_32x32x16_bf16(qa[B][s], kf[s], acc, 0, 0, 0); } while (0)
#define MFMA8(accP, accQ, kf) do { MFMA4(accP, 0, kf); MFMA4(accQ, 1, kf); } while (0)
#define SB() __builtin_amdgcn_sched_barrier(0)
#define SCORE1(acc, tile, B, tauv_, ceM_, cA_, cB_) do { u32x4 x0_, x1_;                                                                                    \
            x0_.x = pkrelu(acc[0], acc[1]); x0_.y = pkrelu(acc[2], acc[3]); x0_.z = pkrelu(acc[4], acc[5]); x0_.w = pkrelu(acc[6], acc[7]);               \
            x1_.x = pkrelu(acc[8], acc[9]); x1_.y = pkrelu(acc[10], acc[11]); x1_.z = pkrelu(acc[12], acc[13]); x1_.w = pkrelu(acc[14], acc[15]);         \
            f32x16 y_ = __builtin_amdgcn_mfma_f32_32x32x16_bf16(wf[B][0], __builtin_bit_cast(bf16x8, x0_), f32x16{}, 0, 0, 0);                            \
            y_ = __builtin_amdgcn_mfma_f32_32x32x16_bf16(wf[B][1], __builtin_bit_cast(bf16x8, x1_), y_, 0, 0, 0);                                         \
            const float sc = y_[0] + y_[1]; const int key = kbase + (tile) * 32 + r32;                                                                  \
            const bool pass = (key <= tqv[B]) && (sc > tauv_);                                                                                      \
            const unsigned long long pm = __ballot(pass); const unsigned mlo = (unsigned)pm, mhi = (unsigned)(pm >> 32);                            \
            const int nlo_ = (int)__popc(mlo);                                                                                                      \
            const unsigned pos = __builtin_amdgcn_mbcnt_hi(mhi, __builtin_amdgcn_mbcnt_lo(mlo, (unsigned)(hi ? cB_ - nlo_ : cA_)));                  \
            if (pass) ceM_[pos] = (ord_key(sc) & 0xffffc000u) | (unsigned)key;                                                                       \
            cA_ += nlo_; cB_ += (int)__popc(mhi); } while (0)
#define SCORE2(accP, accQ, tile) do { SCORE1(accP, tile, 0, tauv0, ceM0, cnt0, cnt1); SCORE1(accQ, tile, 1, tauv1, ceM1, cnt2, cnt3); } while (0)
#define COMPACT_ROUND() do { asm volatile("s_waitcnt lgkmcnt(0)" ::: "memory");                                                                      \
            _Pragma("nounroll") for (int q_ = 0; q_ < 4; ++q_) { const int cq_ = q_ == 0 ? cnt0 : (q_ == 1 ? cnt1 : (q_ == 2 ? cnt2 : cnt3)); if (cq_ > KSEL) {   \
                LAS unsigned* ce_ = ceW + q_ * CAP; int nn_; float t_ = compact_approx(ce_, hist, cq_, lane, nn_);   \
                if (nn_ > CAP - 256) { t_ = compact_exact(ce_, hist, nn_, lane); nn_ = KSEL; }       \
                if (q_ == 0) { tau0 = t_; cnt0 = nn_; } else if (q_ == 1) { tau1 = t_; cnt1 = nn_; } else if (q_ == 2) { tau2 = t_; cnt2 = nn_; } else { tau3 = t_; cnt3 = nn_; } } }   \
            tauv0 = hi ? tau1 : tau0; tauv1 = hi ? tau3 : tau2; } while (0)
#define COMPACT_FINAL() do { asm volatile("s_waitcnt lgkmcnt(0)" ::: "memory");                                                                      \
            _Pragma("nounroll") for (int q_ = 0; q_ < 4; ++q_) { const int cq_ = q_ == 0 ? cnt0 : (q_ == 1 ? cnt1 : (q_ == 2 ? cnt2 : cnt3)); if (cq_ > KSEL) {   \
                compact_exact(ceW + q_ * CAP, hist, cq_, lane);                                                    \
                if (q_ == 0) cnt0 = KSEL; else if (q_ == 1) cnt1 = KSEL; else if (q_ == 2) cnt2 = KSEL; else cnt3 = KSEL; } } } while (0)
        constexpr int FLAG_LIM = CAP - 160;
        asm volatile("s_waitcnt vmcnt(2) lgkmcnt(0)" ::: "memory"); __builtin_amdgcn_s_barrier(); asm volatile("" ::: "memory");
        DMA_CHUNK(2, 2);
        f32x16 accA0, accA1, accB0, accB1; bf16x8 k0[4], k1[4];
        { const LAS unsigned char* kbuf = ring; LOADK(k0, 0); LOADK(k1, 1); SB(); MFMA8(accA0, accA1, k0); SB(); LOADK(k0, 2); SB(); MFMA8(accB0, accB1, k1); SB(); LOADK(k1, 3); SB(); }
        int slot = 0;
#pragma unroll 1
        for (int ch = 0; ch < nch; ++ch) {
            const int kbase = ch * 128; const int nslot = slot == KS_NBUF - 1 ? 0 : slot + 1;
            const LAS unsigned char* kbuf = ring + nslot * KS_BUF;
            SCORE2(accA0, accA1, 0); MFMA8(accA0, accA1, k0);
            asm volatile("s_waitcnt vmcnt(2) lgkmcnt(0)" ::: "memory");
            __builtin_amdgcn_s_barrier(); asm volatile("" ::: "memory");
            DMA_CHUNK(ch + 3, slot);
            const unsigned fraw = ch == 0 ? 0u : flg[(ch + 2) % 3];
            if (tid == 0) flg[(ch + 1) % 3] = 0u;
            LOADK(k0, 0); SB();
            if (__builtin_amdgcn_readfirstlane((int)fraw)) COMPACT_ROUND();
            SCORE2(accB0, accB1, 1); MFMA8(accB0, accB1, k1); LOADK(k1, 1);
            SCORE2(accA0, accA1, 2); MFMA8(accA0, accA1, k0); LOADK(k0, 2);
            SCORE2(accB0, accB1, 3); MFMA8(accB0, accB1, k1); LOADK(k1, 3);
            if (cnt0 > FLAG_LIM || cnt1 > FLAG_LIM || cnt2 > FLAG_LIM || cnt3 > FLAG_LIM) { if (lane == 0) flg[ch % 3] = 1u; }
            slot = nslot;
        }
        asm volatile("s_waitcnt vmcnt(0) lgkmcnt(0)" ::: "memory");
        COMPACT_FINAL();
        }
#undef DMA_CHUNK
#undef MFMA4
#undef MFMA8
#undef LOADK
#undef SB
#undef SCORE1
#undef SCORE2
#undef COMPACT_ROUND
#undef COMPACT_FINAL
#pragma unroll
        for (int j = 0; j < 4; ++j) { const int cj = j == 0 ? cnt0 : (j == 1 ? cnt1 : (j == 2 ? cnt2 : cnt3));
            LAS unsigned short* selJ = (LAS unsigned short*)(lds + SEL_OFF) + (4 * wid + j) * KSEL; const LAS unsigned* ceJ = ceW + j * CAP;
#pragma unroll
            for (int i = 0; i < 4; ++i) { const int e = lane + 64 * i; selJ[e] = e < cj ? (unsigned short)(ceJ[e] & 0x3fffu) : (unsigned short)0; }
            if (lane == 0) ((LAS int*)(lds + NV_OFF))[4 * wid + j] = cj; }
    }
    __syncthreads();
    {
        int lane_o = lane; asm volatile("" : "+v"(lane_o));
        LAS unsigned char* cbuf = lds + wid * 16384;
        const unsigned cbase = (unsigned)(size_t)cbuf;
        const int head = lane_o & 15, g = lane_o >> 4;
        const LAS float* tb = (const LAS float*)(lds + TB_OFF); const LAS unsigned char* lut = (const LAS unsigned char*)(lds + LUT_OFF);
        constexpr float C2 = SCALE * LOG2E;
#define GATHER(chunk, bufsel) do { int keys_[8]; _Pragma("unroll") for (int i = 0; i < 8; ++i) keys_[i] = (int)sel[(chunk) * 32 + 4 * i + g];                                  \
            _Pragma("unroll") for (int i = 0; i < 8; ++i) { const int kap = 4 * i + g; const int c = head ^ (kap & 15);                                                          \
            __builtin_amdgcn_global_load_lds((const unsigned*)(T.ckv8 + (tokb + keys_[i]) * 256 + c * 16), (LAS unsigned*)(cbuf + (bufsel) * 8192 + i * 1024), 16, 0, 0); } } while (0)
#pragma unroll 1
        for (int qq = 0; qq < 4 * ATT_REPS; ++qq) { const int qi = qq & 3;
            const int qs = 4 * wid + qi, t = t0 + qs;
            const int nvalid = ((const LAS int*)(lds + NV_OFF))[qs];
            const LAS unsigned short* sel = (const LAS unsigned short*)(lds + SEL_OFF) + qs * KSEL;
            if (qi == 0) GATHER(0, 0);
            long qf[8];
#pragma unroll
            for (int s = 0; s < 8; ++s) { qf[s] = 0; if (head < 8) qf[s] = *(const long*)(T.qlat8 + ((size_t)head * (2 * L) + tokb + t) * 256 + 32 * s + 8 * g); }
            f32x4 o[16];
#pragma unroll
            for (int nb = 0; nb < 16; ++nb) o[nb] = (f32x4){0.f, 0.f, 0.f, 0.f};
            float m_run = -1e30f, l_run = 0.f;
#pragma unroll 1
            for (int ch = 0; ch < 8; ++ch) {
                const int bs = ch & 1;
                float bias8[8];
                { int dist8[8];
#pragma unroll
                  for (int j = 0; j < 8; ++j) dist8[j] = t - (int)sel[ch * 32 + 8 * g + j];
                  int bk8[8];
#pragma unroll
                  for (int j = 0; j < 8; ++j) { const int dc = dist8[j] < 0 ? 0 : (dist8[j] > 127 ? 127 : dist8[j]); bk8[j] = (int)lut[dc]; }
#pragma unroll
                  for (int j = 0; j < 8; ++j) { const int bk = dist8[j] < 128 ? bk8[j] : 31; const float bv = tb[bk * 8 + (head & 7)]; bias8[j] = (ch * 32 + 8 * g + j) < nvalid ? bv : -__builtin_inff(); } }
                if (ch + 1 < 8) { GATHER(ch + 1, bs ^ 1); asm volatile("s_waitcnt vmcnt(8)" ::: "memory"); }
                else if (qi < 3) { const LAS unsigned short* selc = sel; sel = selc + KSEL; GATHER(0, 0); sel = selc; asm volatile("s_waitcnt vmcnt(8)" ::: "memory"); }
                else asm volatile("s_waitcnt vmcnt(0)" ::: "memory");
                const LAS unsigned char* cb = cbuf + bs * 8192;
                f32x4 sa[2];
#pragma unroll
                for (int e = 0; e < 2; ++e) { sa[e] = (f32x4){0.f, 0.f, 0.f, 0.f};
                    const int kap = 8 * ((lane_o & 15) >> 2) + 4 * e + (lane_o & 3); const int x = kap & 15;
                    const LAS unsigned char* rp = cb + kap * 256 + (g & 1) * 8;
#pragma unroll
                    for (int s = 0; s < 8; ++s) { const long a = *(const LAS long*)(rp + (((2 * s + (g >> 1)) ^ x) << 4)); sa[e] = __builtin_amdgcn_mfma_f32_16x16x32_fp8_fp8(a, qf[s], sa[e], 0, 0, 0); } }
                float v[8]; float cmax = -__builtin_inff();
#pragma unroll
                for (int e = 0; e < 2; ++e)
#pragma unroll
                    for (int r = 0; r < 4; ++r) { const float x = fmaf(sa[e][r], C2, bias8[4 * e + r]); v[4 * e + r] = x; cmax = fmaxf(cmax, x); }
                cmax = fmaxf(cmax, swz16(cmax)); { const u32x2 r_ = __builtin_amdgcn_permlane32_swap(__float_as_uint(cmax), __float_as_uint(cmax), false, false); cmax = fmaxf(__uint_as_float(r_[0]), __uint_as_float(r_[1])); }
                const float mn = fmaxf(m_run, cmax), alpha = __builtin_amdgcn_exp2f(m_run - mn); m_run = mn;
                float ps = 0.f;
#pragma unroll
                for (int j = 0; j < 8; ++j) { v[j] = __builtin_amdgcn_exp2f(v[j] - mn); ps += v[j]; }
                ps += swz16(ps); { const u32x2 r_ = __builtin_amdgcn_permlane32_swap(__float_as_uint(ps), __float_as_uint(ps), false, false); ps = __uint_as_float(r_[0]) + __uint_as_float(r_[1]); }
                l_run = l_run * alpha + ps;
#pragma unroll
                for (int nb = 0; nb < 16; ++nb) o[nb] = o[nb] * alpha;
                int plo = __builtin_amdgcn_cvt_pk_fp8_f32(v[0] * 256.0f, v[1] * 256.0f, 0, false); plo = __builtin_amdgcn_cvt_pk_fp8_f32(v[2] * 256.0f, v[3] * 256.0f, plo, true);
                int phi = __builtin_amdgcn_cvt_pk_fp8_f32(v[4] * 256.0f, v[5] * 256.0f, 0, false); phi = __builtin_amdgcn_cvt_pk_fp8_f32(v[6] * 256.0f, v[7] * 256.0f, phi, true);
                const long pf = (long)(((unsigned long long)(unsigned)phi << 32) | (unsigned)plo);
                const int kapv = 8 * g + ((lane_o & 15) >> 1);
                const unsigned av = cbase + bs * 8192 + kapv * 256 + (lane_o & 1) * 8; const unsigned xv = (unsigned)((kapv & 15) << 4);
#pragma unroll
                for (int nh = 0; nh < 2; ++nh) {
                    unsigned long long ar[8];
#pragma unroll
                    for (int i = 0; i < 8; ++i) { const unsigned ad = av + ((unsigned)((8 * nh + i) << 4) ^ xv); asm volatile("ds_read_b64_tr_b8 %0, %1" : "=&v"(ar[i]) : "v"(ad) : "memory"); }
                    asm volatile("s_waitcnt lgkmcnt(0)" ::: "memory"); __builtin_amdgcn_sched_barrier(0);
#pragma unroll
                    for (int i = 0; i < 8; ++i) o[8 * nh + i] = __builtin_amdgcn_mfma_f32_16x16x32_fp8_fp8((long)ar[i], pf, o[8 * nh + i], 0, 0, 0);
                }
            }
            const float rl = 1.0f / (256.0f * l_run);
            if (head < 8) { bf16* op = T.olat + ((size_t)head * (2 * L) + tokb + t) * 256 + 4 * g;
#pragma unroll
                for (int nb = 0; nb < 16; ++nb) { u32x2 w; w.x = pg8::cvt_pk_bf16(o[nb][0] * rl, o[nb][1] * rl); w.y = pg8::cvt_pk_bf16(o[nb][2] * rl, o[nb][3] * rl); *(u32x2*)(op + 16 * nb) = w; } }
        }
#undef GATHER
    }
    __syncthreads();
}
template <int KD, int NBW, bool OUT8 = false>
__device__ __forceinline__ void absorb(const bf16* Wt, const bf16* X, int ldx, bf16* out, int ldo, int tg0, int tg_step, int ntg, int lane, int reps = 1  , float oscale = 1.0f  ) {
    constexpr int KS = KD / 32; const int r16 = lane & 15, g = lane >> 4;
    bf16x8 a[NBW][KS];
#pragma unroll
    for (int nb = 0; nb < NBW; ++nb)
#pragma unroll
        for (int s = 0; s < KS; ++s) a[nb][s] = *(const bf16x8*)(Wt + (size_t)(16 * nb + r16) * KD + 32 * s + 8 * g);
#pragma unroll 1
    for (int tgg = tg0; tgg < ntg * reps; tgg += tg_step) { const int tg = tgg % ntg;
        const size_t tok = (size_t)tg * 16 + r16;
        bf16x8 b[KS];
#pragma unroll
        for (int s = 0; s < KS; ++s) b[s] = *(const bf16x8*)(X + tok * ldx + 32 * s + 8 * g);
#pragma unroll
        for (int nb = 0; nb < NBW; ++nb) { f32x4 acc = (f32x4){0.f, 0.f, 0.f, 0.f};
#pragma unroll
            for (int s = 0; s < KS; ++s) acc = __builtin_amdgcn_mfma_f32_16x16x32_bf16(a[nb][s], b[s], acc, 0, 0, 0);
            if constexpr (OUT8) *(unsigned*)((unsigned char*)out + tok * ldo + 16 * nb + 4 * g) = pk4f8(acc * oscale);
            else { u32x2 w; w.x = pkbf(acc[0], acc[1]); w.y = pkbf(acc[2], acc[3]); *(u32x2*)(out + tok * ldo + 16 * nb + 4 * g) = w; } }
    }
}
template <int KD, int NB, bool OUT8 = false>
__device__ __forceinline__ void absorb_wg(LAS unsigned char* lds, const bf16* Wt, const bf16* X, int ldx, bf16* out, int ldo, int tg_begin, int tg_per_wave, int tid, int reps = 1  , float oscale = 1.0f  ) {
    constexpr int KS = KD / 32, CPR = KD / 8  , ROWB = KD * 2;
    const int wid = __builtin_amdgcn_readfirstlane(tid >> 6), lane = tid & 63, r16 = lane & 15, g = lane >> 4;
#pragma unroll
    for (int i = 0; i < (16 * NB * CPR) / 512; ++i) { const int q = tid + 512 * i, n = q / CPR, c = q % CPR;
        *(LAS u32x4*)(lds + n * ROWB + ((c ^ (n & 15)) << 4)) = *(const u32x4*)(Wt + (size_t)n * KD + c * 8); }
    __syncthreads();
    const unsigned arow0 = (unsigned)(size_t)lds + r16 * ROWB;
    constexpr int NG = (KD <= 128) ? 8 : 4;
#pragma unroll 1
    for (int ii0 = 0; ii0 < tg_per_wave * reps; ii0 += NG) { const int i0 = ii0 % tg_per_wave;
        bf16x8 b[NG][KS];
#pragma unroll
        for (int gi = 0; gi < NG; ++gi) { const size_t tok = (size_t)(tg_begin + wid * tg_per_wave + i0 + gi) * 16 + r16;
#pragma unroll
            for (int s = 0; s < KS; ++s) b[gi][s] = *(const bf16x8*)(X + tok * ldx + 32 * s + 8 * g); }
#pragma unroll
        for (int gi = 0; gi < NG; ++gi) { const size_t tok = (size_t)(tg_begin + wid * tg_per_wave + i0 + gi) * 16 + r16;
            unsigned arow_u = arow0; asm volatile("" : "+v"(arow_u));
            const LAS unsigned char* arow = (const LAS unsigned char*)(size_t)arow_u;
#pragma unroll
            for (int nb = 0; nb < NB; ++nb) { f32x4 acc = (f32x4){0.f, 0.f, 0.f, 0.f};
#pragma unroll
                for (int s = 0; s < KS; ++s) { const bf16x8 a = *(const LAS bf16x8*)(arow + nb * 16 * ROWB + (((4 * s + g) ^ r16) << 4)); acc = __builtin_amdgcn_mfma_f32_16x16x32_bf16(a, b[gi][s], acc, 0, 0, 0); }
                if constexpr (OUT8) *(unsigned*)((unsigned char*)out + tok * ldo + 16 * nb + 4 * g) = pk4f8(acc * oscale);
                else { u32x2 w; w.x = pkbf(acc[0], acc[1]); w.y = pkbf(acc[2], acc[3]); *(u32x2*)(out + tok * ldo + 16 * nb + 4 * g) = w; } }
        }
    }
    __syncthreads();
}
}
constexpr int NWAVES = 8;
#ifndef MK_N_LAUNCHES
#define MK_N_LAUNCHES 1
#endif
constexpr int N_PHASES = 10;
constexpr int N_LAUNCHES = MK_N_LAUNCHES;
static_assert(N_LAUNCHES == 1 || N_LAUNCHES == N_PHASES, "MK_N_LAUNCHES is 1 or 10");

constexpr int BATCH = 2, SEQ = 16384, DM = 2048, M = BATCH * SEQ;
constexpr int N_INB = 1536, N_IN8 = 4096;
constexpr int N_IN = 5632;
constexpr int D_IN_SRC = 5464;
constexpr int K_O = 2048;
constexpr int FF = 5632, FF2 = 11264;
constexpr int NHALO = 1024;
constexpr size_t MiB = 1u << 20;
constexpr size_t WS_CTL = 0, CTL_ZERO_BYTES = 1 * MiB;
constexpr size_t WS_WIN = 2 * MiB, WS_WIN8 = 10 * MiB, WS_WO = 28 * MiB, WS_WUP = 40 * MiB, WS_WDN = 84 * MiB;
constexpr size_t WS_SMALL = 106 * MiB, WS_KIDX = 122 * MiB, WS_CKV = 126 * MiB, WS_CUM = 142 * MiB, WS_AHALO = 143 * MiB, WS_UHALO = 147 * MiB;
constexpr size_t WS_WUKT = 36 * MiB, WS_WUVT = 36 * MiB + 512 * 1024;
constexpr size_t WS_H = 192 * MiB;
constexpr size_t WS_OLAT = WS_H;
constexpr size_t WS_H8 = 320 * MiB;
constexpr size_t WS_MIX = 320 * MiB;
constexpr size_t WS_X2B = 320 * MiB;
constexpr size_t WS_AQ = 448 * MiB;
constexpr size_t WS_QLAT = 512 * MiB, WS_AKV = 640 * MiB, WS_AIQ = 656 * MiB, WS_BQ = 720 * MiB, WS_BK = 784 * MiB, WS_BV = 848 * MiB;
constexpr size_t WS_ACT = 512 * MiB;
constexpr size_t WS_END = 912 * MiB;
static_assert(WS_WIN + (size_t)N_INB * DM * 2 <= WS_WIN8 && WS_WIN8 + (size_t)N_IN8 * DM <= WS_WO && WS_WO + (size_t)DM * K_O * 2 <= WS_WUP && WS_WUP + (size_t)FF2 * DM * 2 <= WS_WDN && WS_WDN + (size_t)DM * FF * 2 <= WS_SMALL, "weights map");
static_assert(WS_BK - WS_BQ == WS_BV - WS_BK, "q/k/v spacing");
static_assert(WS_UHALO + (size_t)NHALO * FF2 * 4 <= WS_H && WS_ACT + (size_t)M * FF * 2 <= WS_END, "ws map");
constexpr int CW_TMO = 0, CW_CODE = 1, CW_QUEUE = 64  , CW_NORMQ = 320, CW_NORMK = 384, CW_QBLK = 512  , CW_DMIN = 1536  , CW_BAR = 4096;
constexpr size_t CTL_SS1 = 65536, CTL_SS2 = 65536 + 131072;
constexpr int RING_OFF = 0, RING_BYTES = 131072;
constexpr int LDSCTL_OFF = 161024, MISC_OFF = LDSCTL_OFF + 320;
constexpr int LDS_BYTES = 163840;
static_assert(dsa::END_OFF <= LDSCTL_OFF && MISC_OFF + 128 <= LDS_BYTES && fox::LDS_BYTES <= RING_BYTES, "LDS map");

__device__ __forceinline__ int fresh_lane() { int l; asm volatile("v_mbcnt_lo_u32_b32 %0, -1, 0\n\tv_mbcnt_hi_u32_b32 %0, -1, %0" : "=v"(l)); return l; }
struct Frame {
    LAS unsigned char* lds; volatile LAS unsigned* MISC; gu32* ctl;
    int tid, lane, wave, vcu, G;
    __device__ __forceinline__ void refresh() { lane = fresh_lane(); tid = wave * 64 + lane; }
};
__device__ __forceinline__ float wave_sum(float v) {
#pragma unroll
    for (int o = 1; o < 64; o <<= 1) v += __shfl_xor(v, o);
    return v;
}
__device__ __forceinline__ void p0_transpose_item(const float* W, int ldw, int c0, bf16* WT, int ldt, int r0, int k0, const float* gk, LAS float* scr, int lane) {
    float v[32];
#pragma unroll
    for (int i = 0; i < 32; ++i) v[i] = W[(size_t)(k0 + 2 * i + (lane >> 5)) * ldw + c0 + (lane & 31)];
    if (gk) {
        float gs[32];
#pragma unroll
        for (int i = 0; i < 32; ++i) gs[i] = gk[k0 + 2 * i + (lane >> 5)];
#pragma unroll
        for (int i = 0; i < 32; ++i) v[i] *= gs[i];
    }
#pragma unroll
    for (int i = 0; i < 32; ++i) scr[(2 * i + (lane >> 5)) * 33 + (lane & 31)] = v[i];
    LDS_WAIT(); asm volatile("" ::: "memory");
    const int c = lane & 7;
#pragma unroll
    for (int j = 0; j < 4; ++j) { const int n = (lane >> 3) + 8 * j; const LAS float* s = scr + (8 * c) * 33 + n;
        v4u o; o.x = pk2(s[0 * 33], s[1 * 33]); o.y = pk2(s[2 * 33], s[3 * 33]); o.z = pk2(s[4 * 33], s[5 * 33]); o.w = pk2(s[6 * 33], s[7 * 33]);
        *(GAS v4u*)(WT + (size_t)(r0 + n) * ldt + k0 + 8 * c) = o; }
    LDS_WAIT(); asm volatile("" ::: "memory");
}
__device__ __forceinline__ float clamp8(float v) { return __builtin_amdgcn_fmed3f(v, -448.0f, 448.0f); }
__device__ __forceinline__ void p0_transpose_item8(const float* W, int ldw, int c0, unsigned char* WT8, int ldt, int r0, int k0, float scale, LAS float* scr, int lane) {
#pragma unroll
    for (int i = 0; i < 32; ++i) { const int kk = 2 * i + (lane >> 5); scr[kk * 33 + (lane & 31)] = W[(size_t)(k0 + kk) * ldw + c0 + (lane & 31)] * scale; }
    LDS_WAIT(); asm volatile("" ::: "memory");
    const int c = lane & 7;
#pragma unroll
    for (int j = 0; j < 4; ++j) { const int n = (lane >> 3) + 8 * j; const LAS float* s = scr + (8 * c) * 33 + n;
        int lo = __builtin_amdgcn_cvt_pk_fp8_f32(s[0 * 33], s[1 * 33], 0, false); lo = __builtin_amdgcn_cvt_pk_fp8_f32(s[2 * 33], s[3 * 33], lo, true);
        int hi = __builtin_amdgcn_cvt_pk_fp8_f32(s[4 * 33], s[5 * 33], 0, false); hi = __builtin_amdgcn_cvt_pk_fp8_f32(s[6 * 33], s[7 * 33], hi, true);
        *(GAS unsigned long long*)(WT8 + (size_t)(r0 + n) * ldt + k0 + 8 * c) = (unsigned long long)(unsigned)lo | ((unsigned long long)(unsigned)hi << 32); }
    LDS_WAIT(); asm volatile("" ::: "memory");
}
__device__ __forceinline__ void fold_item(Frame& F, const float* A, int lda, const float* B, int ldb, bf16* out, int ldo, int row0, int col0) {
    LAS float* As = (LAS float*)(F.lds); LAS float* Bs = (LAS float*)(F.lds + 64 * 129 * 4);
    { const int r = F.tid >> 3, c = (F.tid & 7) * 16;
#pragma unroll
      for (int q = 0; q < 4; ++q) { const f32x4 v = *(const f32x4*)(A + (size_t)r * lda + c + 4 * q); As[r * 129 + c + 4 * q + 0] = v[0]; As[r * 129 + c + 4 * q + 1] = v[1]; As[r * 129 + c + 4 * q + 2] = v[2]; As[r * 129 + c + 4 * q + 3] = v[3]; } }
    { const int r = F.tid >> 2, c = (F.tid & 3) * 16;
#pragma unroll
      for (int q = 0; q < 4; ++q) *(LAS f32x4*)(Bs + r * 64 + c + 4 * q) = *(const f32x4*)(B + (size_t)r * ldb + c + 4 * q); }
    __syncthreads();
    const int j = F.tid & 63, ig = F.tid >> 6; float acc[8];
#pragma unroll
    for (int ii = 0; ii < 8; ++ii) acc[ii] = 0.f;
#pragma unroll 4
    for (int d = 0; d < 128; ++d) { const float bv = Bs[d * 64 + j];
#pragma unroll
        for (int ii = 0; ii < 8; ++ii) acc[ii] = fmaf(As[(8 * ig + ii) * 129 + d], bv, acc[ii]); }
    v4u o; o.x = pk2(acc[0], acc[1]); o.y = pk2(acc[2], acc[3]); o.z = pk2(acc[4], acc[5]); o.w = pk2(acc[6], acc[7]);
    *(GAS v4u*)(out + (size_t)(row0 + j) * ldo + col0 + 8 * ig) = o;
    __syncthreads();
}
struct Inputs { const float *x, *w_in, *kv_g, *w_uk, *w_uv, *t5, *fgb, *w_o, *g1, *g2, *w_up, *conv_w, *conv_b, *w_down, *gf; };

__device__ __forceinline__ void p0_prologue(Frame& F, const Inputs& I, unsigned char* ws) {
    F.refresh();
    bf16* WIN = (bf16*)(ws + WS_WIN); bf16* H = (bf16*)(ws + WS_H);
    bf16* WUKT = (bf16*)(ws + WS_WUKT); bf16* WUVT = (bf16*)(ws + WS_WUVT);
    LAS float* scr = (LAS float*)(F.lds + RING_OFF + F.wave * 16384);
    const int gw = F.vcu * NWAVES + F.wave, NGW = F.G * NWAVES;
    constexpr int I_IN = 170 * 32, I_UK = 8 * 2 * 8, I_UV = 8 * 4 * 4, NIT = I_IN + I_UK + I_UV;
    constexpr int P0R = ((PROBE2X >> 16) & 1) + 1;
    for (int it = gw; it < NIT * P0R; it += NGW) {
        int r = it % NIT;
        if (r < I_IN) { const int cb = r >> 5, kb = r & 31;
            if (cb < 32 || (cb >= 72 && cb < 168)) {
                const int dst = cb < 32 ? cb * 32 : 1024 + (cb - 72) * 32, src = cb < 32 ? cb * 32 : 2384 + (cb - 72) * 32;
                p0_transpose_item8(I.w_in, D_IN_SRC, src, ws + WS_WIN8, DM, dst, kb * 64, pg8::WIN8_SCALE, scr, F.lane); continue; }
            const int dst = cb < 72 ? (cb - 32) * 32 : 1280 + (cb - 168) * 32, src = cb < 72 ? cb * 32 : 2304 + (cb - 168) * 32;
            p0_transpose_item(I.w_in, D_IN_SRC, src, WIN, DM, dst, kb * 64, nullptr, scr, F.lane); continue; }
        r -= I_IN;
        if (r < I_UK) { const int h = r >> 4, kb = (r >> 3) & 1, nb = r & 7;
            p0_transpose_item(I.w_uk + (size_t)h * 128 * 256, 256, nb * 32, WUKT + (size_t)h * 256 * 128, 128, nb * 32, kb * 64, nullptr, scr, F.lane); continue; }
        r -= I_UK;
        { const int h = r >> 4, kb = (r >> 2) & 3, nb = r & 3;
            p0_transpose_item(I.w_uv + (size_t)h * 256 * 128, 128, nb * 32, WUVT + (size_t)h * 128 * 256, 256, nb * 32, kb * 64, nullptr, scr, F.lane); }
    }
    for (int e = (F.vcu * NWAVES + F.wave) * 64 + F.lane; e < 192 * DM; e += NGW * 64) { const int c = 64 + e / DM, k = e % DM;
        float v = 0.f; if (c < 80) v = I.w_in[(size_t)k * D_IN_SRC + 2368 + (c - 64)]; else if (c < 88) v = I.w_in[(size_t)k * D_IN_SRC + 5456 + (c - 80)];
        WIN[(size_t)(1280 + c) * DM + k] = (bf16)f2bf(v); }
    for (int mm = gw; mm < M * P0R; mm += NGW) { const int m = mm % M;
        const GAS f32x4* xr = (const GAS f32x4*)(I.x + (size_t)m * DM) + F.lane; const GAS f32x4* gr = (const GAS f32x4*)I.g1 + F.lane;
        f32x4 v[8]; float s = 0.f;
#pragma unroll
        for (int j = 0; j < 8; ++j) { v[j] = __builtin_nontemporal_load((const f32x4*)(xr + 64 * j)); s += (v[j].x * v[j].x + v[j].y * v[j].y) + (v[j].z * v[j].z + v[j].w * v[j].w); }
        const float rstd = __builtin_amdgcn_rsqf(wave_sum(s) * (1.0f / DM) + 1e-6f);
        GAS unsigned long long* o8 = (GAS unsigned long long*)(H + (size_t)m * DM) + F.lane;
#pragma unroll
        for (int j = 0; j < 8; ++j) { const f32x4 g = gr[64 * j]; const float h0 = v[j].x * rstd * g.x, h1 = v[j].y * rstd * g.y, h2 = v[j].z * rstd * g.z, h3 = v[j].w * rstd * g.w;
            o8[64 * j] = (unsigned long long)pk2(h0, h1) | ((unsigned long long)pk2(h2, h3) << 32);
            int w8 = __builtin_amdgcn_cvt_pk_fp8_f32(clamp8(h0 * pg8::H8_SCALE), clamp8(h1 * pg8::H8_SCALE), 0, false); w8 = __builtin_amdgcn_cvt_pk_fp8_f32(clamp8(h2 * pg8::H8_SCALE), clamp8(h3 * pg8::H8_SCALE), w8, true);
            ((GAS int*)(ws + WS_H8 + (size_t)m * DM))[F.lane + 64 * j] = w8; }
    }
}
__device__ __forceinline__ void late_weights(Frame& F, const Inputs& I, unsigned char* ws, int gw, int NGW, bool with_down_only) {
    bf16* WO = (bf16*)(ws + WS_WO); bf16* WUP = (bf16*)(ws + WS_WUP); bf16* WDN = (bf16*)(ws + WS_WDN);
    LAS float* scr = (LAS float*)(F.lds + RING_OFF + F.wave * 16384);
    constexpr int I_O = 32 * 64, I_UP = 352 * 32, I_DN = 88 * 64;
    const int it0 = with_down_only ? I_O + I_UP : 0, it1 = with_down_only ? I_O + I_UP + I_DN : I_O + I_UP;
    for (int it = it0 + gw; it < it1; it += NGW) {
        int r = it;
        if (r < I_O) { const int kb = r >> 6, nb = r & 63; p0_transpose_item8(I.w_o, DM, nb * 32, (unsigned char*)WO, K_O, nb * 32, kb * 64, pg8::WO_SCALE, scr, F.lane); continue; }
        r -= I_O;
        if (r < I_UP) { const int cb = r >> 5, kb = r & 31; const int n0 = cb * 32, j = n0 >> 8, c = n0 & 255; const int src = c < 128 ? 128 * j + c : FF + 128 * j + (c - 128);
            p0_transpose_item(I.w_up, FF2, src, WUP, DM, n0, kb * 64, I.g2, scr, F.lane); continue; }
        r -= I_UP;
        { const int kb = r >> 6, nb = r & 63; p0_transpose_item8(I.w_down, DM, nb * 32, (unsigned char*)WDN, FF, nb * 32, kb * 64, pg8::WDN_SCALE, scr, F.lane); }
    }
}
__device__ __forceinline__ float log_sigmoid(float x) { return x >= 0.f ? -log1pf(expf(-x)) : x - log1pf(expf(x)); }
constexpr int NCUMWG = 16;
__device__ __forceinline__ void p2_misc(Frame& F, const Inputs& I, unsigned char* ws) {
    F.refresh();
    { const int h = F.vcu >> 5, part = F.vcu & 31;
      if (F.G == 256) dsa::absorb_wg<128, 16, true>(F.lds, (const bf16*)(ws + WS_WUKT) + (size_t)h * 256 * 128, (const bf16*)(ws + WS_AQ) + (size_t)h * M * 128, 128, (bf16*)(ws + WS_QLAT + (size_t)h * M * 256), 256, part * 64, 8, F.tid);
      else { const int gw0 = F.vcu * NWAVES + F.wave, combo = gw0 & 31, hh = combo >> 2, qd = combo & 3;
        dsa::absorb<128, 4, true>((const bf16*)(ws + WS_WUKT) + ((size_t)hh * 256 + qd * 64) * 128, (const bf16*)(ws + WS_AQ) + (size_t)hh * M * 128, 128, (bf16*)(ws + WS_QLAT + (size_t)hh * M * 256 + qd * 64), 256, gw0 >> 5, (F.G * NWAVES) >> 5, M / 16, F.lane); } }
    const float* SMALL = (const float*)(ws + WS_SMALL); float* CUM = (float*)(ws + WS_CUM);
    if (F.vcu >= F.G - NCUMWG) {
        const int bh = F.vcu - (F.G - NCUMWG), b = bh >> 3, h = bh & 7; LAS float* tot = (LAS float*)(F.lds);
        const float fb = I.fgb[h];
        const float* sp = SMALL + ((size_t)b * SEQ + (size_t)F.tid * 32) * 128 + 80 + h;
        float lf[32]; float s = 0.f;
#pragma unroll
        for (int k = 0; k < 32; ++k) lf[k] = sp[(size_t)k * 128];
#pragma unroll
        for (int k = 0; k < 32; ++k) { const float x = lf[k] + fb;
            lf[k] = fminf(x, 0.f) - 0.6931471805599453f * __builtin_amdgcn_logf(1.0f + __builtin_amdgcn_exp2f(-1.4426950408889634f * fabsf(x))); s += lf[k]; }
        tot[F.tid] = s;
        __syncthreads();
        if (F.wave == 0) { float loc[8]; float run = 0.f;
#pragma unroll
            for (int k = 0; k < 8; ++k) { loc[k] = run; run += tot[8 * F.lane + k]; }
            float incl = run;
#pragma unroll
            for (int o = 1; o < 64; o <<= 1) { const float v = __shfl_up(incl, o); if (F.lane >= o) incl += v; }
            const float excl = incl - run;
#pragma unroll
            for (int k = 0; k < 8; ++k) tot[8 * F.lane + k] = excl + loc[k]; }
        __syncthreads();
        float run = tot[F.tid];
        float* cp = CUM + (size_t)bh * SEQ + (size_t)F.tid * 32;
#pragma unroll
        for (int k = 0; k < 32; k += 4) { f32x4 o; run += lf[k]; o[0] = run; run += lf[k + 1]; o[1] = run; run += lf[k + 2]; o[2] = run; run += lf[k + 3]; o[3] = run; *(f32x4*)(cp + k) = o; }
        __syncthreads();
        return;
    }
    const int nwg = F.G - NCUMWG, gw = F.vcu * NWAVES + F.wave, NGW = nwg * NWAVES;
    const bf16* AKV = (const bf16*)(ws + WS_AKV); unsigned char* CKV8 = (unsigned char*)(ws + WS_CKV); bf16* KIDX = (bf16*)(ws + WS_KIDX);
    const f32x4 g4 = *(const f32x4*)(I.kv_g + 4 * F.lane);
    constexpr int P2R = ((PROBE2X >> 17) & 1) + 1;
    for (int mm = gw; mm < M * P2R; mm += 4 * NGW) {
        unsigned long long raw[4]; f32x4 kv[4];
#pragma unroll
        for (int u = 0; u < 4; ++u) { const int m = (mm + u * NGW) % M; raw[u] = *(const GAS unsigned long long*)(AKV + (size_t)m * 256 + 4 * F.lane);
            kv[u] = (f32x4){0.f, 0.f, 0.f, 0.f}; if (F.lane < 16) kv[u] = *(const f32x4*)(SMALL + (size_t)m * 128 + 4 * F.lane); }
#pragma unroll
        for (int u = 0; u < 4; ++u) { if (mm + u * NGW >= M * P2R) break; const int m = (mm + u * NGW) % M;
            const float a0 = __uint_as_float((unsigned)(raw[u] & 0xffffu) << 16), a1 = __uint_as_float((unsigned)((raw[u] >> 16) & 0xffffu) << 16), a2 = __uint_as_float((unsigned)((raw[u] >> 32) & 0xffffu) << 16), a3 = __uint_as_float((unsigned)((raw[u] >> 48) & 0xffffu) << 16);
            const float rstd = __builtin_amdgcn_rsqf(wave_sum((a0 * a0 + a1 * a1) + (a2 * a2 + a3 * a3)) * (1.0f / 256.0f) + 1e-6f);
            { int w8 = __builtin_amdgcn_cvt_pk_fp8_f32(a0 * rstd * g4[0], a1 * rstd * g4[1], 0, false); w8 = __builtin_amdgcn_cvt_pk_fp8_f32(a2 * rstd * g4[2], a3 * rstd * g4[3], w8, true);
              *(GAS unsigned*)(CKV8 + (size_t)m * 256 + 4 * F.lane) = (unsigned)w8; }
            if (F.lane < 16) *(GAS unsigned long long*)(KIDX + (size_t)m * 64 + 4 * F.lane) = (unsigned long long)pk2(kv[u][0], kv[u][1]) | ((unsigned long long)pk2(kv[u][2], kv[u][3]) << 32); }
    }
    for (int itt = gw; itt < 16 * 64 * P2R; itt += NGW) { const int it = itt % 1024; const int bh = it >> 6, ck = it & 63;
        const bf16* qb_ = (const bf16*)(ws + WS_BQ) + ((size_t)bh * SEQ + (size_t)ck * 256) * 128; const bf16* kb_ = (const bf16*)(ws + WS_BK) + ((size_t)bh * SEQ + (size_t)ck * 256) * 128;
        float mq = 0.f, mk = 0.f, dmn = 3.0e38f;
#pragma unroll 8
        for (int i = 0; i < 64; ++i) { const size_t ro = (size_t)(4 * i + (F.lane >> 4)) * 128 + (F.lane & 15) * 8;
            const v4u vq = *(const GAS v4u*)(qb_ + ro), vk = *(const GAS v4u*)(kb_ + ro);
            float sq = 0.f, sk = 0.f, sd = 0.f; const unsigned wq[4] = {vq.x, vq.y, vq.z, vq.w}, wk[4] = {vk.x, vk.y, vk.z, vk.w};
#pragma unroll
            for (int q = 0; q < 4; ++q) { const float ql = __uint_as_float(wq[q] << 16), qh = __uint_as_float(wq[q] & 0xffff0000u), kl = __uint_as_float(wk[q] << 16), kh = __uint_as_float(wk[q] & 0xffff0000u);
                sq += ql * ql + qh * qh; sk += kl * kl + kh * kh; sd += ql * kl + qh * kh; }
            sq += pg8::dppf<0x128>(sq); sk += pg8::dppf<0x128>(sk); sd += pg8::dppf<0x128>(sd);
            sq += pg8::dppf<0x124>(sq); sk += pg8::dppf<0x124>(sk); sd += pg8::dppf<0x124>(sd);
            sq += pg8::dppf<0x122>(sq); sk += pg8::dppf<0x122>(sk); sd += pg8::dppf<0x122>(sd);
            sq += pg8::dppf<0x121>(sq); sk += pg8::dppf<0x121>(sk); sd += pg8::dppf<0x121>(sd);
            mq = fmaxf(mq, sq); mk = fmaxf(mk, sk); dmn = fminf(dmn, sd); }
        mq = fmaxf(mq, __shfl_xor(mq, 16)); mq = fmaxf(mq, __shfl_xor(mq, 32)); mk = fmaxf(mk, __shfl_xor(mk, 16)); mk = fmaxf(mk, __shfl_xor(mk, 32)); dmn = fminf(dmn, __shfl_xor(dmn, 16)); dmn = fminf(dmn, __shfl_xor(dmn, 32));
        if (F.lane == 0) { atomicMax((unsigned*)(F.ctl + CW_NORMK + bh), __float_as_uint(mk)); __hip_atomic_store(F.ctl + CW_QBLK + it, __float_as_uint(mq), RLX_AGENT); __hip_atomic_store(F.ctl + CW_DMIN + it, __float_as_uint(dmn), RLX_AGENT); } }
    late_weights(F, I, ws, gw, NGW, false);
}
constexpr int NFOX = 16 * 64, NDSA = 2 * 512;
constexpr int NFOX_Q = NFOX * (((PROBE2X >> 3) & 1) + 1), NDSA_Q = NDSA * (((PROBE2X >> 9) & 1) + 1);
__device__ __forceinline__ int queue_fetch(Frame& F, int q) {
    if (F.tid == 0) F.MISC[16] = __hip_atomic_fetch_add(F.ctl + CW_QUEUE + 64 * q, 1u, RLX_AGENT);
    __syncthreads(); const int v = __builtin_amdgcn_readfirstlane((int)F.MISC[16]); __syncthreads(); return v;
}
__device__ __forceinline__ fox::BlockRef fox_ref(Frame& F, unsigned char* ws, int id) {
    const int idm = id % NFOX, qb = 63 - (idm >> 4), bh = idm & 15, b = bh >> 3, h = bh & 7;
    fox::BlockRef r;
    r.Q = (const bf16*)(ws + WS_BQ) + ((size_t)bh * SEQ + (size_t)qb * 256) * 128; r.K = (const bf16*)(ws + WS_BK) + (size_t)bh * SEQ * 128; r.V = (const bf16*)(ws + WS_BV) + (size_t)bh * SEQ * 128;
    r.O = (bf16*)(ws + WS_MIX + ((size_t)b * SEQ + (size_t)qb * 256) * K_O + 1024 + h * 128); r.ldo = K_O;
    r.C = (const float*)(ws + WS_CUM) + (size_t)bh * SEQ; r.P0 = qb * 256; r.cref = __uint_as_float(__builtin_amdgcn_readfirstlane(__float_as_uint(r.C[r.P0])));
    const float qn = sqrtf(__uint_as_float(__hip_atomic_load(F.ctl + CW_QBLK + bh * 64 + qb, RLX_AGENT))), kn = sqrtf(__uint_as_float(__hip_atomic_load(F.ctl + CW_NORMK + bh, RLX_AGENT)));
    const float dmn = __uint_as_float(__hip_atomic_load(F.ctl + CW_DMIN + bh * 64 + qb, RLX_AGENT));
    const float lim = __uint_as_float(__builtin_amdgcn_readfirstlane(__float_as_uint(r.cref + 28.5f + (qn * kn - dmn) * fox::SCALE)));
    const int jd = r.P0 / 64; int nf = 0;
    int l4 = F.lane * 4; asm volatile("" : "+v"(l4));
    float cv[4];
#pragma unroll
    for (int i = 0; i < 4; ++i) { const int j = l4 + i; cv[i] = *(const float*)((const char*)r.C + (unsigned)((64 * (j < jd ? j : 0) + 63) * 4)); }
#pragma unroll
    for (int i = 0; i < 4; ++i) { const bool f = (l4 + i < jd) && (cv[i] > lim); nf += (int)__popcll(__ballot(f)); }
    r.jlo = ((PROBE2X >> 20) & 1) ? (nf > 16 ? nf - 16 : 0) : nf;
    return r;
}
__device__ __forceinline__ void p3_fox(Frame& F, unsigned char* ws, int q) {
    F.refresh();
    int id = (int)blockIdx.x; const int G_ = (int)gridDim.x; (void)q;
    if (id < NFOX_Q) {
        fox::Seam S; fox::BlockRef cur = fox_ref(F, ws, id);
        fox::fox_prime(cur, (char*)F.lds, S, F.tid);
        for (;;) {
            id += G_; const int idn = id; const bool more = idn < NFOX_Q;
            const fox::BlockRef nxt = more ? fox_ref(F, ws, idn) : cur;
            fox::fox_block(cur, nxt, SEQ, (char*)F.lds, S, F.tid);
            if (!more) break;
            cur = nxt;
        }
    }
    asm volatile("s_waitcnt vmcnt(0)" ::: "memory"); __syncthreads();
}
__device__ __forceinline__ void p3_dsa(Frame& F, const Inputs& I, unsigned char* ws) {
    F.refresh();
    dsa::init_tables(F.lds, I.t5, F.tid);
    __syncthreads();
    dsa::Tensors T{(const bf16*)(ws + WS_AIQ), (const float*)(ws + WS_SMALL), (const bf16*)(ws + WS_KIDX), (const unsigned char*)(ws + WS_CKV), (const unsigned char*)(ws + WS_QLAT), (bf16*)(ws + WS_OLAT)};
    const int bpref = ((int)blockIdx.x >> 2) & 1;
    _Pragma("nounroll") for (int pass = 0; pass < 2; ++pass) { const int b = bpref ^ pass;
        for (int uq = queue_fetch(F, 2 + b); uq < NDSA_Q / 2; uq = queue_fetch(F, 2 + b)) { const int u = uq % (NDSA / 2); dsa::unit(F.lds, T, b, (511 - u) * 32, F.tid); } }
}
__device__ __forceinline__ void p4_oa(Frame& F, unsigned char* ws) {
    F.refresh();
    const int h = F.vcu >> 5, part = F.vcu & 31;
    if (F.G == 256) { dsa::absorb_wg<256, 8, true>(F.lds, (const bf16*)(ws + WS_WUVT) + (size_t)h * 128 * 256, (const bf16*)(ws + WS_OLAT) + (size_t)h * M * 256, 256, (bf16*)(ws + WS_MIX + h * 128), K_O, part * 64, 8, F.tid, ((PROBE2X >> 18) & 1) + 1, pg8::MIX_SCALE); return; }
    const int gw0 = F.vcu * NWAVES + F.wave, combo = gw0 & 31, hh = combo >> 2, pr = combo & 3;
    dsa::absorb<256, 2, true>((const bf16*)(ws + WS_WUVT) + ((size_t)hh * 128 + pr * 32) * 256, (const bf16*)(ws + WS_OLAT) + (size_t)hh * M * 256, 256, (bf16*)(ws + WS_MIX + hh * 128 + pr * 32), K_O, gw0 >> 5, (F.G * NWAVES) >> 5, M / 16, F.lane, 1, pg8::MIX_SCALE);
}
__device__ __forceinline__ void p8_final(Frame& F, const Inputs& I, float* out, const bf16* x2b) {
    F.refresh();
    const int gw = F.vcu * NWAVES + F.wave, NGW = F.G * NWAVES; const float* ss2 = (const float*)((const unsigned char*)F.ctl + CTL_SS2);
    f32x4 gv[4][2];
    { const GAS f32x4* gr = (const GAS f32x4*)I.gf + 2 * F.lane;
#pragma unroll
      for (int j = 0; j < 4; ++j) { gv[j][0] = gr[128 * j]; gv[j][1] = gr[128 * j + 1]; } }
    v4u vn[4]; float sn = 0.f;
    if (gw < M) { const GAS v4u* xr = (const GAS v4u*)(x2b + (size_t)gw * DM) + F.lane;
#pragma unroll
        for (int j = 0; j < 4; ++j) vn[j] = xr[64 * j];
        sn = ss2[gw]; }
    for (int m = gw; m < M; m += NGW) {
        GAS f32x4* orow = (GAS f32x4*)(out + (size_t)m * DM) + 2 * F.lane;
        v4u vc[4]; const float sc = sn;
#pragma unroll
        for (int j = 0; j < 4; ++j) vc[j] = vn[j];
        if (m + NGW < M) { const GAS v4u* xr = (const GAS v4u*)(x2b + (size_t)(m + NGW) * DM) + F.lane;
#pragma unroll
            for (int j = 0; j < 4; ++j) vn[j] = xr[64 * j];
            sn = ss2[m + NGW]; }
        const float rstd = __builtin_amdgcn_rsqf(sc * (1.0f / DM) + 1e-6f);
#pragma unroll
        for (int j = 0; j < 4; ++j) { const v4u v = vc[j]; const f32x4 g0 = gv[j][0], g1 = gv[j][1];
            const f32x4 a = {__uint_as_float(v.x << 16), __uint_as_float(v.x & 0xffff0000u), __uint_as_float(v.y << 16), __uint_as_float(v.y & 0xffff0000u)};
            const f32x4 b = {__uint_as_float(v.z << 16), __uint_as_float(v.z & 0xffff0000u), __uint_as_float(v.w << 16), __uint_as_float(v.w & 0xffff0000u)};
            orow[128 * j] = a * g0 * rstd; orow[128 * j + 1] = b * g1 * rstd; }
    }
}

struct Args { const float* in[15]; float* out; unsigned char* ws; int ph_lo, ph_hi; };
__global__ void __launch_bounds__(NWAVES * 64, 2) layer_fwd(Args args) {
    extern __shared__ __attribute__((aligned(16))) unsigned char lds[];
    Frame F;
    F.lds = (LAS unsigned char*)lds; F.MISC = (volatile LAS unsigned*)(F.lds + MISC_OFF);
    F.wave = __builtin_amdgcn_readfirstlane((int)threadIdx.x >> 6); F.refresh();
    F.G = gridDim.x; { const int bx = blockIdx.x; F.vcu = (F.G % 8 == 0) ? (bx % 8) * (F.G / 8) + bx / 8 : bx; }
    unsigned char* ws = args.ws; F.ctl = (gu32*)(ws + WS_CTL);
    Inputs I{args.in[0], args.in[1], args.in[2], args.in[3], args.in[4], args.in[5], args.in[6], args.in[7], args.in[8], args.in[9], args.in[10], args.in[11], args.in[12], args.in[13], args.in[14]};
    for (int u = F.tid; u < (LDS_BYTES - LDSCTL_OFF) / 4; u += NWAVES * 64) ((LAS unsigned*)(F.lds + LDSCTL_OFF))[u] = 0u;
    __syncthreads();
    XcdBarrier bar; bar.bar = (unsigned*)(F.ctl + CW_BAR); bar.x = 0; bar.st = nullptr;
    if (N_LAUNCHES == 1) bar = xcd_barrier_post((unsigned*)(F.ctl + CW_BAR), F.MISC + 8, F.tid == 0);
    const int lo = args.ph_lo, hi = args.ph_hi;
#ifndef PH_MASK
#define PH_MASK 0x3ff
#endif
#define IN(k) (((PH_MASK >> (k)) & 1) && lo <= (k) && (k) < hi)
#define SEAM(k) do { if (IN(k) && IN((k) + 1)) xcd_barrier(bar, F.wave * 64 + fresh_lane() == 0); } while (0)
    float* SS1 = (float*)((unsigned char*)F.ctl + CTL_SS1); float* SS2 = (float*)((unsigned char*)F.ctl + CTL_SS2);
    if (IN(0)) { p0_prologue(F, I, ws); SEAM(0); }
    if (IN(1)) {
        { pg8::Gemm g{(const pg8::bf16_t*)(ws + WS_H), (const pg8::bf16_t*)(ws + WS_WIN), M, N_INB, DM}; pg8::StaticOrder S; S.init(M, N_INB, F.G, (int)blockIdx.x, ((PROBE2X >> 1) & 1) + 1);
          pg8::EpiInProj E{(pg8::bf16_t*)(ws + WS_AQ), (pg8::bf16_t*)(ws + WS_AKV), (pg8::bf16_t*)(ws + WS_AIQ), (pg8::bf16_t*)(ws + WS_BQ), (size_t)(WS_BK - WS_BQ) / 2, (float*)(ws + WS_SMALL)};
          pg8::gemm_phase<pg8::EpiInProj, pg8::StaticOrder, true, true>(F.lds + RING_OFF, g, S, E, F.wave * 64 + fresh_lane()); }
        { pg8::Gemm g{(const pg8::bf16_t*)(ws + WS_H8), (const pg8::bf16_t*)(ws + WS_WIN8), M, N_IN8, DM / 2}; pg8::StaticOrder S; S.init(M, N_IN8, F.G, (int)blockIdx.x, ((PROBE2X >> 1) & 1) + 1);
          pg8::EpiInProj8 E{(pg8::bf16_t*)(ws + WS_AQ), (pg8::bf16_t*)(ws + WS_AKV), (pg8::bf16_t*)(ws + WS_AIQ), (pg8::bf16_t*)(ws + WS_BQ), (size_t)(WS_BK - WS_BQ) / 2, (float*)(ws + WS_SMALL)};
          pg8::gemm_phase<pg8::EpiInProj8, pg8::StaticOrder, true, true, true>(F.lds + RING_OFF, g, S, E, F.wave * 64 + fresh_lane()); }
        SEAM(1);
    }
    if (IN(2)) { p2_misc(F, I, ws); SEAM(2); }
    if (IN(3)) {
        _Pragma("nounroll") for (int rep = 0; rep < 1; ++rep) p3_fox(F, ws, rep);
        p3_dsa(F, I, ws);
        SEAM(3);
    }
    if (IN(4)) { _Pragma("nounroll") for (int rep = 0; rep < ((PROBE2X >> 18) & 1) + 1; ++rep) { if (rep) xcd_barrier(bar, F.wave * 64 + fresh_lane() == 0); p4_oa(F, ws); } SEAM(4); }
    if (IN(5)) {
        pg8::Gemm g{(const pg8::bf16_t*)(ws + WS_MIX), (const pg8::bf16_t*)(ws + WS_WO), M, DM, K_O / 2}; pg8::StaticOrder S; S.init(M, DM, F.G, (int)blockIdx.x);
        pg8::EpiOutProj E{I.x, (pg8::bf16_t*)(ws + WS_H), (pg8::bf16_t*)(ws + WS_AHALO), SS1};
        pg8::gemm_phase<pg8::EpiOutProj, pg8::StaticOrder, true, true, true>(F.lds + RING_OFF, g, S, E, F.wave * 64 + fresh_lane());
        SEAM(5);
    }
    if (IN(6)) {
        pg8::Gemm g{(const pg8::bf16_t*)(ws + WS_AHALO), (const pg8::bf16_t*)(ws + WS_WUP), NHALO, FF2, DM}; pg8::StaticOrder S; S.init(NHALO, FF2, F.G, (int)blockIdx.x);
        pg8::EpiHalo E{SS1, (float*)(ws + WS_UHALO)};
        pg8::gemm_phase<pg8::EpiHalo, pg8::StaticOrder, true, true>(F.lds + RING_OFF, g, S, E, F.wave * 64 + fresh_lane());
        constexpr int NHU = (NHALO / 256) * (FF2 / 256);
        if ((int)blockIdx.x >= NHU) { F.refresh(); late_weights(F, I, ws, ((int)blockIdx.x - NHU) * NWAVES + F.wave, ((int)gridDim.x - NHU) * NWAVES, true); }
        SEAM(6);
    }
    if (IN(7)) {
        pg8::Gemm g{(const pg8::bf16_t*)(ws + WS_H), (const pg8::bf16_t*)(ws + WS_WUP), M, FF2, DM}; pg8::StaticOrder S; S.init(M, FF2, F.G, (int)blockIdx.x, ((PROBE2X >> 6) & 1) + 1);
        pg8::EpiUp E{SS1, (const float*)(ws + WS_UHALO), I.conv_w, I.conv_b, ws + WS_ACT};
        pg8::gemm_phase<pg8::EpiUp, pg8::StaticOrder, true, true>(F.lds + RING_OFF, g, S, E, F.wave * 64 + fresh_lane());
        SEAM(7);
    }
    if (IN(8)) {
        pg8::Gemm g{(const pg8::bf16_t*)(ws + WS_ACT), (const pg8::bf16_t*)(ws + WS_WDN), M, DM, FF / 2}; pg8::StaticOrder S; S.init(M, DM, F.G, (int)blockIdx.x);
        pg8::EpiDown E{(const pg8::bf16_t*)(ws + WS_H), (pg8::bf16_t*)(ws + WS_X2B), SS2};
        pg8::gemm_phase<pg8::EpiDown, pg8::StaticOrder, true, true, true>(F.lds + RING_OFF, g, S, E, F.wave * 64 + fresh_lane());
        SEAM(8);
    }
    if (IN(9)) p8_final(F, I, args.out, (const bf16*)(ws + WS_X2B));
#undef IN
#undef SEAM
}

extern "C" void kernel_launch(void* const* d_in, const int* in_sizes, int n_in, void* d_out, int out_size, void* d_ws, size_t ws_size, hipStream_t stream) {
    static int grid = 0;
    if (grid == 0) {
        if (n_in != 15 || in_sizes[0] != M * DM || out_size != M * DM || ws_size < WS_END) { fprintf(stderr, "kernel_launch: unexpected shapes (n_in %d, in0 %d, out %d, ws %zu)\n", n_in, n_in > 0 ? in_sizes[0] : -1, out_size, ws_size); grid = -1; return; }
        int dev = 0, cus = 0, per_cu = 0;
        if (hipGetDevice(&dev) != hipSuccess || hipDeviceGetAttribute(&cus, hipDeviceAttributeMultiprocessorCount, dev) != hipSuccess) { grid = -1; return; }
        if (hipFuncSetAttribute((const void*)layer_fwd, hipFuncAttributeMaxDynamicSharedMemorySize, LDS_BYTES) != hipSuccess) { fprintf(stderr, "kernel_launch: hipFuncSetAttribute failed\n"); grid = -1; return; }
        if (hipOccupancyMaxActiveBlocksPerMultiprocessor(&per_cu, (const void*)layer_fwd, NWAVES * 64, LDS_BYTES) != hipSuccess || per_cu < 1) fprintf(stderr, "kernel_launch: occupancy query reports %d\n", per_cu);
        (void)hipGetLastError();
        grid = cus;
    }
    if (grid < 0) return;
    if (hipMemsetAsync((char*)d_ws + WS_CTL, 0, CTL_ZERO_BYTES, stream) != hipSuccess) return;
    Args a{};
    for (int i = 0; i < 15; ++i) a.in[i] = (const float*)d_in[i];
    a.out = (float*)d_out; a.ws = (unsigned char*)d_ws;
    for (int li = 0; li < N_LAUNCHES; ++li) {
        a.ph_lo = (N_LAUNCHES == 1) ? 0 : li; a.ph_hi = (N_LAUNCHES == 1) ? N_PHASES : li + 1;
        hipLaunchKernelGGL(layer_fwd, dim3(grid), dim3(NWAVES * 64), LDS_BYTES, stream, a);
        if (hipPeekAtLastError() != hipSuccess) { fprintf(stderr, "kernel_launch: launch %d failed\n", li); break; }
    }
}
```
